# Optimizing an MI355X kernel written in HIP

```python
import jax, jax.numpy as jnp
from jax import lax
import numpy as np

D_MODEL = 1024
BATCH = 8
SEQ = 2048
DEPTH = 1
DEC_BATCH = 128
DEC_SEQ = 4
PAST_LEN = 16384
PAGE_SIZE = 128

A_HEAD = 64
A_HEADS = 8
A_WIDTH = A_HEADS * A_HEAD
A_RANK_W = 64
A_RANK_A = 64
A_RANK_G = 128
A_PROJ = 3 * A_WIDTH + A_RANK_W + A_RANK_A + A_RANK_G
A_LNX_EPS = 64e-5
B_HEADS = 4
B_HEAD = 128
B_WIDTH = B_HEADS * B_HEAD
CONV_K = 4
CONV_CH = 3 * B_WIDTH
B_PROJ = CONV_CH + 2 * B_HEADS + B_WIDTH
DELTA_CHUNK = 64
GATE_COLS = 2 * D_MODEL
IN_COLS = A_PROJ + B_PROJ + GATE_COLS
D_FF = 2816
RMS_EPS = 1e-6

kernel_name = 'hybrid_rwkv7_gdn_macaron_step'

F32 = jnp.float32


def _rms(x, w):
    x32 = x.astype(F32)
    y = x32 * lax.rsqrt(jnp.mean(x32 * x32, axis=-1, keepdims=True) + RMS_EPS) * w.astype(F32)
    return y.astype(x.dtype)


def _swiglu(x, wg, wu, wd):
    return (jax.nn.silu(x @ wg) * (x @ wu)) @ wd


def _l2norm(t):
    return t * lax.rsqrt(jnp.sum(t * t, axis=-1, keepdims=True) + 1e-6)


def _rwkv7(pa, s_shift, s_state, mu, w0, w2, a0, a2, g2, k_k, k_a, r_k, lnx_w, lnx_b):
    Bn, T, _ = pa.shape
    pa32 = pa.astype(F32)
    prev = jnp.concatenate([s_shift.astype(F32)[:, None], pa32[:, :-1]], axis=1)
    pm = pa32 + (prev - pa32) * mu.astype(F32)
    splits = (A_WIDTH, A_WIDTH + A_RANK_W, 2 * A_WIDTH + A_RANK_W,
              3 * A_WIDTH + A_RANK_W, 3 * A_WIDTH + A_RANK_W + A_RANK_A)
    r, wd, k, v, ad, gd = jnp.split(pm, splits, axis=-1)
    w_log = -jax.nn.softplus(-(w0.astype(F32) + jnp.tanh(wd) @ w2.astype(F32))) - 0.5
    decay = jnp.exp(-jnp.exp(w_log))
    a = jax.nn.sigmoid(a0.astype(F32) + ad @ a2.astype(F32))
    g = jax.nn.sigmoid(gd) @ g2.astype(F32)
    hs = lambda t: t.reshape(Bn, T, A_HEADS, A_HEAD)
    kk = hs(k * k_k.astype(F32))
    kk = kk / jnp.maximum(jnp.sqrt(jnp.sum(kk * kk, axis=-1, keepdims=True)), 1e-12)
    k = k * (1.0 + (a - 1.0) * k_a.astype(F32))
    r_h, k_h, v_h, a_h, d_h = hs(r), hs(k), hs(v), hs(a), hs(decay)

    def step(S, inp):
        r_t, d_t, k_t, v_t, kk_t, a_t = inp
        sa = jnp.einsum('bhvk,bhk->bhv', S, -kk_t)
        S = (S * d_t[:, :, None, :] + sa[..., None] * (kk_t * a_t)[:, :, None, :]
             + v_t[..., None] * k_t[:, :, None, :])
        return S, jnp.einsum('bhvk,bhk->bhv', S, r_t)

    xs = tuple(jnp.moveaxis(t, 1, 0) for t in (r_h, d_h, k_h, v_h, kk, a_h))
    S_fin, o = lax.scan(step, s_state.astype(F32), xs)
    o = jnp.moveaxis(o, 0, 1)
    mean = jnp.mean(o, axis=-1, keepdims=True)
    var = jnp.mean(jnp.square(o - mean), axis=-1, keepdims=True)
    o = ((o - mean) * lax.rsqrt(var + A_LNX_EPS)).reshape(Bn, T, A_WIDTH) * lnx_w.astype(F32) + lnx_b.astype(F32)
    bonus = jnp.sum(r_h * k_h * r_k.astype(F32), axis=-1, keepdims=True) * v_h
    o = (o + bonus.reshape(Bn, T, A_WIDTH)) * g
    return o, S_fin, pa32[:, -1]


def _chunked_gated_delta(q, k, v, beta, g, S0):
    Bn, T, H, DK = q.shape
    DV = v.shape[-1]
    C = min(DELTA_CHUNK, T)
    n = -(-T // C)
    pad = n * C - T

    def blk(t):
        t = jnp.pad(t, [(0, 0), (0, pad)] + [(0, 0)] * (t.ndim - 2))
        t = t.reshape((Bn, n, C) + t.shape[2:])
        return jnp.moveaxis(t, 3, 1)

    q, k, v, beta, g = blk(q), blk(k), blk(v), blk(beta), blk(g)
    gc = jnp.cumsum(g, axis=-1)
    idx = jnp.arange(C)
    incl = idx[:, None] >= idx[None, :]
    strict = idx[:, None] > idx[None, :]
    diff = gc[..., :, None] - gc[..., None, :]
    decay_mat = jnp.where(incl, jnp.exp(jnp.where(incl, diff, 0.0)), 0.0)
    kb = k * beta[..., None]
    A = jnp.where(strict, jnp.einsum('bhnik,bhnjk->bhnij', kb, k) * decay_mat, 0.0)
    M = A + jnp.eye(C, dtype=A.dtype)
    rhs = jnp.concatenate([v * beta[..., None], kb * jnp.exp(gc)[..., None]], axis=-1)
    sol = lax.linalg.triangular_solve(M, rhs, left_side=True, lower=True, unit_diagonal=True)
    u_c, w_c = sol[..., :DV], sol[..., DV:]
    qk = jnp.einsum('bhnik,bhnjk->bhnij', q, k) * decay_mat
    q_dec = q * jnp.exp(gc)[..., None]
    k_dec = k * jnp.exp(gc[..., -1:] - gc)[..., None]
    g_last = jnp.exp(gc[..., -1])

    def step(S, inp):
        u_t, w_t, qk_t, qd_t, kd_t, gl_t = inp
        v_new = u_t - jnp.einsum('bhck,bhkv->bhcv', w_t, S)
        o = jnp.einsum('bhck,bhkv->bhcv', qd_t, S) + jnp.einsum('bhij,bhjv->bhiv', qk_t, v_new)
        S = S * gl_t[..., None, None] + jnp.einsum('bhck,bhcv->bhkv', kd_t, v_new)
        return S, o

    xs = tuple(jnp.moveaxis(t, 2, 0) for t in (u_c, w_c, qk, q_dec, k_dec, g_last))
    S_fin, o = lax.scan(step, S0, xs)
    o = jnp.transpose(o, (1, 0, 3, 2, 4)).reshape(Bn, n * C, H, DV)[:, :T]
    return o, S_fin


def _gated_delta_branch(pb, s_conv, s_state, conv_w, A_log, dt_bias, norm_w):
    Bn, T, _ = pb.shape
    pb = pb.astype(F32)
    qkv = pb[..., :CONV_CH]
    a_in = pb[..., CONV_CH:CONV_CH + B_HEADS]
    b_in = pb[..., CONV_CH + B_HEADS:CONV_CH + 2 * B_HEADS]
    z = pb[..., CONV_CH + 2 * B_HEADS:]
    xp = jnp.concatenate([s_conv.astype(F32), qkv], axis=1)
    cw = conv_w.astype(F32)
    conv = sum(xp[:, i:i + T] * cw[i] for i in range(CONV_K))
    conv = jax.nn.silu(conv)
    new_conv = xp[:, T:]
    q, k, v = jnp.split(conv, 3, axis=-1)
    hs = lambda t: t.reshape(Bn, T, B_HEADS, B_HEAD)
    q = _l2norm(hs(q)) * (B_HEAD ** -0.5)
    k = _l2norm(hs(k))
    v = hs(v)
    beta = jax.nn.sigmoid(b_in)
    g = -jnp.exp(A_log.astype(F32)) * jax.nn.softplus(a_in + dt_bias.astype(F32))
    o, S_fin = _chunked_gated_delta(q, k, v, beta, g, s_state.astype(F32))
    o = o * lax.rsqrt(jnp.mean(o * o, axis=-1, keepdims=True) + RMS_EPS) * norm_w.astype(F32)
    o = o * jax.nn.silu(hs(z))
    return o.reshape(Bn, T, B_WIDTH), S_fin, new_conv


def _layer(x, s_rwkv, s_shift, s_delta, s_conv,
           ffn1_norm, ffn1_w_gate, ffn1_w_up, ffn1_w_down, mix_norm, w_in,
           rwkv_mu, rwkv_w0, rwkv_w2, rwkv_a0, rwkv_a2, rwkv_g2, rwkv_k_k, rwkv_k_a, rwkv_r_k,
           rwkv_lnx_w, rwkv_lnx_b, gdn_conv_w, gdn_A_log, gdn_dt_bias, gdn_norm_w,
           proj_a, proj_b, w_out, ffn2_norm, ffn2_w_gate, ffn2_w_up, ffn2_w_down):
    dt = x.dtype
    h = x + 0.5 * _swiglu(_rms(x, ffn1_norm), ffn1_w_gate, ffn1_w_up, ffn1_w_down)
    u = _rms(h, mix_norm)
    P = u @ w_in
    pa = P[..., :A_PROJ]
    pb = P[..., A_PROJ:A_PROJ + B_PROJ]
    gate_a = P[..., A_PROJ + B_PROJ:A_PROJ + B_PROJ + D_MODEL]
    gate_b = P[..., A_PROJ + B_PROJ + D_MODEL:]
    oa, rwkv_new, shift_new = _rwkv7(pa, s_shift, s_rwkv, rwkv_mu, rwkv_w0, rwkv_w2, rwkv_a0, rwkv_a2,
                                     rwkv_g2, rwkv_k_k, rwkv_k_a, rwkv_r_k, rwkv_lnx_w, rwkv_lnx_b)
    ob, delta_new, conv_new = _gated_delta_branch(pb, s_conv, s_delta, gdn_conv_w, gdn_A_log,
                                                  gdn_dt_bias, gdn_norm_w)
    merged = (jax.nn.sigmoid(gate_a) * (oa.astype(dt) @ proj_a)
              + jax.nn.sigmoid(gate_b) * (ob.astype(dt) @ proj_b))
    h = h + merged @ w_out
    h = h + 0.5 * _swiglu(_rms(h, ffn2_norm), ffn2_w_gate, ffn2_w_up, ffn2_w_down)
    return h, rwkv_new, shift_new, delta_new, conv_new


def setup_inputs(seed: int = 0) -> dict:
    key = jax.random.key(seed)
    ks = iter(jax.random.split(key, 48))
    L, D = DEPTH, D_MODEL

    def nrm(shape, scale):
        return jax.random.normal(next(ks), shape, F32) * scale

    inp = {}
    inp['x_prompt'] = nrm((BATCH, SEQ, D), 1.0)
    inp['x_sample'] = nrm((DEC_BATCH, DEC_SEQ, D), 1.0)
    inp['state_rwkv'] = nrm((L, DEC_BATCH, A_HEADS, A_HEAD, A_HEAD), 0.5)
    inp['state_rwkv_shift'] = nrm((L, DEC_BATCH, A_PROJ), 1.0)
    inp['state_delta'] = nrm((L, DEC_BATCH, B_HEADS, B_HEAD, B_HEAD), 0.1)
    inp['state_conv'] = nrm((L, DEC_BATCH, CONV_K - 1, CONV_CH), 1.0)
    inp['ffn1_norm'] = 1.0 + nrm((L, D), 0.05)
    inp['ffn1_w_gate'] = nrm((L, D, D_FF), D ** -0.5)
    inp['ffn1_w_up'] = nrm((L, D, D_FF), D ** -0.5)
    inp['ffn1_w_down'] = nrm((L, D_FF, D), D_FF ** -0.5)
    inp['mix_norm'] = 1.0 + nrm((L, D), 0.05)
    inp['w_in'] = nrm((L, D, IN_COLS), D ** -0.5)
    inp['rwkv_mu'] = jax.random.uniform(next(ks), (L, A_PROJ), F32)
    inp['rwkv_w0'] = -0.5 + nrm((L, A_WIDTH), 0.5)
    inp['rwkv_w2'] = nrm((L, A_RANK_W, A_WIDTH), A_RANK_W ** -0.5)
    inp['rwkv_a0'] = nrm((L, A_WIDTH), 0.1)
    inp['rwkv_a2'] = nrm((L, A_RANK_A, A_WIDTH), A_RANK_A ** -0.5)
    inp['rwkv_g2'] = nrm((L, A_RANK_G, A_WIDTH), A_RANK_G ** -0.5)
    inp['rwkv_k_k'] = 0.85 + nrm((L, A_WIDTH), 0.05)
    inp['rwkv_k_a'] = 1.0 + nrm((L, A_WIDTH), 0.05)
    inp['rwkv_r_k'] = nrm((L, A_HEADS, A_HEAD), 0.1)
    inp['rwkv_lnx_w'] = 1.0 + nrm((L, A_WIDTH), 0.05)
    inp['rwkv_lnx_b'] = nrm((L, A_WIDTH), 0.01)
    inp['gdn_conv_w'] = nrm((L, CONV_K, CONV_CH), CONV_K ** -0.5)
    inp['gdn_A_log'] = jnp.log(jax.random.uniform(next(ks), (L, B_HEADS), F32, 1.0, 16.0))
    inp['gdn_dt_bias'] = nrm((L, B_HEADS), 0.1)
    inp['gdn_norm_w'] = 1.0 + nrm((L, B_HEAD), 0.05)
    inp['proj_a'] = nrm((L, A_WIDTH, D), A_WIDTH ** -0.5)
    inp['proj_b'] = nrm((L, B_WIDTH, D), B_WIDTH ** -0.5)
    inp['w_out'] = nrm((L, D, D), D ** -0.5)
    inp['ffn2_norm'] = 1.0 + nrm((L, D), 0.05)
    inp['ffn2_w_gate'] = nrm((L, D, D_FF), D ** -0.5)
    inp['ffn2_w_up'] = nrm((L, D, D_FF), D ** -0.5)
    inp['ffn2_w_down'] = nrm((L, D_FF, D), D_FF ** -0.5)
    inp['final_norm'] = 1.0 + nrm((D,), 0.05)
    return inp


def reference(x_prompt, x_sample, state_rwkv, state_rwkv_shift, state_delta, state_conv,
              ffn1_norm, ffn1_w_gate, ffn1_w_up, ffn1_w_down, mix_norm, w_in,
              rwkv_mu, rwkv_w0, rwkv_w2, rwkv_a0, rwkv_a2, rwkv_g2, rwkv_k_k, rwkv_k_a, rwkv_r_k,
              rwkv_lnx_w, rwkv_lnx_b, gdn_conv_w, gdn_A_log, gdn_dt_bias, gdn_norm_w,
              proj_a, proj_b, w_out, ffn2_norm, ffn2_w_gate, ffn2_w_up, ffn2_w_down, final_norm):
    Bp = x_prompt.shape[0]
    dt = x_prompt.dtype
    zr = jnp.zeros((Bp, A_HEADS, A_HEAD, A_HEAD), dt)
    zs = jnp.zeros((Bp, A_PROJ), dt)
    zd = jnp.zeros((Bp, B_HEADS, B_HEAD, B_HEAD), dt)
    zc = jnp.zeros((Bp, CONV_K - 1, CONV_CH), dt)
    hp, hs = x_prompt, x_sample
    rp, sp, dp, cp = [], [], [], []
    rs, ss, ds, cs = [], [], [], []
    for l in range(DEPTH):
        lp = (ffn1_norm[l], ffn1_w_gate[l], ffn1_w_up[l], ffn1_w_down[l], mix_norm[l], w_in[l],
              rwkv_mu[l], rwkv_w0[l], rwkv_w2[l], rwkv_a0[l], rwkv_a2[l], rwkv_g2[l], rwkv_k_k[l],
              rwkv_k_a[l], rwkv_r_k[l], rwkv_lnx_w[l], rwkv_lnx_b[l], gdn_conv_w[l], gdn_A_log[l],
              gdn_dt_bias[l], gdn_norm_w[l], proj_a[l], proj_b[l], w_out[l],
              ffn2_norm[l], ffn2_w_gate[l], ffn2_w_up[l], ffn2_w_down[l])
        hp, r1, s1, d1, c1 = _layer(hp, zr, zs, zd, zc, *lp)
        hs, r2, s2, d2, c2 = _layer(hs, state_rwkv[l], state_rwkv_shift[l], state_delta[l], state_conv[l], *lp)
        rp.append(r1); sp.append(s1); dp.append(d1); cp.append(c1)
        rs.append(r2); ss.append(s2); ds.append(d2); cs.append(c2)
    y_prompt = _rms(hp, final_norm)
    y_sample = _rms(hs, final_norm)
    return (y_prompt, y_sample,
            jnp.stack(rp), jnp.stack(sp), jnp.stack(dp), jnp.stack(cp),
            jnp.stack(rs), jnp.stack(ss), jnp.stack(ds), jnp.stack(cs))
```

```cpp
#include <hip/hip_runtime.h>
#include <cstdio>
#include <cstdint>

#ifndef MK_N_LAUNCHES
#define MK_N_LAUNCHES 1
#endif

#ifndef PROBE_SCAN2
#define PROBE_SCAN2 0
#endif
#ifndef PROBE_MODE
#define PROBE_MODE 0
#endif
#ifndef PROBE_LREP
#define PROBE_LREP -1
#endif
#ifndef PROBE_REP
#define PROBE_REP -1
#endif
#define LAS __attribute__((address_space(3)))
#define GAS __attribute__((address_space(1)))
typedef unsigned short h16;
typedef _Float16 f16x8 __attribute__((ext_vector_type(8)));
typedef _Float16 f16x4 __attribute__((ext_vector_type(4)));
typedef _Float16 f16x2 __attribute__((ext_vector_type(2)));
typedef _Float16 h2 __attribute__((ext_vector_type(2)));
typedef float f32x4 __attribute__((ext_vector_type(4)));
typedef float f32x2 __attribute__((ext_vector_type(2)));
typedef unsigned u32x4 __attribute__((ext_vector_type(4)));
typedef unsigned u32x2 __attribute__((ext_vector_type(2)));
typedef GAS unsigned gu32;

constexpr int D = 1024, MP = 16384, MS = 512, M = MP + MS, SEQ = 2048, NB_P = 8, NB_S = 128, TS = 4;
constexpr int FF = 2816, APROJ = 1792, CONVCH = 1536;
constexpr int PAQ_W = 3328, Z_W = 512, GT_W = 2048, NIN = PAQ_W + Z_W + GT_W;
constexpr int GT_P = 2112;
constexpr float RMS_EPS = 1e-6f, LNX_EPS = 64e-5f;
constexpr int C_R = 0, C_WD = 512, C_K = 576, C_V = 1088, C_AD = 1600, C_GD = 1664, C_Q = 1792, C_GK = 2304, C_GV = 2816;
constexpr size_t O_Y = 0, O_RWKV_P = 17301504, O_SHIFT_P = 17563648, O_DELTA_P = 17577984, O_CONV_P = 18102272,
                 O_RWKV_S = 18139136, O_SHIFT_S = 22333440, O_DELTA_S = 22562816, O_CONV_S = 30951424, O_END = 31541248;

constexpr size_t MiB = 1u << 20;
constexpr size_t WS_CTL = 0, CTL_ZERO_BYTES = 64 * 1024;
constexpr size_t WS_SSQ0 = 1 * MiB, WS_SSQ1 = WS_SSQ0 + (size_t)M * 64, WS_SSQ2 = WS_SSQ1 + (size_t)M * 64, WS_SSQ3 = WS_SSQ2 + (size_t)M * 64;
constexpr size_t WS_AB = WS_SSQ3 + (size_t)M * 64;
constexpr size_t WS_BON = WS_AB + (size_t)M * 32;
constexpr size_t WS_WAB = WS_BON + (size_t)M * 128;
constexpr size_t WS_W2T = WS_WAB + 32768;
constexpr size_t WS_A2T = WS_W2T + 65536;
constexpr size_t WS_G2T = WS_A2T + 65536;
static_assert(WS_G2T + 131072 <= 8 * MiB, "small arrays");
constexpr size_t WS_A = 8 * MiB;
constexpr size_t WS_WPT = 41 * MiB, WS_WOUTT = 43 * MiB;
constexpr size_t WS_W2UP = 45 * MiB;
constexpr size_t WS_W2DN = 56 * MiB;
constexpr size_t WS_B = 62 * MiB;
constexpr size_t WS_HID = WS_B;
constexpr size_t WS_PAQ = WS_B;
constexpr size_t WS_Z = WS_PAQ + (size_t)M * PAQ_W * 2;
constexpr size_t WS_GT = WS_Z + (size_t)M * Z_W * 2;
constexpr size_t WS_MRG = WS_B;
constexpr size_t WS_END = WS_GT + (size_t)M * GT_P * 2;
static_assert(WS_END <= 256 * MiB, "workspace map");
static_assert(WS_A + (size_t)M * D * 2 <= WS_WPT, "region A");
constexpr size_t DO_W1UP = O_DELTA_S * 4;
constexpr size_t DO_W1DN = DO_W1UP + (size_t)5632 * 1024 * 2;
constexpr size_t DO_WIN = O_RWKV_S * 4;
static_assert(DO_W1DN + (size_t)1024 * 2816 * 2 <= O_CONV_S * 4 && DO_WIN + (size_t)NIN * 1024 * 2 <= O_SHIFT_S * 4, "d_out scratch");

constexpr int NWAVES = 8, NTHREADS = 512;
constexpr int RING_BYTES = 131072, LDSCTL_OFF = RING_BYTES, MISC_OFF = LDSCTL_OFF + 320, LDS_BYTES = 147456;

__device__ __forceinline__ unsigned pkh(float lo, float hi) { f16x2 v; v.x = (_Float16)lo; v.y = (_Float16)hi; return __builtin_bit_cast(unsigned, v); }
__device__ __forceinline__ f32x2 unpk(unsigned u) { f16x2 v = __builtin_bit_cast(f16x2, u); f32x2 r; r.x = (float)v.x; r.y = (float)v.y; return r; }
__device__ __forceinline__ f32x4 unpk4(u32x2 u) { f32x2 a = unpk(u.x), b = unpk(u.y); return (f32x4){a.x, a.y, b.x, b.y}; }
__device__ __forceinline__ float h2f(h16 v) { return (float)__builtin_bit_cast(_Float16, v); }
__device__ __forceinline__ h2 bc2(float x) { const _Float16 h = (_Float16)x; return (h2){h, h}; }
__device__ __forceinline__ h2 u2h(unsigned u) { return __builtin_bit_cast(h2, u); }
__device__ __forceinline__ float fexp(float x) { return __builtin_amdgcn_exp2f(x * 1.44269504089f); }
__device__ __forceinline__ float frcp(float x) { return __builtin_amdgcn_rcpf(x); }
__device__ __forceinline__ float fsigmoid(float x) { return frcp(1.0f + fexp(-x)); }
__device__ __forceinline__ float fsilu(float x) { return x * frcp(1.0f + fexp(-x)); }
__device__ __forceinline__ float ftanh(float x) { return 1.0f - 2.0f * frcp(1.0f + fexp(2.0f * x)); }
template <int CTRL> __device__ __forceinline__ float dppf(float x) { return __builtin_bit_cast(float, __builtin_amdgcn_update_dpp(0, __builtin_bit_cast(int, x), CTRL, 0xF, 0xF, false)); }
__device__ __forceinline__ float row_sum16(float x) { x += dppf<0x128>(x); x += dppf<0x124>(x); x += dppf<0x122>(x); x += dppf<0x121>(x); return x; }
__device__ __forceinline__ float wave_sum(float v) {
#pragma unroll
    for (int o = 1; o < 64; o <<= 1) v += __shfl_xor(v, o);
    return v;
}
#define LDS_WAIT() asm volatile("s_waitcnt lgkmcnt(0)" ::: "memory")
#define VM_WAIT() asm volatile("s_waitcnt vmcnt(0)" ::: "memory")
#define RLX_AGENT __ATOMIC_RELAXED, __HIP_MEMORY_SCOPE_AGENT

namespace pg8 {
constexpr int BM = 256, BK = 64, HALF = 128, HTB = HALF * BK * 2, STAGE_BYTES = 8 * HTB, NXCD = 8, WGM = 8;
__host__ __device__ __forceinline__ int lds_byte(int r, int c) { const int st = (r >> 4) * 2 + (c >> 5), rr = r & 15, cc = c & 31, ob = rr * 64 + cc * 2; return st * 1024 + (ob ^ (((ob >> 9) & 1) << 5)); }
__host__ __device__ __forceinline__ void stage_rc(int b, int& R, int& C) { const int st = b / 1024, sb = b % 1024, swz = sb ^ (((sb >> 9) & 1) << 5); R = (st >> 1) * 16 + swz / 64; C = (st & 1) * 32 + (swz % 64) / 2; }
__host__ __device__ __forceinline__ int perm32(int rho) { const int n = rho >> 4, i = rho & 15; return 8 * (i >> 2) + 4 * n + (i & 3); }

struct Unit { int pm, pn; };
struct Gemm { const h16* A; const h16* Bt; int lda, K; };

struct StaticOrder {
    int nM, nN, nwg, G, c;
    __device__ void init(int Mr, int N, int G_, int c_) { nM = Mr / BM; nN = N / BM; nwg = nM * nN; G = G_; c = c_; }
    __device__ bool next(int i, Unit& u) const {
        const long L = (long)i * G + c; if (L >= nwg) return false;
        int wgid = (int)L; { const int q = nwg / NXCD, r = nwg % NXCD, xcd = wgid % NXCD, off = wgid / NXCD; wgid = (xcd < r ? xcd * (q + 1) : r * (q + 1) + (xcd - r) * q) + off; }
        const int nig = WGM * nN, gid = wgid / nig, fm = gid * WGM, gsz = (nM - fm) < WGM ? (nM - fm) : WGM;
        u.pm = fm + ((wgid % nig) % gsz); u.pn = (wgid % nig) / gsz; return true;
    }
};

struct RowScale {
    const float* ssq; int np;
    __device__ __forceinline__ float operator()(int row) const {
        const f32x4* p = (const f32x4*)(ssq + (size_t)row * 16); float s;
        if (np == 1) s = ssq[(size_t)row * 16];
        else { f32x4 a = p[0], b = p[1], c = p[2], d = p[3]; s = ((a.x + a.y) + (a.z + a.w)) + ((b.x + b.y) + (b.z + b.w)) + ((c.x + c.y) + (c.z + c.w)) + ((d.x + d.y) + (d.z + d.w)); }
        return __builtin_amdgcn_rsqf(s * (1.0f / 1024.0f) + RMS_EPS);
    }
};

struct EpiSwiglu {
    static constexpr bool PERM = true, MID = false;
    h16* O; RowScale rs;
    __device__ __forceinline__ void operator()(const f32x4 (&acc)[2][2][4][2], const Unit& u, int wr, int wc, int fr, int fq) const {
        const int row0 = u.pm * BM + wr * 64 + fr, col0 = u.pn * 128 + wc * 32 + 8 * fq;
#pragma unroll
        for (int ai = 0; ai < 2; ++ai)
#pragma unroll
            for (int m = 0; m < 4; ++m) {
                const int row = row0 + ai * HALF + m * 16; const float s = rs(row);
                float o[8];
#pragma unroll
                for (int n = 0; n < 2; ++n)
#pragma unroll
                    for (int i = 0; i < 4; ++i) { const float g = acc[ai][0][m][n][i] * s, v = acc[ai][1][m][n][i] * s; o[4 * n + i] = fsilu(g) * v; }
                u32x4 w; w.x = pkh(o[0], o[1]); w.y = pkh(o[2], o[3]); w.z = pkh(o[4], o[5]); w.w = pkh(o[6], o[7]);
                *(u32x4*)(O + (size_t)row * FF + col0) = w;
            }
    }
};
struct EpiP {
    static constexpr bool PERM = true, MID = false;
    h16 *paq, *z, *gt; RowScale rs;
    __device__ __forceinline__ void operator()(const f32x4 (&acc)[2][2][4][2], const Unit& u, int wr, int wc, int fr, int fq) const {
        h16* base; int ld, colt;
        if (u.pn < 13) { base = paq; ld = PAQ_W; colt = u.pn * BM; } else if (u.pn < 15) { base = z; ld = Z_W; colt = (u.pn - 13) * BM; } else { base = gt; ld = GT_P; colt = (u.pn - 15) * BM; }
        const int row0 = u.pm * BM + wr * 64 + fr, col0 = colt + wc * 32 + 8 * fq;
#pragma unroll
        for (int ai = 0; ai < 2; ++ai)
#pragma unroll
            for (int m = 0; m < 4; ++m) {
                const int row = row0 + ai * HALF + m * 16; const float s = rs(row);
#pragma unroll
                for (int bj = 0; bj < 2; ++bj) {
                    f32x4 a = acc[ai][bj][m][0] * s, b = acc[ai][bj][m][1] * s;
                    if (u.pn >= 15) {
#pragma unroll
                        for (int i = 0; i < 4; ++i) { a[i] = fmaxf(fsigmoid(a[i]), 1e-7f); b[i] = fmaxf(fsigmoid(b[i]), 1e-7f); }
                    }
                    u32x4 w; w.x = pkh(a.x, a.y); w.y = pkh(a.z, a.w); w.z = pkh(b.x, b.y); w.w = pkh(b.z, b.w);
                    *(u32x4*)(base + (size_t)row * ld + col0 + bj * HALF) = w;
                }
            }
    }
};
struct EpiResid {
    static constexpr bool PERM = false, MID = false;
    const float* base0; const float* base1; int split_row;
    float* out; h16* outh; float* ssq; float alpha;
    __device__ __forceinline__ void operator()(const f32x4 (&acc)[2][2][4][2], const Unit& u, int wr, int wc, int fr, int fq) const {
        const int row0 = u.pm * BM + wr * 64 + fr, col0 = u.pn * BM + wc * 32 + 4 * fq;
#pragma unroll
        for (int ai = 0; ai < 2; ++ai)
#pragma unroll
            for (int m = 0; m < 4; ++m) {
                const int row = row0 + ai * HALF + m * 16;
                const float* bp = (row < split_row) ? base0 + (size_t)row * D : base1 + (size_t)(row - split_row) * D;
                float s = 0.f;
#pragma unroll
                for (int bj = 0; bj < 2; ++bj)
#pragma unroll
                    for (int n = 0; n < 2; ++n) {
                        const int col = col0 + bj * HALF + n * 16;
                        const f32x4 bv = *(const f32x4*)(bp + col); const f32x4 o = bv + acc[ai][bj][m][n] * alpha;
                        *(f32x4*)(out + (size_t)row * D + col) = o;
                        if (outh) { u32x2 w; w.x = pkh(o.x, o.y); w.y = pkh(o.z, o.w); *(u32x2*)(outh + (size_t)row * D + col) = w; }
                        s += (o.x * o.x + o.y * o.y) + (o.z * o.z + o.w * o.w);
                    }
                s += __shfl_xor(s, 16); s += __shfl_xor(s, 32);
                if (fq == 0) ssq[(size_t)row * 16 + u.pn * 4 + wc] = s;
            }
    }
};
struct EpiMerge {
    static constexpr bool PERM = true, MID = true;
    const h16* gt; h16* O; int mid_t;
    __device__ __forceinline__ void mid(f32x4 (&acc)[2][2][4][2], const Unit& u, int wr, int wc, int fr, int fq) const {
        asm volatile("" : "+v"(fr), "+v"(fq));
        const int row0 = u.pm * BM + wr * 64 + fr, col0 = u.pn * BM + wc * 32 + 8 * fq;
#pragma unroll
        for (int ai = 0; ai < 2; ++ai)
#pragma unroll
            for (int m = 0; m < 4; ++m) {
                const h16* gp = gt + (size_t)(row0 + ai * HALF + m * 16) * GT_P + col0;
#pragma unroll
                for (int bj = 0; bj < 2; ++bj) {
                    const u32x4 ga = *(const u32x4*)(gp + bj * HALF), gb = *(const u32x4*)(gp + 1024 + bj * HALF);
                    const f32x4 a0 = unpk4((u32x2){ga.x, ga.y}), a1 = unpk4((u32x2){ga.z, ga.w}), b0 = unpk4((u32x2){gb.x, gb.y}), b1 = unpk4((u32x2){gb.z, gb.w});
                    f32x4 r0, r1;
#pragma unroll
                    for (int i = 0; i < 4; ++i) { r0[i] = a0[i] * frcp(b0[i]); r1[i] = a1[i] * frcp(b1[i]); }
                    acc[ai][bj][m][0] *= r0; acc[ai][bj][m][1] *= r1;
                    asm volatile("" ::: "memory");
                }
            }
    }
    __device__ __forceinline__ void operator()(const f32x4 (&acc)[2][2][4][2], const Unit& u, int wr, int wc, int fr, int fq) const {
        const int row0 = u.pm * BM + wr * 64 + fr, col0 = u.pn * BM + wc * 32 + 8 * fq;
#pragma unroll
        for (int ai = 0; ai < 2; ++ai)
#pragma unroll
            for (int m = 0; m < 4; ++m) {
                const int row = row0 + ai * HALF + m * 16;
                const h16* gp = gt + (size_t)row * GT_P + 1024 + col0;
#pragma unroll
                for (int bj = 0; bj < 2; ++bj) {
                    const u32x4 gb = *(const u32x4*)(gp + bj * HALF);
                    const f32x4 b0 = unpk4((u32x2){gb.x, gb.y}), b1 = unpk4((u32x2){gb.z, gb.w});
                    f32x4 a = acc[ai][bj][m][0], b = acc[ai][bj][m][1];
#pragma unroll
                    for (int i = 0; i < 4; ++i) { a[i] *= b0[i]; b[i] *= b1[i]; }
                    u32x4 w; w.x = pkh(a.x, a.y); w.y = pkh(a.z, a.w); w.z = pkh(b.x, b.y); w.w = pkh(b.z, b.w);
                    *(u32x4*)(O + (size_t)row * D + col0 + bj * HALF) = w;
                }
            }
    }
};

template <class Epi, class Sched>
__device__ __forceinline__ void gemm_phase(LAS unsigned char* lds, const Gemm g, const Sched& S, const Epi& E) {
    const int tid = threadIdx.x, wid = __builtin_amdgcn_readfirstlane(tid >> 6), lane = tid & 63, wr = wid >> 2, wc = wid & 3, fr = lane & 15, fq = lane >> 4;
    const int K = g.K, nt = K / BK, lda = g.lda;
    unsigned voffA[2], voffB[2];
#pragma unroll
    for (int i = 0; i < 2; ++i) { int R, C; stage_rc(tid * 16 + i * 8192, R, C); const int Rb = Epi::PERM ? ((R & ~31) + perm32(R & 31)) : R;
        voffA[i] = (unsigned)(R * lda + C) * 2u; voffB[i] = (unsigned)(Rb * K + C) * 2u; }
    const size_t kstep = (size_t)(BK * 2);
    const size_t hstepA = (size_t)HALF * lda * 2, hstepB = (size_t)HALF * K * 2;
    const size_t tstepA = 2 * hstepA, tstepB = 2 * hstepB;
    const unsigned ldsw = (unsigned)wid * 1024u;
    const int aoff = lds_byte(wr * 64 + fr, fq * 8), boff = lds_byte(wc * 32 + fr, fq * 8);
#define PG8_SA(b, h) (((b) * 2 + (h)) * HTB)
#define PG8_SB(b, h) ((4 + (b) * 2 + (h)) * HTB)
#define PG8_STAGE(bufoff, gbase, voff) do { _Pragma("unroll") for (int _i = 0; _i < 2; ++_i) \
        __builtin_amdgcn_global_load_lds((const unsigned*)((const char*)(gbase) + (voff)[_i]), (LAS unsigned*)(lds + (bufoff) + ldsw + _i * 8192), 16, 0, 0); } while (0)
#define PG8_LDA(dst, b, h) do { _Pragma("unroll") for (int m = 0; m < 4; ++m) _Pragma("unroll") for (int k = 0; k < 2; ++k) dst[m][k] = *(const LAS f16x8*)(lds + PG8_SA(b, h) + aoff + m * 2048 + k * 1024); } while (0)
#define PG8_LDB(dst, b, h) do { _Pragma("unroll") for (int n = 0; n < 2; ++n) _Pragma("unroll") for (int k = 0; k < 2; ++k) dst[n][k] = *(const LAS f16x8*)(lds + PG8_SB(b, h) + boff + n * 2048 + k * 1024); } while (0)
#define PG8_MMA(ai, bj, At, Bt) do { __builtin_amdgcn_s_setprio(1); _Pragma("unroll") for (int m = 0; m < 4; ++m) _Pragma("unroll") for (int n = 0; n < 2; ++n) _Pragma("unroll") for (int k = 0; k < 2; ++k) \
        acc[ai][bj][m][n] = __builtin_amdgcn_mfma_f32_16x16x32_f16(Bt[n][k], At[m][k], acc[ai][bj][m][n], 0, 0, 0); __builtin_amdgcn_s_setprio(0); } while (0)
#define PG8_WAIT_V(n) asm volatile("s_waitcnt vmcnt(" #n ")" ::: "memory")
#define PG8_WAIT_L(n) asm volatile("s_waitcnt lgkmcnt(" #n ")" ::: "memory")
#define PG8_BAR __builtin_amdgcn_s_barrier()
#define PG8_SCHED __builtin_amdgcn_sched_barrier(0)
#define PG8_KBODY \
            const bool last = (t == nt - 2); \
            const char* a1 = cA + (size_t)(t + 1) * kstep; \
            const char* a2 = last ? nA : cA + (size_t)(t + 2) * kstep; const char* b2 = last ? nB : cB + (size_t)(t + 2) * kstep; \
            const char* a3 = a2 + kstep; const char* b3 = b2 + kstep; \
            PG8_LDB(B0, 0, 0); PG8_LDB(B1, 0, 1); PG8_SCHED; PG8_LDA(At, 0, 0); PG8_STAGE(PG8_SA(1, 1), a1 + hstepA, voffA); \
            PG8_WAIT_V(8); PG8_WAIT_L(0); PG8_BAR; PG8_MMA(0, 0, At, B0); PG8_MMA(0, 1, At, B1); PG8_BAR; PG8_SCHED; \
            PG8_LDA(At, 0, 1); PG8_STAGE(PG8_SB(0, 0), b2, voffB); PG8_STAGE(PG8_SB(0, 1), b2 + hstepB, voffB); PG8_STAGE(PG8_SA(0, 0), a2, voffA); \
            PG8_WAIT_V(8); PG8_WAIT_L(0); PG8_BAR; PG8_MMA(1, 0, At, B0); PG8_MMA(1, 1, At, B1); PG8_BAR; PG8_SCHED; \
            PG8_LDB(B0, 1, 0); PG8_LDB(B1, 1, 1); PG8_SCHED; PG8_LDA(At, 1, 0); PG8_STAGE(PG8_SA(0, 1), a2 + hstepA, voffA); \
            PG8_WAIT_V(8); PG8_WAIT_L(0); PG8_BAR; PG8_MMA(0, 0, At, B0); PG8_MMA(0, 1, At, B1); PG8_BAR; PG8_SCHED; \
            PG8_LDA(At, 1, 1); PG8_STAGE(PG8_SB(1, 0), b3, voffB); PG8_STAGE(PG8_SB(1, 1), b3 + hstepB, voffB); PG8_STAGE(PG8_SA(1, 0), a3, voffA); \
            PG8_WAIT_V(8); PG8_WAIT_L(0); PG8_BAR; PG8_MMA(1, 0, At, B0); PG8_MMA(1, 1, At, B1); PG8_BAR; PG8_SCHED;
    Unit cur, nxt; int ui = 0;
    if (!S.next(0, cur)) return;
    f32x4 acc[2][2][4][2];
#pragma unroll
    for (int a = 0; a < 2; ++a)
#pragma unroll
        for (int b = 0; b < 2; ++b)
#pragma unroll
            for (int m = 0; m < 4; ++m)
#pragma unroll
                for (int n = 0; n < 2; ++n) acc[a][b][m][n] = (f32x4){0.f, 0.f, 0.f, 0.f};
    f16x8 At[4][2], B0[2][2], B1[2][2];
    const char* cA = (const char*)g.A + (size_t)cur.pm * tstepA; const char* cB = (const char*)g.Bt + (size_t)cur.pn * tstepB;
    PG8_STAGE(PG8_SB(0, 0), cB, voffB); PG8_STAGE(PG8_SB(0, 1), cB + hstepB, voffB); PG8_STAGE(PG8_SA(0, 0), cA, voffA); PG8_STAGE(PG8_SA(0, 1), cA + hstepA, voffA);
    if (wr == 1) PG8_BAR;
    PG8_WAIT_V(2); PG8_BAR;
    PG8_STAGE(PG8_SB(1, 0), cB + kstep, voffB); PG8_STAGE(PG8_SA(1, 0), cA + kstep, voffA); PG8_STAGE(PG8_SB(1, 1), cB + hstepB + kstep, voffB);
    PG8_WAIT_V(6); PG8_BAR;
    for (;;) {
        const bool has_next = S.next(ui + 1, nxt);
        const char* nA = has_next ? (const char*)g.A + (size_t)nxt.pm * tstepA : cA; const char* nB = has_next ? (const char*)g.Bt + (size_t)nxt.pn * tstepB : cB;
        if constexpr (Epi::MID) {
            for (int t = 0; t < E.mid_t; t += 2) { PG8_KBODY }
            E.mid(acc, cur, wr, wc, fr, fq); PG8_SCHED;
            for (int t = E.mid_t; t < nt; t += 2) { PG8_KBODY }
        } else {
            for (int t = 0; t < nt; t += 2) { PG8_KBODY }
        }
        if (wr == 0) PG8_BAR;
        E(acc, cur, wr, wc, fr, fq);
        if (!has_next) break;
#pragma unroll
        for (int a = 0; a < 2; ++a)
#pragma unroll
            for (int b = 0; b < 2; ++b)
#pragma unroll
                for (int m = 0; m < 4; ++m)
#pragma unroll
                    for (int n = 0; n < 2; ++n) acc[a][b][m][n] = (f32x4){0.f, 0.f, 0.f, 0.f};
        cur = nxt; cA = nA; cB = nB; ++ui;
        if (wr == 1) PG8_BAR;
    }
    PG8_WAIT_V(0);
    PG8_BAR;
#undef PG8_KBODY
#undef PG8_SA
#undef PG8_SB
#undef PG8_STAGE
#undef PG8_LDA
#undef PG8_LDB
#undef PG8_MMA
#undef PG8_WAIT_V
#undef PG8_WAIT_L
#undef PG8_BAR
#undef PG8_SCHED
}
}

struct SResid {
    const float* base; float* out; h16* outh; float* ssq; float alpha;
    __device__ __forceinline__ void operator()(f32x4 sa, f32x4 sb, int row, int col, int pc, int t) const {
        const f32x4 bv = *(const f32x4*)(base + (size_t)row * D + col); const f32x4 o = bv + (sa + sb) * alpha;
        *(f32x4*)(out + (size_t)row * D + col) = o;
        if (outh) { u32x2 w; w.x = pkh(o.x, o.y); w.y = pkh(o.z, o.w); *(u32x2*)(outh + (size_t)row * D + col) = w; }
        float s = (o.x * o.x + o.y * o.y) + (o.z * o.z + o.w * o.w);
        s = row_sum16(s);
        if ((t & 15) == 0) ssq[(size_t)row * 16 + pc] = s;
    }
};
struct SMerge {
    const h16* gt; h16* O;
    __device__ __forceinline__ void operator()(f32x4 sa, f32x4 sb, int row, int col, int pc, int t) const {
        const f32x4 ga = unpk4(*(const u32x2*)(gt + (size_t)row * GT_P + col)), gb = unpk4(*(const u32x2*)(gt + (size_t)row * GT_P + 1024 + col));
        const f32x4 o = ga * sa + gb * sb;
        u32x2 w; w.x = pkh(o.x, o.y); w.y = pkh(o.z, o.w); *(u32x2*)(O + (size_t)row * D + col) = w;
    }
};
template <class SE>
__device__ __forceinline__ void sample_gemm(LAS unsigned char* lds, const h16* A, int lda, const h16* Bt, int K, const SE& E, int piece, int tid) {
    const int w = __builtin_amdgcn_readfirstlane(tid >> 6), lane = tid & 63, n = lane & 15, q = lane >> 4;
    const int pr = piece >> 4, pc = piece & 15, kw = K >> 3, kbeg = w * kw;
    f32x4 acc[2][4];
#pragma unroll
    for (int m = 0; m < 2; ++m)
#pragma unroll
        for (int nn = 0; nn < 4; ++nn) acc[m][nn] = (f32x4){0.f, 0.f, 0.f, 0.f};
    const h16* ap = A + (size_t)(MP + 32 * pr + n) * lda + kbeg + 8 * q;
    const h16* bp = Bt + (size_t)(64 * pc + n) * K + kbeg + 8 * q;
#pragma unroll 4
    for (int k0 = 0; k0 < kw; k0 += 32) {
        f16x8 av[2], bv[4];
#pragma unroll
        for (int m = 0; m < 2; ++m) av[m] = *(const f16x8*)(ap + (size_t)(16 * m) * lda + k0);
#pragma unroll
        for (int nn = 0; nn < 4; ++nn) bv[nn] = *(const f16x8*)(bp + (size_t)(16 * nn) * K + k0);
#pragma unroll
        for (int m = 0; m < 2; ++m)
#pragma unroll
            for (int nn = 0; nn < 4; ++nn) acc[m][nn] = __builtin_amdgcn_mfma_f32_16x16x32_f16(av[m], bv[nn], acc[m][nn], 0, 0, 0);
    }
    LAS float* P = (LAS float*)lds + w * 2048;
#pragma unroll
    for (int m = 0; m < 2; ++m)
#pragma unroll
        for (int nn = 0; nn < 4; ++nn)
#pragma unroll
            for (int i = 0; i < 4; ++i) P[(16 * m + 4 * q + i) * 64 + 16 * nn + n] = acc[m][nn][i];
    LDS_WAIT(); __builtin_amdgcn_s_barrier(); asm volatile("" ::: "memory");
    const int r = tid >> 4, c4 = (tid & 15) * 4;
    const LAS float* Q = (const LAS float*)lds + r * 64 + c4;
    f32x4 sa = *(const LAS f32x4*)(Q), sb = *(const LAS f32x4*)(Q + 4 * 2048);
#pragma unroll
    for (int ww = 1; ww < 4; ++ww) { sa += *(const LAS f32x4*)(Q + ww * 2048); sb += *(const LAS f32x4*)(Q + (4 + ww) * 2048); }
    E(sa, sb, MP + 32 * pr + r, 64 * pc + c4, pc, tid);
    LDS_WAIT(); __builtin_amdgcn_s_barrier(); asm volatile("" ::: "memory");
}

#define XB_TMO      128
#define XB_XCNT(j)  (256  + 64 * (j))
#define XB_XSUB(j)  (1280 + 64 * (j))
#define XB_XGEN(j)  (2304 + 64 * (j))
#define XB_TOP      3328
#define XB_TOPGEN   3392
#define XCD_BAR_WORDS 3456
#define XB_SPIN_CAP (1u << 18)
__device__ __forceinline__ unsigned xb_ld(unsigned* p)              { return __hip_atomic_load(p, __ATOMIC_RELAXED, __HIP_MEMORY_SCOPE_AGENT); }
__device__ __forceinline__ unsigned xb_add(unsigned* p, unsigned v) { return __hip_atomic_fetch_add(p, v, __ATOMIC_RELAXED, __HIP_MEMORY_SCOPE_AGENT); }
__device__ __forceinline__ unsigned xb_xcc_id() { return (unsigned)__builtin_amdgcn_s_getreg((3 << 11) | 20) & 0xFu; }
#define XB_SPIN(cond, bar) do { unsigned _sp = 0; while (cond) { __builtin_amdgcn_s_sleep(1); \
    if ((++_sp & 255u) == 0u) { if (xb_ld(&(bar)[XB_TMO])) break; if (_sp > XB_SPIN_CAP) { atomicAdd(&(bar)[XB_TMO], 1u); break; } } } } while (0)
struct XcdBarrier { unsigned* bar; unsigned x; volatile LAS unsigned* st; };
__device__ __forceinline__ XcdBarrier xcd_barrier_post(unsigned* bar, volatile LAS unsigned* st) {
    XcdBarrier b; b.bar = bar; b.x = xb_xcc_id(); b.st = st;
    if (threadIdx.x == 0) (void)xb_add(&bar[XB_XCNT(b.x)], 1u);
    return b;
}
__device__ __forceinline__ void xcd_barrier_complete(unsigned* bar, unsigned x, unsigned& nloc, unsigned& nx) {
    const unsigned G = gridDim.x * gridDim.y * gridDim.z;
    unsigned sum, cnt, mine, sp = 0u;
    for (;;) {
        sum = 0u; cnt = 0u; mine = 0u;
#pragma unroll
        for (unsigned j = 0; j < 16; ++j) { const unsigned c = xb_ld(&bar[XB_XCNT(j)]); sum += c; cnt += (c > 0u) ? 1u : 0u; mine = (j == x) ? c : mine; }
        if (sum == G) break;
        __builtin_amdgcn_s_sleep(1);
        if ((++sp & 255u) == 0u) { if (xb_ld(&bar[XB_TMO])) break; if (sp > XB_SPIN_CAP) { atomicAdd(&bar[XB_TMO], 1u); break; } }
    }
    nloc = mine > 0u ? mine : 1u; nx = cnt > 0u ? cnt : 1u;
}
__device__ __forceinline__ void xcd_barrier(const XcdBarrier& b) {
    asm volatile("s_waitcnt vmcnt(0)" ::: "memory");
    __syncthreads();
    if (threadIdx.x == 0) {
        unsigned* bar = b.bar;
        __builtin_amdgcn_s_waitcnt(0);
        unsigned nloc = b.st[0], nx = b.st[1];
        if (nloc == 0u) { xcd_barrier_complete(bar, b.x, nloc, nx); b.st[0] = nloc; b.st[1] = nx; }
        const unsigned old = xb_add(&bar[XB_XSUB(b.x)], 1u);
        const unsigned gen = old / nloc;
        if (old + 1u == (gen + 1u) * nloc) {
            __builtin_amdgcn_fence(__ATOMIC_RELEASE, "agent");
            asm volatile("s_waitcnt vmcnt(0)" ::: "memory");
            const unsigned og = xb_add(&bar[XB_TOP], 1u);
            const unsigned tg = og / nx;
            if (og + 1u == (tg + 1u) * nx) xb_add(&bar[XB_TOPGEN], 1u);
            else XB_SPIN(xb_ld(&bar[XB_TOPGEN]) == tg, bar);
            __builtin_amdgcn_fence(__ATOMIC_ACQUIRE, "agent");
            xb_add(&bar[XB_XGEN(b.x)], 1u);
            asm volatile("s_waitcnt vmcnt(0)" ::: "memory");
        } else {
            XB_SPIN(xb_ld(&bar[XB_XGEN(b.x)]) == gen, bar);
            __builtin_amdgcn_fence(__ATOMIC_ACQUIRE, "agent");
            asm volatile("s_waitcnt vmcnt(0)" ::: "memory");
        }
    }
    __syncthreads();
}

struct Args { const float* in[35]; float* out; unsigned char* ws; int ph_lo, ph_hi, li, pad; };
typedef const Args __attribute__((address_space(4)))* KArgs;

struct Frame {
    LAS unsigned char* lds; int tid, lane, wave, G, bx;
};

__device__ __forceinline__ void tr_item(const float* W, int ldw, int k0, int src_col0, const float* kscale, h16* WT, int ldwt, int dst_row0, int dst_k0, LAS float* scr, int lane) {
    float vv[32];
#pragma unroll
    for (int i = 0; i < 32; ++i) { const int kk = 2 * i + (lane >> 5); vv[i] = W[(size_t)(k0 + kk) * ldw + src_col0 + (lane & 31)]; }
    if (kscale) {
#pragma unroll
        for (int i = 0; i < 32; ++i) vv[i] *= kscale[k0 + 2 * i + (lane >> 5)];
    }
#pragma unroll
    for (int i = 0; i < 32; ++i) { const int kk = 2 * i + (lane >> 5); scr[kk * 33 + (lane & 31)] = vv[i]; }
    LDS_WAIT(); asm volatile("" ::: "memory");
    const int c = lane & 7;
#pragma unroll
    for (int j = 0; j < 4; ++j) { const int n = (lane >> 3) + 8 * j; const LAS float* s = scr + (8 * c) * 33 + n;
        u32x4 o; o.x = pkh(s[0 * 33], s[1 * 33]); o.y = pkh(s[2 * 33], s[3 * 33]); o.z = pkh(s[4 * 33], s[5 * 33]); o.w = pkh(s[6 * 33], s[7 * 33]);
        *(u32x4*)(WT + (size_t)(dst_row0 + n) * ldwt + dst_k0 + 8 * c) = o; }
    LDS_WAIT(); asm volatile("" ::: "memory");
}
__device__ __forceinline__ void tr_up_item(const float* Wg, const float* Wu, const float* nrm, h16* WT, int item, LAS float* scr, int lane) {
    const int nblk = 5632 / 32, kb = item / nblk, nb = item % nblk, d0 = nb * 32, pn = d0 >> 8, j0 = d0 & 255;
    const float* src = (j0 < 128) ? Wg : Wu; const int col = 128 * pn + (j0 & 127);
    tr_item(src, FF, 64 * kb, col, nrm, WT, D, d0, 64 * kb, scr, lane);
}
__device__ __forceinline__ void p0_prologue(KArgs a, Frame& F) {
    unsigned char* ws = a->ws; unsigned char* dob = (unsigned char*)a->out;
    LAS float* scr = (LAS float*)(F.lds + F.wave * 16384);
    const int gw = F.bx * NWAVES + F.wave, NGW = F.G * NWAVES;
    constexpr int I_UP = 16 * 176, I_DN = 44 * 32, I_IN = 16 * 184;
    constexpr int NITEMS = I_UP + I_DN + I_IN;
    for (int it = gw; it < NITEMS; it += NGW) {
        int r = it;
        if (r < I_UP) { tr_up_item(a->in[7], a->in[8], a->in[6], (h16*)(dob + DO_W1UP), r, scr, F.lane); continue; } r -= I_UP;
        if (r < I_DN) { const int kb = r / 32, nb = r % 32; tr_item(a->in[9], D, 64 * kb, 32 * nb, nullptr, (h16*)(dob + DO_W1DN), FF, 32 * nb, 64 * kb, scr, F.lane); continue; } r -= I_DN;
        { const int kb = r / 184, nb = r % 184, d0 = 32 * nb; tr_item(a->in[11], 5896, 64 * kb, d0 + (d0 >= PAQ_W ? 8 : 0), a->in[10], (h16*)(dob + DO_WIN), D, d0, 64 * kb, scr, F.lane); }
    }
    {
        const int gt = F.bx * NTHREADS + F.tid, NGT = F.G * NTHREADS;
        h16* wab = (h16*)(ws + WS_WAB); h16* w2t = (h16*)(ws + WS_W2T); h16* a2t = (h16*)(ws + WS_A2T); h16* g2t = (h16*)(ws + WS_G2T);
        for (int i = gt; i < 16 * 1024; i += NGT) { const int j = i >> 10, k = i & 1023; const float v = (j < 8) ? a->in[11][(size_t)k * 5896 + PAQ_W + j] * a->in[10][k] : 0.f; wab[i] = __builtin_bit_cast(h16, (_Float16)v); }
        for (int i = gt; i < 512 * 64; i += NGT) { const int n = i >> 6, k = i & 63; w2t[i] = __builtin_bit_cast(h16, (_Float16)a->in[14][k * 512 + n]); a2t[i] = __builtin_bit_cast(h16, (_Float16)a->in[16][k * 512 + n]); }
        for (int i = gt; i < 512 * 128; i += NGT) { const int n = i >> 7, k = i & 127; g2t[i] = __builtin_bit_cast(h16, (_Float16)a->in[17][k * 512 + n]); }
    }
    h16* xh = (h16*)(ws + WS_A); float* ssq0 = (float*)(ws + WS_SSQ0);
    for (int m0 = gw; m0 < M; m0 += 4 * NGW) {
        f32x4 v[4][4];
#pragma unroll
        for (int r = 0; r < 4; ++r) { const int m = m0 + r * NGW; if (m < M) { const float* xrow = (m < MP) ? a->in[0] + (size_t)m * D : a->in[1] + (size_t)(m - MP) * D; const f32x4* xr = (const f32x4*)xrow + F.lane;
#pragma unroll
            for (int j = 0; j < 4; ++j) v[r][j] = xr[64 * j]; } }
#pragma unroll
        for (int r = 0; r < 4; ++r) { const int m = m0 + r * NGW; if (m < M) { u32x2* o8 = (u32x2*)(xh + (size_t)m * D) + F.lane; float s = 0.f;
#pragma unroll
            for (int j = 0; j < 4; ++j) { const f32x4 t = v[r][j]; s += (t.x * t.x + t.y * t.y) + (t.z * t.z + t.w * t.w); u32x2 w; w.x = pkh(t.x, t.y); w.y = pkh(t.z, t.w); o8[64 * j] = w; }
            s = wave_sum(s);
            if (F.lane == 0) ssq0[(size_t)m * 16] = s; } }
    }
}

__device__ __forceinline__ void ab_gemv(KArgs a, Frame& F) {
    const h16* hh = (const h16*)(a->ws + WS_A); const h16* wab = (const h16*)(a->ws + WS_WAB); float* ab = (float*)(a->ws + WS_AB);
    pg8::RowScale rs{(const float*)(a->ws + WS_SSQ1), 16};
    const int gw = F.bx * NWAVES + F.wave, NGW = F.G * NWAVES, n = F.lane & 15, q = F.lane >> 4;
    for (int tile = gw; tile < M / 16; tile += NGW) {
        const h16* ap = hh + (size_t)(tile * 16 + n) * D + 8 * q; const h16* bp = wab + (size_t)n * D + 8 * q;
        f32x4 acc0 = (f32x4){0.f, 0.f, 0.f, 0.f}, acc1 = acc0;
#pragma unroll 8
        for (int st = 0; st < 32; st += 2) {
            const f16x8 a0 = *(const f16x8*)(ap + 32 * st), b0 = *(const f16x8*)(bp + 32 * st), a1 = *(const f16x8*)(ap + 32 * st + 32), b1 = *(const f16x8*)(bp + 32 * st + 32);
            acc0 = __builtin_amdgcn_mfma_f32_16x16x32_f16(a0, b0, acc0, 0, 0, 0); acc1 = __builtin_amdgcn_mfma_f32_16x16x32_f16(a1, b1, acc1, 0, 0, 0);
        }
        if (n < 8) {
#pragma unroll
            for (int i = 0; i < 4; ++i) { const int row = tile * 16 + 4 * q + i; ab[(size_t)row * 8 + n] = (acc0[i] + acc1[i]) * rs(row); }
        }
    }
}

__device__ __forceinline__ void gdn_prep(KArgs a, Frame& F) {
    const h16* PAQ = (const h16*)(a->ws + WS_PAQ); h16* QK = (h16*)(a->ws + WS_A);
    const float* cwp = a->in[23];
    const int lane = F.lane, arr = lane >> 5, c4 = (lane & 31) * 4;
    const int gw = F.bx * NWAVES + F.wave, NGW = F.G * NWAVES;
    for (int item = gw; item < (M / 4) * 4; item += NGW) {
        const int hh = item & 3, run = item >> 2, row0 = 4 * run;
        const int qcol = (arr ? C_GK : C_Q) + hh * 128 + c4, qch = qcol - C_Q;
        f32x4 cwq[4];
#pragma unroll
        for (int i = 0; i < 4; ++i) cwq[i] = *(const f32x4*)(cwp + i * CONVCH + qch);
        const float qscale = arr ? 1.0f : 0.08838834764831845f;
        const h16* pq = PAQ + (size_t)row0 * PAQ_W + qcol;
        f32x4 w0, w1, w2;
        if (row0 >= MP) { const float* sc = a->in[5] + (size_t)((row0 - MP) >> 2) * 3 * CONVCH + qch; w0 = *(const f32x4*)sc; w1 = *(const f32x4*)(sc + CONVCH); w2 = *(const f32x4*)(sc + 2 * CONVCH); }
        else if ((row0 & (SEQ - 1)) == 0) { w0 = w1 = w2 = (f32x4){0.f, 0.f, 0.f, 0.f}; }
        else { w0 = unpk4(*(const u32x2*)(pq - 3 * PAQ_W)); w1 = unpk4(*(const u32x2*)(pq - 2 * PAQ_W)); w2 = unpk4(*(const u32x2*)(pq - PAQ_W)); }
        f32x4 xs[4];
#pragma unroll
        for (int i = 0; i < 4; ++i) xs[i] = unpk4(*(const u32x2*)(pq + (size_t)i * PAQ_W));
#pragma unroll
        for (int i = 0; i < 4; ++i) {
            f32x4 cv = w0 * cwq[0] + w1 * cwq[1] + w2 * cwq[2] + xs[i] * cwq[3];
            cv.x = fsilu(cv.x); cv.y = fsilu(cv.y); cv.z = fsilu(cv.z); cv.w = fsilu(cv.w);
            float ss = (cv.x * cv.x + cv.y * cv.y) + (cv.z * cv.z + cv.w * cv.w);
            ss = row_sum16(ss); ss += __shfl_xor(ss, 16);
            const float sc = __builtin_amdgcn_rsqf(ss + 1e-6f) * qscale;
            cv = cv * sc;
            u32x2 o; o.x = pkh(cv.x, cv.y); o.y = pkh(cv.z, cv.w);
            *(u32x2*)(QK + (size_t)(row0 + i) * D + arr * 512 + hh * 128 + c4) = o;
            w0 = w1; w1 = w2; w2 = xs[i];
        }
    }
    const int gt = F.bx * NTHREADS + F.tid, NGT = F.G * NTHREADS;
    for (int i = gt; i < NB_P * APROJ; i += NGT) { const int bb = i / APROJ, cc = i % APROJ; a->out[O_SHIFT_P + i] = h2f(PAQ[(size_t)(bb * SEQ + SEQ - 1) * PAQ_W + cc]); }
    for (int i = gt; i < NB_S * APROJ; i += NGT) { const int bb = i / APROJ, cc = i % APROJ; a->out[O_SHIFT_S + i] = h2f(PAQ[(size_t)(MP + bb * TS + TS - 1) * PAQ_W + cc]); }
    for (int i = gt; i < NB_P * 3 * CONVCH; i += NGT) { const int bb = i / (3 * CONVCH), r = (i / CONVCH) % 3, cc = i % CONVCH; a->out[O_CONV_P + i] = h2f(PAQ[(size_t)(bb * SEQ + SEQ - 3 + r) * PAQ_W + C_Q + cc]); }
    for (int i = gt; i < NB_S * 3 * CONVCH; i += NGT) { const int bb = i / (3 * CONVCH), r = (i / CONVCH) % 3, cc = i % CONVCH; a->out[O_CONV_S + i] = h2f(PAQ[(size_t)(MP + bb * TS + 1 + r) * PAQ_W + C_Q + cc]); }
}

constexpr int NBLK_P = SEQ / 16, NBLK = NBLK_P + 4;
constexpr int RX_BYTES = 8192, RY_BYTES = 12288, GY_BYTES = 10752;
constexpr int R_X = 0, R_Y = R_X + 2 * RX_BYTES, G_Y = 0;
static_assert(R_Y + 3 * RY_BYTES <= RING_BYTES && G_Y + 2 * GY_BYTES <= RING_BYTES, "scan LDS");

__device__ __forceinline__ int blk_row0(int j, int b, int sgrp) { return (j < NBLK_P) ? b * SEQ + 16 * j : MP + 16 * (4 * sgrp + (j - NBLK_P)); }
#define WG_BAR() do { asm volatile("s_waitcnt lgkmcnt(0)" ::: "memory"); __builtin_amdgcn_s_barrier(); asm volatile("" ::: "memory"); } while (0)

struct RwkvPre { u32x2 cr, cw, ck, ca, pr, pw, pk, pa; };
struct RwkvOps { u32x2 r, d, k, q, b; unsigned v; };
__device__ __forceinline__ RwkvOps rwkv_ld(const LAS unsigned char* Y, int s, int kq, int vi) {
    RwkvOps o; const LAS unsigned char* p = Y + s * 128 + kq * 8;
    o.r = *(const LAS u32x2*)(p); o.d = *(const LAS u32x2*)(p + 2048); o.k = *(const LAS u32x2*)(p + 4096); o.q = *(const LAS u32x2*)(p + 6144); o.b = *(const LAS u32x2*)(p + 8192);
    o.v = *(const LAS unsigned*)(Y + 10240 + s * 128 + vi * 4);
    return o;
}
__device__ __forceinline__ float rwkv_step(h2& S0, h2& S1, const RwkvOps& p) {
    float sa = __builtin_amdgcn_fdot2(S0, u2h(p.q.x), 0.f, false); sa = __builtin_amdgcn_fdot2(S1, u2h(p.q.y), sa, false);
    sa = -row_sum16(sa);
    const h2 sah = bc2(sa), vv = u2h(p.v);
    S0 = __builtin_elementwise_fma(S0, u2h(p.d.x), __builtin_elementwise_fma(vv, u2h(p.k.x), sah * u2h(p.b.x)));
    S1 = __builtin_elementwise_fma(S1, u2h(p.d.y), __builtin_elementwise_fma(vv, u2h(p.k.y), sah * u2h(p.b.y)));
    float o = __builtin_amdgcn_fdot2(S0, u2h(p.r.x), 0.f, false); o = __builtin_amdgcn_fdot2(S1, u2h(p.r.y), o, false);
    return row_sum16(o);
}

__device__ __forceinline__ void rwkv_role(KArgs a, Frame& F, int c, int mode) {
    const bool do_stage = (mode != 6), do_scan = (mode != 5), do_write = (mode < 3);
    const int w = F.wave, lane = F.lane;
    const int b = c >> 4, h = (c >> 1) & 7, half = c & 1;
    const h16* PAQ = (const h16*)(a->ws + WS_PAQ); h16* OB = (h16*)(a->ws + WS_PAQ) + C_Q; float* bon = (float*)(a->ws + WS_BON);
    const float* mu = a->in[12];
    LAS unsigned char* lds = F.lds;
    const int tsl = lane >> 4, kq = lane & 15;
    const int rwA = w & 3;
    const f32x4 mu_r = *(const f32x4*)(mu + C_R + h * 64 + 4 * kq), mu_w = *(const f32x4*)(mu + C_WD + 4 * kq), mu_k = *(const f32x4*)(mu + C_K + h * 64 + 4 * kq), mu_a = *(const f32x4*)(mu + C_AD + 4 * kq);
    const f32x4 kkw = *(const f32x4*)(a->in[18] + h * 64 + 4 * kq);
    const int o_r = C_R + h * 64 + 4 * kq, o_w = C_WD + 4 * kq, o_k = C_K + h * 64 + 4 * kq, o_a = C_AD + 4 * kq;
    const int sA = 4 * rwA + tsl;
    const int sVv = 2 * w + (lane >> 5), vloc = lane & 31, vcolp = C_V + h * 64 + 32 * half + vloc; const float mu_v = mu[vcolp];
    const int kb = 16 * rwA + kq;
    const float w0b = a->in[13][h * 64 + kb], a0b = a->in[15][h * 64 + kb], kab = a->in[19][h * 64 + kb], rkb = a->in[20][h * 64 + kb];
    f16x8 w2f[2], a2f[2];
    { const h16* w2t = (const h16*)(a->ws + WS_W2T) + (size_t)(h * 64 + kb) * 64 + 8 * tsl; const h16* a2t = (const h16*)(a->ws + WS_A2T) + (size_t)(h * 64 + kb) * 64 + 8 * tsl;
      w2f[0] = *(const f16x8*)w2t; w2f[1] = *(const f16x8*)(w2t + 32); a2f[0] = *(const f16x8*)a2t; a2f[1] = *(const f16x8*)(a2t + 32); }
    const int vi = 4 * w + tsl, vrow = 32 * half + vi;
    h2 S0 = (h2){0, 0}, S1 = (h2){0, 0};
    const int sgrp = b;

#define RW_PREFETCH(j) do { const int row_ = b * SEQ + 16 * (j) + sA; const h16* pc_ = PAQ + (size_t)row_ * PAQ_W; const h16* pp_ = pc_ - (((j) == 0 && sA == 0) ? 0 : PAQ_W); \
        pre.cr = *(const u32x2*)(pc_ + o_r); pre.cw = *(const u32x2*)(pc_ + o_w); pre.ck = *(const u32x2*)(pc_ + o_k); pre.ca = *(const u32x2*)(pc_ + o_a); \
        pre.pr = *(const u32x2*)(pp_ + o_r); pre.pw = *(const u32x2*)(pp_ + o_w); pre.pk = *(const u32x2*)(pp_ + o_k); pre.pa = *(const u32x2*)(pp_ + o_a); } while (0)
#define RW_STAGE_A(j, cr, cw, ck, ca, pr, pw, pk, pa) do { \
        LAS unsigned char* X_ = lds + R_X + ((j) & 1) * RX_BYTES; LAS unsigned char* Y_ = lds + R_Y + ((j) % 3) * RY_BYTES; \
        const f32x4 r_ = cr + (pr - cr) * mu_r, w_ = cw + (pw - cw) * mu_w, k_ = ck + (pk - ck) * mu_k, a_ = ca + (pa - ca) * mu_a; \
        { u32x2 t_; t_.x = pkh(r_.x, r_.y); t_.y = pkh(r_.z, r_.w); *(LAS u32x2*)(Y_ + 0 + sA * 128 + kq * 8) = t_; } \
        { u32x2 t_; t_.x = pkh(ftanh(w_.x), ftanh(w_.y)); t_.y = pkh(ftanh(w_.z), ftanh(w_.w)); *(LAS u32x2*)(X_ + 0 + sA * 128 + kq * 8) = t_; } \
        { u32x2 t_; t_.x = pkh(a_.x, a_.y); t_.y = pkh(a_.z, a_.w); *(LAS u32x2*)(X_ + 2048 + sA * 128 + kq * 8) = t_; } \
        *(LAS f32x4*)(X_ + 4096 + sA * 256 + kq * 16) = k_; \
        const f32x4 kkr_ = k_ * kkw; \
        float ss_ = (kkr_.x * kkr_.x + kkr_.y * kkr_.y) + (kkr_.z * kkr_.z + kkr_.w * kkr_.w); \
        ss_ = row_sum16(ss_); \
        const float inv_ = frcp(fmaxf(__builtin_amdgcn_sqrtf(ss_), 1e-12f)); \
        { const f32x4 kn_ = kkr_ * inv_; u32x2 t_; t_.x = pkh(kn_.x, kn_.y); t_.y = pkh(kn_.z, kn_.w); *(LAS u32x2*)(Y_ + 6144 + sA * 128 + kq * 8) = t_; } } while (0)
#define RW_STAGE_V(j, cv, pv) do { LAS unsigned char* Y_ = lds + R_Y + ((j) % 3) * RY_BYTES; \
        const float vl_ = (cv) + ((pv) - (cv)) * mu_v; *(LAS unsigned*)(Y_ + 10240 + sVv * 128 + vloc * 4) = pkh(vl_, vl_); } while (0)
#define RW_STAGE_B(j) do { \
        LAS unsigned char* X_ = lds + R_X + ((j) & 1) * RX_BYTES; LAS unsigned char* Y_ = lds + R_Y + ((j) % 3) * RY_BYTES; \
        f32x4 wacc_ = (f32x4){0.f, 0.f, 0.f, 0.f}, aacc_ = (f32x4){0.f, 0.f, 0.f, 0.f}; \
        _Pragma("unroll") for (int st_ = 0; st_ < 2; ++st_) { \
            const f16x8 ta_ = *(const LAS f16x8*)(X_ + 0 + kq * 128 + tsl * 16 + st_ * 64); \
            const f16x8 aa_ = *(const LAS f16x8*)(X_ + 2048 + kq * 128 + tsl * 16 + st_ * 64); \
            wacc_ = __builtin_amdgcn_mfma_f32_16x16x32_f16(ta_, w2f[st_], wacc_, 0, 0, 0); \
            aacc_ = __builtin_amdgcn_mfma_f32_16x16x32_f16(aa_, a2f[st_], aacc_, 0, 0, 0); } \
        const int row0_ = blk_row0((j), b, sgrp); \
        _Pragma("unroll") for (int i_ = 0; i_ < 4; ++i_) { \
            const int s_ = 4 * tsl + i_; \
            const float dd_ = fexp(-0.60653065971f * fsigmoid(w0b + wacc_[i_])); \
            const float av_ = fsigmoid(a0b + aacc_[i_]); \
            const float kr_ = *(const LAS float*)(X_ + 4096 + s_ * 256 + kb * 4); \
            const float kkv_ = h2f(*(const LAS h16*)(Y_ + 6144 + s_ * 128 + kb * 2)); \
            const float rv_ = h2f(*(const LAS h16*)(Y_ + 0 + s_ * 128 + kb * 2)); \
            const float kp_ = kr_ * (1.0f + (av_ - 1.0f) * kab); \
            *(LAS h16*)(Y_ + 2048 + s_ * 128 + kb * 2) = __builtin_bit_cast(h16, (_Float16)dd_); \
            *(LAS h16*)(Y_ + 4096 + s_ * 128 + kb * 2) = __builtin_bit_cast(h16, (_Float16)kp_); \
            *(LAS h16*)(Y_ + 8192 + s_ * 128 + kb * 2) = __builtin_bit_cast(h16, (_Float16)(kkv_ * av_)); \
            const float bp_ = row_sum16(rv_ * kp_ * rkb); \
            if (do_write && half == 0 && kq == 0) bon[(size_t)(row0_ + s_) * 32 + h * 4 + rwA] = bp_; } } while (0)

    RwkvPre pre; h16 pcv = 0, ppv = 0;
#define RW_PREFETCH_V(j) do { const int row_ = b * SEQ + 16 * (j) + sVv; pcv = PAQ[(size_t)row_ * PAQ_W + vcolp]; ppv = PAQ[(size_t)(row_ - (((j) == 0 && sVv == 0) ? 0 : 1)) * PAQ_W + vcolp]; } while (0)
    if (w < 4) RW_PREFETCH(0);
    RW_PREFETCH_V(0);
    for (int it = 0; it < NBLK_P + 2; ++it) {
        if (do_stage && it < NBLK_P) {
            if (w < 4) {
                const f32x4 cr = unpk4(pre.cr), cw = unpk4(pre.cw), ck = unpk4(pre.ck), ca = unpk4(pre.ca);
                f32x4 pr = unpk4(pre.pr), pw = unpk4(pre.pw), pk = unpk4(pre.pk), pa = unpk4(pre.pa);
                if (it == 0 && sA == 0) { pr = pw = pk = pa = (f32x4){0.f, 0.f, 0.f, 0.f}; }
                RW_STAGE_A(it, cr, cw, ck, ca, pr, pw, pk, pa);
                if (it + 1 < NBLK_P) RW_PREFETCH(it + 1);
            }
            { const float cv = h2f(pcv); float pv = h2f(ppv); if (it == 0 && sVv == 0) pv = 0.f; RW_STAGE_V(it, cv, pv); if (it + 1 < NBLK_P) RW_PREFETCH_V(it + 1); }
        }
        if (do_stage && w >= 4 && it >= 1 && it - 1 < NBLK_P) RW_STAGE_B(it - 1);
        if (do_scan && it >= 2) {
            const int j = it - 2;
            const LAS unsigned char* Y = lds + R_Y + (j % 3) * RY_BYTES;
            float osave = 0.f;
            RwkvOps cur = rwkv_ld(Y, 0, kq, vi);
#pragma unroll
            for (int s = 0; s < 16; ++s) {
                RwkvOps nxt = cur; if (s < 15) nxt = rwkv_ld(Y, s + 1, kq, vi);
                const float o = rwkv_step(S0, S1, cur);
                osave = (kq == s) ? o : osave; cur = nxt;
            }
            if (do_write) OB[(size_t)(b * SEQ + 16 * j + kq) * PAQ_W + h * 64 + vrow] = __builtin_bit_cast(h16, (_Float16)osave); else asm volatile("" :: "v"(osave));
        }
        WG_BAR();
    }
    if (!do_write) { asm volatile("" :: "v"(S0), "v"(S1)); return; }
    { float* sp = a->out + O_RWKV_P + ((size_t)(b * 8 + h)) * 4096 + vrow * 64 + 4 * kq; *(f32x4*)sp = (f32x4){(float)S0.x, (float)S0.y, (float)S1.x, (float)S1.y}; }
    for (int it = 0; it < 6; ++it) {
        if (it < 4) {
            const int j = NBLK_P + it, row0 = blk_row0(j, b, sgrp);
            if (w < 4) {
                const int row = row0 + sA; const h16* pc = PAQ + (size_t)row * PAQ_W;
                const f32x4 cr = unpk4(*(const u32x2*)(pc + o_r)), cw = unpk4(*(const u32x2*)(pc + o_w)), ck = unpk4(*(const u32x2*)(pc + o_k)), ca = unpk4(*(const u32x2*)(pc + o_a));
                f32x4 pr, pw, pk, pa;
                if ((sA & 3) == 0) {
                    const float* sp = a->in[3] + (size_t)((row - MP) >> 2) * APROJ;
                    pr = *(const f32x4*)(sp + o_r); pw = *(const f32x4*)(sp + o_w); pk = *(const f32x4*)(sp + o_k); pa = *(const f32x4*)(sp + o_a);
                } else {
                    const h16* pp = pc - PAQ_W;
                    pr = unpk4(*(const u32x2*)(pp + o_r)); pw = unpk4(*(const u32x2*)(pp + o_w)); pk = unpk4(*(const u32x2*)(pp + o_k)); pa = unpk4(*(const u32x2*)(pp + o_a));
                }
                RW_STAGE_A(j, cr, cw, ck, ca, pr, pw, pk, pa);
            }
            { const int row = row0 + sVv; const float cv = h2f(PAQ[(size_t)row * PAQ_W + vcolp]);
              const float pv = ((sVv & 3) == 0) ? a->in[3][(size_t)((row - MP) >> 2) * APROJ + vcolp] : h2f(PAQ[(size_t)(row - 1) * PAQ_W + vcolp]);
              RW_STAGE_V(j, cv, pv); }
        }
        if (w >= 4 && it >= 1 && it - 1 < 4) RW_STAGE_B(NBLK_P + it - 1);
        if (it >= 2) {
            const int j = NBLK_P + it - 2; const int row0 = blk_row0(j, b, sgrp);
            const LAS unsigned char* Y = lds + R_Y + (j % 3) * RY_BYTES;
            const size_t sbase = ((size_t)((row0 - MP) >> 2) * 8 + h) * 4096 + vrow * 64 + 4 * kq;
            f32x4 st[4];
#pragma unroll
            for (int q = 0; q < 4; ++q) st[q] = *(const f32x4*)(a->in[2] + sbase + (size_t)q * 8 * 4096);
            float osave = 0.f;
#pragma unroll
            for (int q = 0; q < 4; ++q) {
                S0 = (h2){(_Float16)st[q].x, (_Float16)st[q].y}; S1 = (h2){(_Float16)st[q].z, (_Float16)st[q].w};
#pragma unroll
                for (int s = 4 * q; s < 4 * q + 4; ++s) { const RwkvOps p = rwkv_ld(Y, s, kq, vi); const float o = rwkv_step(S0, S1, p); osave = (kq == s) ? o : osave; }
                *(f32x4*)(a->out + O_RWKV_S + sbase + (size_t)q * 8 * 4096) = (f32x4){(float)S0.x, (float)S0.y, (float)S1.x, (float)S1.y};
            }
            OB[(size_t)(row0 + kq) * PAQ_W + h * 64 + vrow] = __builtin_bit_cast(h16, (_Float16)osave);
        }
        WG_BAR();
    }
#undef RW_PREFETCH
#undef RW_PREFETCH_V
#undef RW_STAGE_A
#undef RW_STAGE_V
#undef RW_STAGE_B
}

struct GdnPre { u32x4 qk; h16 v[4]; float ain, bin, vb; };
struct GdnOps { u32x4 q, k; unsigned v; float eg, beta; unsigned meh; };
__device__ __forceinline__ GdnOps gdn_ld(const LAS unsigned char* Y, int s, int kq, int vi) {
    GdnOps o;
    o.q = *(const LAS u32x4*)(Y + 0 + s * 256 + kq * 16); o.k = *(const LAS u32x4*)(Y + 4096 + s * 256 + kq * 16);
    o.v = *(const LAS unsigned*)(Y + 8192 + s * 128 + vi * 4); o.eg = *(const LAS float*)(Y + 10240 + s * 16); o.beta = *(const LAS float*)(Y + 10240 + s * 16 + 4); o.meh = *(const LAS unsigned*)(Y + 10240 + s * 16 + 8);
    return o;
}
__device__ __forceinline__ float gdn_step(h2 (&S)[4], const GdnOps& p) {
    float ks = __builtin_amdgcn_fdot2(S[1], u2h(p.k.y), __builtin_amdgcn_fdot2(S[0], u2h(p.k.x), 0.f, false), false) + __builtin_amdgcn_fdot2(S[3], u2h(p.k.w), __builtin_amdgcn_fdot2(S[2], u2h(p.k.z), 0.f, false), false);
    ks = row_sum16(ks);
    const float vv = (float)u2h(p.v).x;
    const float dl = vv - p.eg * ks;
    const h2 dlh = bc2(dl), meh = u2h(p.meh);
    S[0] = __builtin_elementwise_fma(u2h(p.k.x), dlh, __builtin_elementwise_fma(S[0], meh, S[0])); S[1] = __builtin_elementwise_fma(u2h(p.k.y), dlh, __builtin_elementwise_fma(S[1], meh, S[1]));
    S[2] = __builtin_elementwise_fma(u2h(p.k.z), dlh, __builtin_elementwise_fma(S[2], meh, S[2])); S[3] = __builtin_elementwise_fma(u2h(p.k.w), dlh, __builtin_elementwise_fma(S[3], meh, S[3]));
    float o = __builtin_amdgcn_fdot2(S[0], u2h(p.q.x), 0.f, false); o = __builtin_amdgcn_fdot2(S[1], u2h(p.q.y), o, false);
    o = __builtin_amdgcn_fdot2(S[2], u2h(p.q.z), o, false); o = __builtin_amdgcn_fdot2(S[3], u2h(p.q.w), o, false);
    return row_sum16(o);
}

__device__ __forceinline__ void gdn_role(KArgs a, Frame& F, int cc, int mode) {
    const bool do_stage = (mode != 4), do_scan = (mode != 3), do_write = (mode < 3);
    const int w = F.wave, lane = F.lane;
    const int b = cc >> 4, hh = (cc >> 2) & 3, qt = cc & 3;
    const h16* PAQ = (const h16*)(a->ws + WS_PAQ); h16* OB = (h16*)(a->ws + WS_PAQ) + C_Q; const float* ab = (const float*)(a->ws + WS_AB);
    const float* cwp = a->in[23];
    LAS unsigned char* lds = F.lds;
    const h16* QK = (const h16*)(a->ws + WS_A);
    const int qarr = w >> 2, qslot = ((w & 3) << 2) + (lane >> 4), qj = lane & 15;
    const int qkoff = qarr * 512 + hh * 128 + 8 * qj;
    const int tsl = lane >> 4, kq = lane & 15;
    const int sV = 2 * w + (lane >> 5), vloc = lane & 31, vcolp = C_GV + hh * 128 + 32 * qt + vloc, vch = vcolp - C_Q;
    float cwv[4];
#pragma unroll
    for (int i = 0; i < 4; ++i) cwv[i] = cwp[i * CONVCH + vch];
    const float negA = -fexp(a->in[24][hh]), dtb = a->in[25][hh];
    const int vi = 4 * w + tsl, vcol = 32 * qt + vi;
    h2 S[4];
#pragma unroll
    for (int i = 0; i < 4; ++i) S[i] = (h2){0, 0};
    const int sgrp = b;

#define GD_QK(Y_, v_) do { *(LAS u32x4*)((Y_) + qarr * 4096 + qslot * 256 + qj * 16) = (v_); } while (0)
#define GD_GB(Y_, ain_, bin_) do { if (w == 0 && lane < 16) { const float xx_ = (ain_) + dtb; const float sp_ = (xx_ > 20.f) ? xx_ : __logf(1.0f + fexp(xx_)); \
        const float eg_ = fexp(negA * sp_), me_ = eg_ - 1.0f, bt_ = fsigmoid(bin_); *(LAS u32x4*)((Y_) + 10240 + lane * 16) = (u32x4){__builtin_bit_cast(unsigned, bt_ * eg_), __builtin_bit_cast(unsigned, bt_), pkh(me_, me_), 0u}; } } while (0)
#define GD_PREFETCH(j) do { pre.qk = *(const u32x4*)(QK + (size_t)(b * SEQ + 16 * (j) + qslot) * D + qkoff); \
        const int rowv_ = b * SEQ + 16 * (j) + sV; \
        _Pragma("unroll") for (int i_ = 0; i_ < 4; ++i_) { int rr_ = rowv_ - 3 + i_; rr_ = rr_ < b * SEQ ? b * SEQ : rr_; pre.v[i_] = PAQ[(size_t)rr_ * PAQ_W + vcolp]; } \
        pre.vb = ab[(size_t)rowv_ * 8 + 4 + hh]; \
        if (w == 0 && lane < 16) { const int rg_ = b * SEQ + 16 * (j) + lane; pre.ain = ab[(size_t)rg_ * 8 + hh]; pre.bin = ab[(size_t)rg_ * 8 + 4 + hh]; } } while (0)

    GdnPre pre; pre.ain = 0.f; pre.bin = 0.f;
    for (int it = 0; it < NBLK_P + 2; ++it) {
        if (do_stage && it >= 1 && it - 1 < NBLK_P) {
            const int j = it - 1; LAS unsigned char* Y = lds + G_Y + (j & 1) * GY_BYTES;
            GD_QK(Y, pre.qk);
            { const int t = 16 * j + sV; float accv = 0.f;
#pragma unroll
              for (int i = 0; i < 4; ++i) { const float x = (t - 3 + i >= 0) ? h2f(pre.v[i]) : 0.f; accv += x * cwv[i]; }
              const float sv = fsilu(accv) * fsigmoid(pre.vb); *(LAS unsigned*)(Y + 8192 + sV * 128 + vloc * 4) = pkh(sv, sv); }
            GD_GB(Y, pre.ain, pre.bin);
        }
        if (do_stage && it < NBLK_P) GD_PREFETCH(it);
        if (do_scan && it >= 2) {
            const int j = it - 2;
            const LAS unsigned char* Y = lds + G_Y + (j & 1) * GY_BYTES;
            float osave = 0.f;
            GdnOps cur = gdn_ld(Y, 0, kq, vi);
#pragma unroll
            for (int s = 0; s < 16; ++s) {
                GdnOps nxt = cur; if (s < 15) nxt = gdn_ld(Y, s + 1, kq, vi);
                const float o = gdn_step(S, cur);
                osave = (kq == s) ? o : osave; cur = nxt;
            }
            if (do_write) OB[(size_t)(b * SEQ + 16 * j + kq) * PAQ_W + 512 + hh * 128 + vcol] = __builtin_bit_cast(h16, (_Float16)osave); else asm volatile("" :: "v"(osave));
        }
        WG_BAR();
    }
    if (!do_write) { asm volatile("" :: "v"(S[0]), "v"(S[1]), "v"(S[2]), "v"(S[3])); return; }
    { float* sp = a->out + O_DELTA_P + ((size_t)(b * 4 + hh)) * 16384 + (size_t)(8 * kq) * 128 + vcol;
#pragma unroll
      for (int i = 0; i < 4; ++i) { sp[(2 * i) * 128] = (float)S[i].x; sp[(2 * i + 1) * 128] = (float)S[i].y; } }
    for (int it = 0; it < 6; ++it) {
        if (it >= 1 && it - 1 < 4) {
            const int j = NBLK_P + it - 1; LAS unsigned char* Y = lds + G_Y + (j & 1) * GY_BYTES;
            const int row0 = blk_row0(j, b, sgrp);
            { const u32x4 qv = *(const u32x4*)(QK + (size_t)(row0 + qslot) * D + qkoff); GD_QK(Y, qv); }
            { const int row = row0 + sV, t = sV & 3; float accv = 0.f;
#pragma unroll
              for (int i = 0; i < 4; ++i) { const int tt = t - 3 + i; float x;
                  if (tt >= 0) x = h2f(PAQ[(size_t)(row - 3 + i) * PAQ_W + vcolp]); else x = a->in[5][((size_t)((row - MP) >> 2) * 3 + (3 + tt)) * CONVCH + vch];
                  accv += x * cwv[i]; }
              const float sv = fsilu(accv) * fsigmoid(ab[(size_t)row * 8 + 4 + hh]); *(LAS unsigned*)(Y + 8192 + sV * 128 + vloc * 4) = pkh(sv, sv); }
            { float ain = 0.f, bin = 0.f; if (w == 0 && lane < 16) { ain = ab[(size_t)(row0 + lane) * 8 + hh]; bin = ab[(size_t)(row0 + lane) * 8 + 4 + hh]; } GD_GB(Y, ain, bin); }
        }
        if (it >= 2) {
            const int j = NBLK_P + it - 2; const int row0 = blk_row0(j, b, sgrp);
            const LAS unsigned char* Y = lds + G_Y + (j & 1) * GY_BYTES;
            const size_t sbase = ((size_t)((row0 - MP) >> 2) * 4 + hh) * 16384 + (size_t)(8 * kq) * 128 + vcol;
            float osave = 0.f;
#pragma unroll
            for (int q = 0; q < 4; ++q) {
                const float* sp = a->in[4] + sbase + (size_t)q * 4 * 16384;
#pragma unroll
                for (int i = 0; i < 4; ++i) S[i] = (h2){(_Float16)sp[(2 * i) * 128], (_Float16)sp[(2 * i + 1) * 128]};
#pragma unroll
                for (int s = 4 * q; s < 4 * q + 4; ++s) { const GdnOps p = gdn_ld(Y, s, kq, vi); const float o = gdn_step(S, p); osave = (kq == s) ? o : osave; }
                float* so = a->out + O_DELTA_S + sbase + (size_t)q * 4 * 16384;
#pragma unroll
                for (int i = 0; i < 4; ++i) { so[(2 * i) * 128] = (float)S[i].x; so[(2 * i + 1) * 128] = (float)S[i].y; }
            }
            OB[(size_t)(row0 + kq) * PAQ_W + 512 + hh * 128 + vcol] = __builtin_bit_cast(h16, (_Float16)osave);
        }
        WG_BAR();
    }
#undef GD_QK
#undef GD_GB
#undef GD_PREFETCH
}

__device__ __forceinline__ void post_phase(KArgs a, Frame& F) {
    const h16* PAQ = (const h16*)(a->ws + WS_PAQ); const h16* Z = (const h16*)(a->ws + WS_Z); const h16* OI = (const h16*)(a->ws + WS_PAQ) + C_Q; h16* OB = (h16*)(a->ws + WS_A); const float* bon = (const float*)(a->ws + WS_BON);
    const float* mu = a->in[12];
    LAS unsigned char* lds = F.lds;
    const int lane = F.lane, w = F.wave, tsl = lane >> 4, n = lane & 15;
    const h16* g2t = (const h16*)(a->ws + WS_G2T);
    for (int blk = F.bx; blk < M / 16; blk += F.G) {
        const int row0 = blk * 16;
        {
            const int tok = F.tid >> 5, c4 = (F.tid & 31) * 4, row = row0 + tok;
            const bool smp = row >= MP; const int t = smp ? ((row - MP) & 3) : (row & (SEQ - 1));
            const f32x4 cg = unpk4(*(const u32x2*)(PAQ + (size_t)row * PAQ_W + C_GD + c4));
            f32x4 pg;
            if (t > 0) pg = unpk4(*(const u32x2*)(PAQ + (size_t)(row - 1) * PAQ_W + C_GD + c4));
            else if (smp) pg = *(const f32x4*)(a->in[3] + (size_t)((row - MP) >> 2) * APROJ + C_GD + c4);
            else pg = (f32x4){0.f, 0.f, 0.f, 0.f};
            const f32x4 m4 = *(const f32x4*)(mu + C_GD + c4);
            const f32x4 g = cg + (pg - cg) * m4;
            u32x2 o; o.x = pkh(fsigmoid(g.x), fsigmoid(g.y)); o.y = pkh(fsigmoid(g.z), fsigmoid(g.w));
            *(LAS u32x2*)(lds + tok * 256 + c4 * 2) = o;
        }
        __syncthreads();
        {
            f32x4 gacc[4];
#pragma unroll
            for (int nt = 0; nt < 4; ++nt) gacc[nt] = (f32x4){0.f, 0.f, 0.f, 0.f};
#pragma unroll
            for (int st = 0; st < 4; ++st) {
                const f16x8 av = *(const LAS f16x8*)(lds + n * 256 + tsl * 16 + st * 64);
#pragma unroll
                for (int nt = 0; nt < 4; ++nt) {
                    const f16x8 bv = *(const f16x8*)(g2t + (size_t)(w * 64 + nt * 16 + n) * 128 + 8 * tsl + 32 * st);
                    gacc[nt] = __builtin_amdgcn_mfma_f32_16x16x32_f16(av, bv, gacc[nt], 0, 0, 0);
                }
            }
#pragma unroll
            for (int i = 0; i < 4; ++i) {
                const int row = row0 + 4 * tsl + i;
                const bool smp = row >= MP; const int t = smp ? ((row - MP) & 3) : (row & (SEQ - 1));
                float o[4], sum = 0.f;
#pragma unroll
                for (int nt = 0; nt < 4; ++nt) { o[nt] = h2f(OI[(size_t)row * PAQ_W + w * 64 + nt * 16 + n]); sum += o[nt]; }
                const float mean = row_sum16(sum) * (1.0f / 64.0f);
                float var = 0.f;
#pragma unroll
                for (int nt = 0; nt < 4; ++nt) { o[nt] -= mean; var += o[nt] * o[nt]; }
                const float rstd = __builtin_amdgcn_rsqf(row_sum16(var) * (1.0f / 64.0f) + LNX_EPS);
                const f32x4 bp = *(const f32x4*)(bon + (size_t)row * 32 + w * 4);
                const float bonus = (bp.x + bp.y) + (bp.z + bp.w);
#pragma unroll
                for (int nt = 0; nt < 4; ++nt) {
                    const int col = w * 64 + nt * 16 + n;
                    const float cv = h2f(PAQ[(size_t)row * PAQ_W + C_V + col]); float pv;
                    if (t > 0) pv = h2f(PAQ[(size_t)(row - 1) * PAQ_W + C_V + col]); else if (smp) pv = a->in[3][(size_t)((row - MP) >> 2) * APROJ + C_V + col]; else pv = 0.f;
                    const float vl = cv + (pv - cv) * mu[C_V + col];
                    const float val = (o[nt] * rstd * a->in[21][col] + a->in[22][col] + bonus * vl) * gacc[nt][i];
                    o[nt] = val;
                }
                asm volatile("" ::: "memory");
#pragma unroll
                for (int nt = 0; nt < 4; ++nt) OB[(size_t)row * D + w * 64 + nt * 16 + n] = __builtin_bit_cast(h16, (_Float16)o[nt]);
            }
        }
#pragma unroll
        for (int i = 0; i < 2; ++i) {
            const int row = row0 + 2 * w + i, col = tsl * 128 + n * 8;
            const u32x4 ov = *(const u32x4*)(OI + (size_t)row * PAQ_W + 512 + col); const u32x4 zv = *(const u32x4*)(Z + (size_t)row * Z_W + col);
            const f32x4 o0 = unpk4((u32x2){ov.x, ov.y}), o1 = unpk4((u32x2){ov.z, ov.w}), z0 = unpk4((u32x2){zv.x, zv.y}), z1 = unpk4((u32x2){zv.z, zv.w});
            float ss = ((o0.x * o0.x + o0.y * o0.y) + (o0.z * o0.z + o0.w * o0.w)) + ((o1.x * o1.x + o1.y * o1.y) + (o1.z * o1.z + o1.w * o1.w));
            const float rstd = __builtin_amdgcn_rsqf(row_sum16(ss) * (1.0f / 128.0f) + RMS_EPS);
            const f32x4 n0 = *(const f32x4*)(a->in[26] + n * 8), n1 = *(const f32x4*)(a->in[26] + n * 8 + 4);
            f32x4 r0 = o0 * rstd * n0, r1 = o1 * rstd * n1;
            r0.x *= fsilu(z0.x); r0.y *= fsilu(z0.y); r0.z *= fsilu(z0.z); r0.w *= fsilu(z0.w);
            r1.x *= fsilu(z1.x); r1.y *= fsilu(z1.y); r1.z *= fsilu(z1.z); r1.w *= fsilu(z1.w);
            u32x4 wv; wv.x = pkh(r0.x, r0.y); wv.y = pkh(r0.z, r0.w); wv.z = pkh(r1.x, r1.y); wv.w = pkh(r1.z, r1.w);
            *(u32x4*)(OB + (size_t)row * D + 512 + col) = wv;
        }
        __syncthreads();
    }
}

__device__ __forceinline__ void final_norm(KArgs a, Frame& F) {
    pg8::RowScale rs{(const float*)(a->ws + WS_SSQ3), 16};
    const int gw = F.bx * NWAVES + F.wave, NGW = F.G * NWAVES;
    const f32x4* fw = (const f32x4*)a->in[34] + F.lane; f32x4 wv[4];
#pragma unroll
    for (int j = 0; j < 4; ++j) wv[j] = fw[64 * j];
    for (int m = gw; m < M; m += NGW) {
        f32x4* xr = (f32x4*)(a->out + (size_t)m * D) + F.lane; const float s = rs(m);
#pragma unroll
        for (int j = 0; j < 4; ++j) { const f32x4 v = xr[64 * j]; xr[64 * j] = v * s * wv[j]; }
    }
}

__device__ __forceinline__ void late_convert(KArgs a, Frame& F, int part, int nparts) {
    unsigned char* ws = a->ws;
    LAS float* scr = (LAS float*)(F.lds + F.wave * 16384);
    const int gw = part * NWAVES + F.wave, NGW = nparts * NWAVES;
    constexpr int I_UP = 16 * 176, I_DN = 44 * 32, I_PJ = 8 * 32, I_WO = 16 * 32;
    constexpr int NITEMS = I_UP + I_DN + 2 * I_PJ + I_WO;
    for (int it = gw; it < NITEMS; it += NGW) {
        int r = it;
        if (r < I_UP) { tr_up_item(a->in[31], a->in[32], a->in[30], (h16*)(ws + WS_W2UP), r, scr, F.lane); continue; } r -= I_UP;
        if (r < I_DN) { const int kb = r / 32, nb = r % 32; tr_item(a->in[33], D, 64 * kb, 32 * nb, nullptr, (h16*)(ws + WS_W2DN), FF, 32 * nb, 64 * kb, scr, F.lane); continue; } r -= I_DN;
        if (r < I_PJ) { const int kb = r / 32, nb = r % 32; tr_item(a->in[27], D, 64 * kb, 32 * nb, nullptr, (h16*)(ws + WS_WPT), D, 32 * nb, 64 * kb, scr, F.lane); continue; } r -= I_PJ;
        if (r < I_PJ) { const int kb = r / 32, nb = r % 32; tr_item(a->in[28], D, 64 * kb, 32 * nb, nullptr, (h16*)(ws + WS_WPT), D, 32 * nb, 512 + 64 * kb, scr, F.lane); continue; } r -= I_PJ;
        { const int kb = r / 32, nb = r % 32; tr_item(a->in[29], D, 64 * kb, 32 * nb, nullptr, (h16*)(ws + WS_WOUTT), D, 32 * nb, 64 * kb, scr, F.lane); }
    }
}

constexpr int N_PHASES = 12;
__global__ void __launch_bounds__(NTHREADS, 2) mk_fwd(Args args) {
    extern __shared__ __attribute__((aligned(16))) unsigned char lds_raw[];
    Frame F;
    F.lds = (LAS unsigned char*)lds_raw;
    F.tid = threadIdx.x; F.lane = F.tid & 63; F.wave = __builtin_amdgcn_readfirstlane(F.tid >> 6);
    F.G = gridDim.x; F.bx = blockIdx.x;
    volatile LAS unsigned* MISC = (volatile LAS unsigned*)(F.lds + MISC_OFF);
    for (int u = F.tid; u < (LDS_BYTES - LDSCTL_OFF) / 4; u += NTHREADS) ((LAS unsigned*)(F.lds + LDSCTL_OFF))[u] = 0u;
    __syncthreads();
    KArgs ka0 = (KArgs)__builtin_amdgcn_kernarg_segment_ptr();
    unsigned char* ws = ka0->ws;
    XcdBarrier bar; bar.bar = (unsigned*)(ws + WS_CTL) + 1024; bar.x = 0; bar.st = nullptr;
    if (MK_N_LAUNCHES == 1) bar = xcd_barrier_post((unsigned*)(ws + WS_CTL) + 1024, MISC + 8);
    const int lo = ka0->ph_lo, hi = ka0->ph_hi;
#ifndef PH_MASK
#define PH_MASK 0xfff
#endif
#define IN(k) (((PH_MASK >> (k)) & 1) && lo <= (k) && (k) < hi)
#define SEAM(k) do { if (IN(k) && IN((k) + 1)) xcd_barrier(bar); } while (0)
    const int c = F.bx;

#define NREP(k) ((PROBE_REP == (k)) ? 2 : 1)
    if (IN(0)) for (int rep_ = 0; rep_ < NREP(0); ++rep_) { KArgs args = ka0; asm volatile("" : "+s"(args)); unsigned char* ws = args->ws; unsigned char* dob = (unsigned char*)args->out; (void)ws; (void)dob; p0_prologue(args, F); } SEAM(0);
    if (IN(1)) for (int rep_ = 0; rep_ < NREP(1); ++rep_) { KArgs args = ka0; asm volatile("" : "+s"(args)); unsigned char* ws = args->ws; unsigned char* dob = (unsigned char*)args->out; (void)ws; (void)dob;
        pg8::Gemm g{(const h16*)(ws + WS_A), (const h16*)(dob + DO_W1UP), D, D}; pg8::StaticOrder S; S.init(M, 5632, F.G, c);
        pg8::EpiSwiglu E{(h16*)(ws + WS_HID), pg8::RowScale{(const float*)(ws + WS_SSQ0), 1}};
        pg8::gemm_phase(F.lds, g, S, E);
    } SEAM(1);
    if (IN(2)) for (int rep_ = 0; rep_ < NREP(2); ++rep_) { KArgs args = ka0; asm volatile("" : "+s"(args)); unsigned char* ws = args->ws; unsigned char* dob = (unsigned char*)args->out; (void)ws; (void)dob;
        pg8::Gemm g{(const h16*)(ws + WS_HID), (const h16*)(dob + DO_W1DN), FF, FF}; pg8::StaticOrder S; S.init(MP, D, F.G, c);
        pg8::EpiResid E{args->in[0], args->in[1], MP, args->out, (h16*)(ws + WS_A), (float*)(ws + WS_SSQ1), 0.5f};
        pg8::gemm_phase(F.lds, g, S, E);
        SResid SE{args->in[1] - (size_t)MP * D, args->out, (h16*)(ws + WS_A), (float*)(ws + WS_SSQ1), 0.5f};
        if (c < 256) sample_gemm(F.lds, g.A, FF, g.Bt, FF, SE, c, F.tid);
    } SEAM(2);
    if (IN(3)) for (int rep_ = 0; rep_ < NREP(3); ++rep_) { KArgs args = ka0; asm volatile("" : "+s"(args)); unsigned char* ws = args->ws; unsigned char* dob = (unsigned char*)args->out; (void)ws; (void)dob;
        pg8::Gemm g{(const h16*)(ws + WS_A), (const h16*)(dob + DO_WIN), D, D}; pg8::StaticOrder S; S.init(M, NIN, F.G, c);
        pg8::EpiP E{(h16*)(ws + WS_PAQ), (h16*)(ws + WS_Z), (h16*)(ws + WS_GT), pg8::RowScale{(const float*)(ws + WS_SSQ1), 16}};
        pg8::gemm_phase(F.lds, g, S, E);
        ab_gemv(args, F);
    } SEAM(3);
    if (IN(4)) for (int rep_ = 0; rep_ < NREP(4); ++rep_) { KArgs args = ka0; asm volatile("" : "+s"(args)); gdn_prep(args, F); } SEAM(4);
    if (IN(5)) for (int rep_ = 0; rep_ < NREP(5); ++rep_) { KArgs args = ka0; asm volatile("" : "+s"(args)); unsigned char* ws = args->ws; unsigned char* dob = (unsigned char*)args->out; (void)ws; (void)dob;
        const int mode = (MK_N_LAUNCHES == 1) ? 0 : args->pad;
        if (F.G == 256) { if (c < 128) { if (mode == 0 || mode == 1 || mode == 5 || mode == 6) rwkv_role(args, F, c, mode); if (mode == 0) late_convert(args, F, c, 128); } else { if (mode == 0 || mode == 2 || mode == 3 || mode == 4) gdn_role(args, F, c - 128, mode); } }
    } SEAM(5);
    if (IN(6)) for (int rep_ = 0; rep_ < NREP(6); ++rep_) { KArgs args = ka0; asm volatile("" : "+s"(args)); unsigned char* ws = args->ws; unsigned char* dob = (unsigned char*)args->out; (void)ws; (void)dob; post_phase(args, F); } SEAM(6);
    if (IN(7)) for (int rep_ = 0; rep_ < NREP(7); ++rep_) { KArgs args = ka0; asm volatile("" : "+s"(args)); unsigned char* ws = args->ws; unsigned char* dob = (unsigned char*)args->out; (void)ws; (void)dob;
        pg8::Gemm g{(const h16*)(ws + WS_A), (const h16*)(ws + WS_WPT), D, D}; pg8::StaticOrder S; S.init(MP, D, F.G, c);
        pg8::EpiMerge E{(const h16*)(ws + WS_GT), (h16*)(ws + WS_MRG), 8};
        pg8::gemm_phase(F.lds, g, S, E);
        SMerge SE{(const h16*)(ws + WS_GT), (h16*)(ws + WS_MRG)};
        if (c < 256) sample_gemm(F.lds, g.A, D, g.Bt, D, SE, c, F.tid);
    } SEAM(7);
    if (IN(8)) for (int rep_ = 0; rep_ < NREP(8); ++rep_) { KArgs args = ka0; asm volatile("" : "+s"(args)); unsigned char* ws = args->ws; unsigned char* dob = (unsigned char*)args->out; (void)ws; (void)dob;
        pg8::Gemm g{(const h16*)(ws + WS_MRG), (const h16*)(ws + WS_WOUTT), D, D}; pg8::StaticOrder S; S.init(MP, D, F.G, c);
        pg8::EpiResid E{args->out, args->out, M, args->out, (h16*)(ws + WS_A), (float*)(ws + WS_SSQ2), 1.0f};
        pg8::gemm_phase(F.lds, g, S, E);
        SResid SE{args->out, args->out, (h16*)(ws + WS_A), (float*)(ws + WS_SSQ2), 1.0f};
        if (c < 256) sample_gemm(F.lds, g.A, D, g.Bt, D, SE, c, F.tid);
    } SEAM(8);
    if (IN(9)) for (int rep_ = 0; rep_ < NREP(9); ++rep_) { KArgs args = ka0; asm volatile("" : "+s"(args)); unsigned char* ws = args->ws; unsigned char* dob = (unsigned char*)args->out; (void)ws; (void)dob;
        pg8::Gemm g{(const h16*)(ws + WS_A), (const h16*)(ws + WS_W2UP), D, D}; pg8::StaticOrder S; S.init(M, 5632, F.G, c);
        pg8::EpiSwiglu E{(h16*)(ws + WS_HID), pg8::RowScale{(const float*)(ws + WS_SSQ2), 16}};
        pg8::gemm_phase(F.lds, g, S, E);
    } SEAM(9);
    if (IN(10)) for (int rep_ = 0; rep_ < NREP(10); ++rep_) { KArgs args = ka0; asm volatile("" : "+s"(args)); unsigned char* ws = args->ws; unsigned char* dob = (unsigned char*)args->out; (void)ws; (void)dob;
        pg8::Gemm g{(const h16*)(ws + WS_HID), (const h16*)(ws + WS_W2DN), FF, FF}; pg8::StaticOrder S; S.init(MP, D, F.G, c);
        pg8::EpiResid E{args->out, args->out, M, args->out, nullptr, (float*)(ws + WS_SSQ3), 0.5f};
        pg8::gemm_phase(F.lds, g, S, E);
        SResid SE{args->out, args->out, nullptr, (float*)(ws + WS_SSQ3), 0.5f};
        if (c < 256) sample_gemm(F.lds, g.A, FF, g.Bt, FF, SE, c, F.tid);
    } SEAM(10);
    if (IN(11)) for (int rep_ = 0; rep_ < NREP(11); ++rep_) { KArgs args = ka0; asm volatile("" : "+s"(args)); unsigned char* ws = args->ws; unsigned char* dob = (unsigned char*)args->out; (void)ws; (void)dob; final_norm(args, F); }
#undef IN
#undef SEAM
}

extern "C" void kernel_launch(void* const* d_in, const int* in_sizes, int n_in, void* d_out, int out_size, void* d_ws, size_t ws_size, hipStream_t stream) {
    static int grid = 0;
    if (grid == 0) {
        if (n_in != 35 || in_sizes[0] != MP * D || in_sizes[1] != MS * D || (size_t)out_size != O_END || ws_size < WS_END) {
            fprintf(stderr, "kernel_launch: unexpected shapes: n_in %d in0 %d out %d ws %zu (need %zu)\n", n_in, n_in > 0 ? in_sizes[0] : -1, out_size, ws_size, (size_t)WS_END); grid = -1; return; }
        int dev = 0, cus = 0, per_cu = 0;
        if (hipGetDevice(&dev) != hipSuccess || hipDeviceGetAttribute(&cus, hipDeviceAttributeMultiprocessorCount, dev) != hipSuccess) { fprintf(stderr, "kernel_launch: device query failed\n"); grid = -1; return; }
        if (hipFuncSetAttribute((const void*)mk_fwd, hipFuncAttributeMaxDynamicSharedMemorySize, LDS_BYTES) != hipSuccess) { fprintf(stderr, "kernel_launch: hipFuncSetAttribute failed\n"); grid = -1; return; }
        if (hipOccupancyMaxActiveBlocksPerMultiprocessor(&per_cu, (const void*)mk_fwd, NTHREADS, LDS_BYTES) != hipSuccess || per_cu < 1) { fprintf(stderr, "kernel_launch: occupancy query says %d blocks per CU\n", per_cu); grid = -1; (void)hipGetLastError(); return; }
        (void)hipGetLastError();
        grid = cus;
        if (grid != 256) fprintf(stderr, "kernel_launch: %d CUs; the scan phase needs exactly 256 workgroups\n", grid);
    }
    if (grid < 0) return;
    (void)hipMemsetAsync((char*)d_ws + WS_CTL, 0, CTL_ZERO_BYTES, stream);
    Args a{};
    for (int i = 0; i < 35; ++i) a.in[i] = (const float*)d_in[i];
    a.out = (float*)d_out; a.ws = (unsigned char*)d_ws;
    if (MK_N_LAUNCHES == 1) {
        a.ph_lo = 0; a.ph_hi = N_PHASES; a.li = 0;
        hipLaunchKernelGGL(mk_fwd, dim3(grid), dim3(NTHREADS), LDS_BYTES, stream, a);
    } else {
        for (int li = 0; li < N_PHASES; ++li) { a.ph_lo = li; a.ph_hi = li + 1; a.li = li; hipLaunchKernelGGL(mk_fwd, dim3(grid), dim3(NTHREADS), LDS_BYTES, stream, a);
            if (li == PROBE_LREP) { a.pad = PROBE_MODE; hipLaunchKernelGGL(mk_fwd, dim3(grid), dim3(NTHREADS), LDS_BYTES, stream, a); a.pad = 0; } }
    }
}
```

```cpp
#include <hip/hip_runtime.h>
#include <cstdio>
#include <cstdint>

#ifndef MK_N_LAUNCHES
#define MK_N_LAUNCHES 1
#endif

#ifndef PROBE_SCAN2
#define PROBE_SCAN2 0
#endif
#ifndef PROBE_MODE
#define PROBE_MODE 0
#endif
#ifndef PROBE_LREP
#define PROBE_LREP -1
#endif
#ifndef PROBE_NX
#define PROBE_NX 4
#endif
#ifndef PROBE_REP
#define PROBE_REP -1
#endif
#define LAS __attribute__((address_space(3)))
#define GAS __attribute__((address_space(1)))
typedef unsigned short h16;
typedef _Float16 f16x8 __attribute__((ext_vector_type(8)));
typedef _Float16 f16x4 __attribute__((ext_vector_type(4)));
typedef _Float16 f16x2 __attribute__((ext_vector_type(2)));
typedef _Float16 h2 __attribute__((ext_vector_type(2)));
typedef _Float16 f16x4 __attribute__((ext_vector_type(4)));
typedef float f32x4 __attribute__((ext_vector_type(4)));
typedef float f32x2 __attribute__((ext_vector_type(2)));
typedef unsigned u32x4 __attribute__((ext_vector_type(4)));
typedef unsigned u32x2 __attribute__((ext_vector_type(2)));
typedef short v4i16_t __attribute__((ext_vector_type(4)));
typedef GAS unsigned gu32;

constexpr int D = 1024, MP = 16384, MS = 512, M = MP + MS, SEQ = 2048, NB_P = 8, NB_S = 128, TS = 4;
constexpr int FF = 2816, APROJ = 1792, CONVCH = 1536;
constexpr int PAQ_W = 3328, Z_W = 512, GT_W = 2048, NIN = PAQ_W + Z_W + GT_W;
constexpr int GT_P = 2112;
constexpr float RMS_EPS = 1e-6f, LNX_EPS = 64e-5f;
constexpr int C_R = 0, C_WD = 512, C_K = 576, C_V = 1088, C_AD = 1600, C_GD = 1664, C_Q = 1792, C_GK = 2304, C_GV = 2816;
constexpr size_t O_Y = 0, O_RWKV_P = 17301504, O_SHIFT_P = 17563648, O_DELTA_P = 17577984, O_CONV_P = 18102272,
                 O_RWKV_S = 18139136, O_SHIFT_S = 22333440, O_DELTA_S = 22562816, O_CONV_S = 30951424, O_END = 31541248;

constexpr size_t MiB = 1u << 20;
constexpr size_t WS_CTL = 0, CTL_ZERO_BYTES = 64 * 1024;
constexpr size_t WS_SSQ0 = 1 * MiB, WS_SSQ1 = WS_SSQ0 + (size_t)M * 64, WS_SSQ2 = WS_SSQ1 + (size_t)M * 64, WS_SSQ3 = WS_SSQ2 + (size_t)M * 64;
constexpr size_t WS_AB = WS_SSQ3 + (size_t)M * 64;
constexpr size_t WS_BON = WS_AB + (size_t)M * 32;
constexpr size_t WS_WAB = WS_BON + (size_t)M * 128;
constexpr size_t WS_W2T = WS_WAB + 32768;
constexpr size_t WS_A2T = WS_W2T + 65536;
constexpr size_t WS_G2T = WS_A2T + 65536;
static_assert(WS_G2T + 131072 <= 8 * MiB, "small arrays");
constexpr size_t WS_A = 8 * MiB;
constexpr size_t WS_WPT = 41 * MiB, WS_WOUTT = 43 * MiB;
constexpr size_t WS_W2UP = 45 * MiB;
constexpr size_t WS_W2DN = 56 * MiB;
constexpr size_t WS_B = 62 * MiB;
constexpr size_t WS_HID = WS_B;
constexpr size_t WS_PAQ = WS_B;
constexpr size_t WS_Z = WS_PAQ + (size_t)M * PAQ_W * 2;
constexpr size_t WS_GT = WS_Z + (size_t)M * Z_W * 2;
constexpr size_t WS_MRG = WS_B;
constexpr size_t WS_END = WS_GT + (size_t)M * GT_P * 2;
static_assert(WS_END <= 256 * MiB, "workspace map");
static_assert(WS_A + (size_t)M * D * 2 <= WS_WPT, "region A");
constexpr size_t DO_W1UP = O_DELTA_S * 4;
constexpr size_t DO_W1DN = DO_W1UP + (size_t)5632 * 1024 * 2;
constexpr size_t DO_WIN = O_RWKV_S * 4;
static_assert(DO_W1DN + (size_t)1024 * 2816 * 2 <= O_CONV_S * 4 && DO_WIN + (size_t)NIN * 1024 * 2 <= O_SHIFT_S * 4, "d_out scratch");

constexpr int NWAVES = 8, NTHREADS = 512;
constexpr int RING_BYTES = 131072, LDSCTL_OFF = RING_BYTES, MISC_OFF = LDSCTL_OFF + 320, LDS_BYTES = 147456;

__device__ __forceinline__ unsigned pkh(float lo, float hi) { f16x2 v; v.x = (_Float16)lo; v.y = (_Float16)hi; return __builtin_bit_cast(unsigned, v); }
__device__ __forceinline__ f32x2 unpk(unsigned u) { f16x2 v = __builtin_bit_cast(f16x2, u); f32x2 r; r.x = (float)v.x; r.y = (float)v.y; return r; }
__device__ __forceinline__ f32x4 unpk4(u32x2 u) { f32x2 a = unpk(u.x), b = unpk(u.y); return (f32x4){a.x, a.y, b.x, b.y}; }
__device__ __forceinline__ float h2f(h16 v) { return (float)__builtin_bit_cast(_Float16, v); }
__device__ __forceinline__ h2 bc2(float x) { const _Float16 h = (_Float16)x; return (h2){h, h}; }
__device__ __forceinline__ h2 u2h(unsigned u) { return __builtin_bit_cast(h2, u); }
__device__ __forceinline__ float fexp(float x) { return __builtin_amdgcn_exp2f(x * 1.44269504089f); }
__device__ __forceinline__ float frcp(float x) { return __builtin_amdgcn_rcpf(x); }
__device__ __forceinline__ float fsigmoid(float x) { return frcp(1.0f + fexp(-x)); }
__device__ __forceinline__ float fsilu(float x) { return x * frcp(1.0f + fexp(-x)); }
__device__ __forceinline__ float ftanh(float x) { return 1.0f - 2.0f * frcp(1.0f + fexp(2.0f * x)); }
template <int CTRL> __device__ __forceinline__ float dppf(float x) { return __builtin_bit_cast(float, __builtin_amdgcn_update_dpp(0, __builtin_bit_cast(int, x), CTRL, 0xF, 0xF, false)); }
__device__ __forceinline__ float row_sum16(float x) { x += dppf<0x128>(x); x += dppf<0x124>(x); x += dppf<0x122>(x); x += dppf<0x121>(x); return x; }
__device__ __forceinline__ float wave_sum(float v) {
#pragma unroll
    for (int o = 1; o < 64; o <<= 1) v += __shfl_xor(v, o);
    return v;
}
#define MFMA16(a_, b_, c_) __builtin_amdgcn_mfma_f32_16x16x16f16(a_, b_, c_, 0, 0, 0)
__device__ __forceinline__ f16x4 cvt4(f32x4 v) { return (f16x4){(_Float16)v.x, (_Float16)v.y, (_Float16)v.z, (_Float16)v.w}; }
__device__ __forceinline__ f16x4 u2q(u32x2 u) { return __builtin_bit_cast(f16x4, u); }
#define LDS_WAIT() asm volatile("s_waitcnt lgkmcnt(0)" ::: "memory")
#define VM_WAIT() asm volatile("s_waitcnt vmcnt(0)" ::: "memory")
#define RLX_AGENT __ATOMIC_RELAXED, __HIP_MEMORY_SCOPE_AGENT

namespace pg8 {
constexpr int BM = 256, BK = 64, HALF = 128, HTB = HALF * BK * 2, STAGE_BYTES = 8 * HTB, NXCD = 8, WGM = 8;
__host__ __device__ __forceinline__ int lds_byte(int r, int c) { const int st = (r >> 4) * 2 + (c >> 5), rr = r & 15, cc = c & 31, ob = rr * 64 + cc * 2; return st * 1024 + (ob ^ (((ob >> 9) & 1) << 5)); }
__host__ __device__ __forceinline__ void stage_rc(int b, int& R, int& C) { const int st = b / 1024, sb = b % 1024, swz = sb ^ (((sb >> 9) & 1) << 5); R = (st >> 1) * 16 + swz / 64; C = (st & 1) * 32 + (swz % 64) / 2; }
__host__ __device__ __forceinline__ int perm32(int rho) { const int n = rho >> 4, i = rho & 15; return 8 * (i >> 2) + 4 * n + (i & 3); }

struct Unit { int pm, pn; };
struct Gemm { const h16* A; const h16* Bt; int lda, K; };

struct StaticOrder {
    int nM, nN, nwg, G, c;
    __device__ void init(int Mr, int N, int G_, int c_) { nM = Mr / BM; nN = N / BM; nwg = nM * nN; G = G_; c = c_; }
    __device__ bool next(int i, Unit& u) const {
        const long L = (long)i * G + c; if (L >= nwg) return false;
        int wgid = (int)L; { const int q = nwg / NXCD, r = nwg % NXCD, xcd = wgid % NXCD, off = wgid / NXCD; wgid = (xcd < r ? xcd * (q + 1) : r * (q + 1) + (xcd - r) * q) + off; }
        const int nig = WGM * nN, gid = wgid / nig, fm = gid * WGM, gsz = (nM - fm) < WGM ? (nM - fm) : WGM;
        u.pm = fm + ((wgid % nig) % gsz); u.pn = (wgid % nig) / gsz; return true;
    }
};

struct RowScale {
    const float* ssq; int np;
    __device__ __forceinline__ float operator()(int row) const {
        const f32x4* p = (const f32x4*)(ssq + (size_t)row * 16); float s;
        if (np == 1) s = ssq[(size_t)row * 16];
        else { f32x4 a = p[0], b = p[1], c = p[2], d = p[3]; s = ((a.x + a.y) + (a.z + a.w)) + ((b.x + b.y) + (b.z + b.w)) + ((c.x + c.y) + (c.z + c.w)) + ((d.x + d.y) + (d.z + d.w)); }
        return __builtin_amdgcn_rsqf(s * (1.0f / 1024.0f) + RMS_EPS);
    }
};

struct EpiSwiglu {
    static constexpr bool PERM = true, MID = false;
    h16* O; RowScale rs;
    __device__ __forceinline__ void operator()(const f32x4 (&acc)[2][2][4][2], const Unit& u, int wr, int wc, int fr, int fq) const {
        const int row0 = u.pm * BM + wr * 64 + fr, col0 = u.pn * 128 + wc * 32 + 8 * fq;
#pragma unroll
        for (int ai = 0; ai < 2; ++ai)
#pragma unroll
            for (int m = 0; m < 4; ++m) {
                const int row = row0 + ai * HALF + m * 16; const float s = rs(row);
                float o[8];
#pragma unroll
                for (int n = 0; n < 2; ++n)
#pragma unroll
                    for (int i = 0; i < 4; ++i) { const float g = acc[ai][0][m][n][i] * s, v = acc[ai][1][m][n][i] * s; o[4 * n + i] = fsilu(g) * v; }
                u32x4 w; w.x = pkh(o[0], o[1]); w.y = pkh(o[2], o[3]); w.z = pkh(o[4], o[5]); w.w = pkh(o[6], o[7]);
                *(u32x4*)(O + (size_t)row * FF + col0) = w;
            }
    }
};
struct EpiP {
    static constexpr bool PERM = true, MID = false;
    h16 *paq, *z, *gt; RowScale rs;
    __device__ __forceinline__ void operator()(const f32x4 (&acc)[2][2][4][2], const Unit& u, int wr, int wc, int fr, int fq) const {
        h16* base; int ld, colt;
        if (u.pn < 13) { base = paq; ld = PAQ_W; colt = u.pn * BM; } else if (u.pn < 15) { base = z; ld = Z_W; colt = (u.pn - 13) * BM; } else { base = gt; ld = GT_P; colt = (u.pn - 15) * BM; }
        const int row0 = u.pm * BM + wr * 64 + fr, col0 = colt + wc * 32 + 8 * fq;
#pragma unroll
        for (int ai = 0; ai < 2; ++ai)
#pragma unroll
            for (int m = 0; m < 4; ++m) {
                const int row = row0 + ai * HALF + m * 16; const float s = rs(row);
#pragma unroll
                for (int bj = 0; bj < 2; ++bj) {
                    f32x4 a = acc[ai][bj][m][0] * s, b = acc[ai][bj][m][1] * s;
                    if (u.pn >= 15) {
#pragma unroll
                        for (int i = 0; i < 4; ++i) { a[i] = fmaxf(fsigmoid(a[i]), 1e-7f); b[i] = fmaxf(fsigmoid(b[i]), 1e-7f); }
                    }
                    u32x4 w; w.x = pkh(a.x, a.y); w.y = pkh(a.z, a.w); w.z = pkh(b.x, b.y); w.w = pkh(b.z, b.w);
                    *(u32x4*)(base + (size_t)row * ld + col0 + bj * HALF) = w;
                }
            }
    }
};
struct EpiResid {
    static constexpr bool PERM = false, MID = false;
    const float* base0; const float* base1; int split_row;
    float* out; h16* outh; float* ssq; float alpha;
    __device__ __forceinline__ void operator()(const f32x4 (&acc)[2][2][4][2], const Unit& u, int wr, int wc, int fr, int fq) const {
        const int row0 = u.pm * BM + wr * 64 + fr, col0 = u.pn * BM + wc * 32 + 4 * fq;
#pragma unroll
        for (int ai = 0; ai < 2; ++ai)
#pragma unroll
            for (int m = 0; m < 4; ++m) {
                const int row = row0 + ai * HALF + m * 16;
                const float* bp = (row < split_row) ? base0 + (size_t)row * D : base1 + (size_t)(row - split_row) * D;
                float s = 0.f;
#pragma unroll
                for (int bj = 0; bj < 2; ++bj)
#pragma unroll
                    for (int n = 0; n < 2; ++n) {
                        const int col = col0 + bj * HALF + n * 16;
                        const f32x4 bv = *(const f32x4*)(bp + col); const f32x4 o = bv + acc[ai][bj][m][n] * alpha;
                        *(f32x4*)(out + (size_t)row * D + col) = o;
                        if (outh) { u32x2 w; w.x = pkh(o.x, o.y); w.y = pkh(o.z, o.w); *(u32x2*)(outh + (size_t)row * D + col) = w; }
                        s += (o.x * o.x + o.y * o.y) + (o.z * o.z + o.w * o.w);
                    }
                s += __shfl_xor(s, 16); s += __shfl_xor(s, 32);
                if (fq == 0) ssq[(size_t)row * 16 + u.pn * 4 + wc] = s;
            }
    }
};
struct EpiMerge {
    static constexpr bool PERM = true, MID = true;
    const h16* gt; h16* O; int mid_t;
    __device__ __forceinline__ void mid(f32x4 (&acc)[2][2][4][2], const Unit& u, int wr, int wc, int fr, int fq) const {
        asm volatile("" : "+v"(fr), "+v"(fq));
        const int row0 = u.pm * BM + wr * 64 + fr, col0 = u.pn * BM + wc * 32 + 8 * fq;
#pragma unroll
        for (int ai = 0; ai < 2; ++ai)
#pragma unroll
            for (int m = 0; m < 4; ++m) {
                const h16* gp = gt + (size_t)(row0 + ai * HALF + m * 16) * GT_P + col0;
#pragma unroll
                for (int bj = 0; bj < 2; ++bj) {
                    const u32x4 ga = *(const u32x4*)(gp + bj * HALF), gb = *(const u32x4*)(gp + 1024 + bj * HALF);
                    const f32x4 a0 = unpk4((u32x2){ga.x, ga.y}), a1 = unpk4((u32x2){ga.z, ga.w}), b0 = unpk4((u32x2){gb.x, gb.y}), b1 = unpk4((u32x2){gb.z, gb.w});
                    f32x4 r0, r1;
#pragma unroll
                    for (int i = 0; i < 4; ++i) { r0[i] = a0[i] * frcp(b0[i]); r1[i] = a1[i] * frcp(b1[i]); }
                    acc[ai][bj][m][0] *= r0; acc[ai][bj][m][1] *= r1;
                    asm volatile("" ::: "memory");
                }
            }
    }
    __device__ __forceinline__ void operator()(const f32x4 (&acc)[2][2][4][2], const Unit& u, int wr, int wc, int fr, int fq) const {
        const int row0 = u.pm * BM + wr * 64 + fr, col0 = u.pn * BM + wc * 32 + 8 * fq;
#pragma unroll
        for (int ai = 0; ai < 2; ++ai)
#pragma unroll
            for (int m = 0; m < 4; ++m) {
                const int row = row0 + ai * HALF + m * 16;
                const h16* gp = gt + (size_t)row * GT_P + 1024 + col0;
#pragma unroll
                for (int bj = 0; bj < 2; ++bj) {
                    const u32x4 gb = *(const u32x4*)(gp + bj * HALF);
                    const f32x4 b0 = unpk4((u32x2){gb.x, gb.y}), b1 = unpk4((u32x2){gb.z, gb.w});
                    f32x4 a = acc[ai][bj][m][0], b = acc[ai][bj][m][1];
#pragma unroll
                    for (int i = 0; i < 4; ++i) { a[i] *= b0[i]; b[i] *= b1[i]; }
                    u32x4 w; w.x = pkh(a.x, a.y); w.y = pkh(a.z, a.w); w.z = pkh(b.x, b.y); w.w = pkh(b.z, b.w);
                    *(u32x4*)(O + (size_t)row * D + col0 + bj * HALF) = w;
                }
            }
    }
};

template <class Epi, class Sched>
__device__ __forceinline__ void gemm_phase(LAS unsigned char* lds, const Gemm g, const Sched& S, const Epi& E) {
    const int tid = threadIdx.x, wid = __builtin_amdgcn_readfirstlane(tid >> 6), lane = tid & 63, wr = wid >> 2, wc = wid & 3, fr = lane & 15, fq = lane >> 4;
    const int K = g.K, nt = K / BK, lda = g.lda;
    unsigned voffA[2], voffB[2];
#pragma unroll
    for (int i = 0; i < 2; ++i) { int R, C; stage_rc(tid * 16 + i * 8192, R, C); const int Rb = Epi::PERM ? ((R & ~31) + perm32(R & 31)) : R;
        voffA[i] = (unsigned)(R * lda + C) * 2u; voffB[i] = (unsigned)(Rb * K + C) * 2u; }
    const size_t kstep = (size_t)(BK * 2);
    const size_t hstepA = (size_t)HALF * lda * 2, hstepB = (size_t)HALF * K * 2;
    const size_t tstepA = 2 * hstepA, tstepB = 2 * hstepB;
    const unsigned ldsw = (unsigned)wid * 1024u;
    const int aoff = lds_byte(wr * 64 + fr, fq * 8), boff = lds_byte(wc * 32 + fr, fq * 8);
#define PG8_SA(b, h) (((b) * 2 + (h)) * HTB)
#define PG8_SB(b, h) ((4 + (b) * 2 + (h)) * HTB)
#define PG8_STAGE(bufoff, gbase, voff) do { _Pragma("unroll") for (int _i = 0; _i < 2; ++_i) \
        __builtin_amdgcn_global_load_lds((const unsigned*)((const char*)(gbase) + (voff)[_i]), (LAS unsigned*)(lds + (bufoff) + ldsw + _i * 8192), 16, 0, 0); } while (0)
#define PG8_LDA(dst, b, h) do { _Pragma("unroll") for (int m = 0; m < 4; ++m) _Pragma("unroll") for (int k = 0; k < 2; ++k) dst[m][k] = *(const LAS f16x8*)(lds + PG8_SA(b, h) + aoff + m * 2048 + k * 1024); } while (0)
#define PG8_LDB(dst, b, h) do { _Pragma("unroll") for (int n = 0; n < 2; ++n) _Pragma("unroll") for (int k = 0; k < 2; ++k) dst[n][k] = *(const LAS f16x8*)(lds + PG8_SB(b, h) + boff + n * 2048 + k * 1024); } while (0)
#define PG8_MMA(ai, bj, At, Bt) do { __builtin_amdgcn_s_setprio(1); _Pragma("unroll") for (int m = 0; m < 4; ++m) _Pragma("unroll") for (int n = 0; n < 2; ++n) _Pragma("unroll") for (int k = 0; k < 2; ++k) \
        acc[ai][bj][m][n] = __builtin_amdgcn_mfma_f32_16x16x32_f16(Bt[n][k], At[m][k], acc[ai][bj][m][n], 0, 0, 0); __builtin_amdgcn_s_setprio(0); } while (0)
#define PG8_WAIT_V(n) asm volatile("s_waitcnt vmcnt(" #n ")" ::: "memory")
#define PG8_WAIT_L(n) asm volatile("s_waitcnt lgkmcnt(" #n ")" ::: "memory")
#define PG8_BAR __builtin_amdgcn_s_barrier()
#define PG8_SCHED __builtin_amdgcn_sched_barrier(0)
#define PG8_KBODY \
            const bool last = (t == nt - 2); \
            const char* a1 = cA + (size_t)(t + 1) * kstep; \
            const char* a2 = last ? nA : cA + (size_t)(t + 2) * kstep; const char* b2 = last ? nB : cB + (size_t)(t + 2) * kstep; \
            const char* a3 = a2 + kstep; const char* b3 = b2 + kstep; \
            PG8_LDB(B0, 0, 0); PG8_LDB(B1, 0, 1); PG8_SCHED; PG8_LDA(At, 0, 0); PG8_STAGE(PG8_SA(1, 1), a1 + hstepA, voffA); \
            PG8_WAIT_V(8); PG8_WAIT_L(0); PG8_BAR; PG8_MMA(0, 0, At, B0); PG8_MMA(0, 1, At, B1); PG8_BAR; PG8_SCHED; \
            PG8_LDA(At, 0, 1); PG8_STAGE(PG8_SB(0, 0), b2, voffB); PG8_STAGE(PG8_SB(0, 1), b2 + hstepB, voffB); PG8_STAGE(PG8_SA(0, 0), a2, voffA); \
            PG8_WAIT_V(8); PG8_WAIT_L(0); PG8_BAR; PG8_MMA(1, 0, At, B0); PG8_MMA(1, 1, At, B1); PG8_BAR; PG8_SCHED; \
            PG8_LDB(B0, 1, 0); PG8_LDB(B1, 1, 1); PG8_SCHED; PG8_LDA(At, 1, 0); PG8_STAGE(PG8_SA(0, 1), a2 + hstepA, voffA); \
            PG8_WAIT_V(8); PG8_WAIT_L(0); PG8_BAR; PG8_MMA(0, 0, At, B0); PG8_MMA(0, 1, At, B1); PG8_BAR; PG8_SCHED; \
            PG8_LDA(At, 1, 1); PG8_STAGE(PG8_SB(1, 0), b3, voffB); PG8_STAGE(PG8_SB(1, 1), b3 + hstepB, voffB); PG8_STAGE(PG8_SA(1, 0), a3, voffA); \
            PG8_WAIT_V(8); PG8_WAIT_L(0); PG8_BAR; PG8_MMA(1, 0, At, B0); PG8_MMA(1, 1, At, B1); PG8_BAR; PG8_SCHED;
    Unit cur, nxt; int ui = 0;
    if (!S.next(0, cur)) return;
    f32x4 acc[2][2][4][2];
#pragma unroll
    for (int a = 0; a < 2; ++a)
#pragma unroll
        for (int b = 0; b < 2; ++b)
#pragma unroll
            for (int m = 0; m < 4; ++m)
#pragma unroll
                for (int n = 0; n < 2; ++n) acc[a][b][m][n] = (f32x4){0.f, 0.f, 0.f, 0.f};
    f16x8 At[4][2], B0[2][2], B1[2][2];
    const char* cA = (const char*)g.A + (size_t)cur.pm * tstepA; const char* cB = (const char*)g.Bt + (size_t)cur.pn * tstepB;
    PG8_STAGE(PG8_SB(0, 0), cB, voffB); PG8_STAGE(PG8_SB(0, 1), cB + hstepB, voffB); PG8_STAGE(PG8_SA(0, 0), cA, voffA); PG8_STAGE(PG8_SA(0, 1), cA + hstepA, voffA);
    if (wr == 1) PG8_BAR;
    PG8_WAIT_V(2); PG8_BAR;
    PG8_STAGE(PG8_SB(1, 0), cB + kstep, voffB); PG8_STAGE(PG8_SA(1, 0), cA + kstep, voffA); PG8_STAGE(PG8_SB(1, 1), cB + hstepB + kstep, voffB);
    PG8_WAIT_V(6); PG8_BAR;
    for (;;) {
        const bool has_next = S.next(ui + 1, nxt);
        const char* nA = has_next ? (const char*)g.A + (size_t)nxt.pm * tstepA : cA; const char* nB = has_next ? (const char*)g.Bt + (size_t)nxt.pn * tstepB : cB;
        if constexpr (Epi::MID) {
            for (int t = 0; t < E.mid_t; t += 2) { PG8_KBODY }
            E.mid(acc, cur, wr, wc, fr, fq); PG8_SCHED;
            for (int t = E.mid_t; t < nt; t += 2) { PG8_KBODY }
        } else {
            for (int t = 0; t < nt; t += 2) { PG8_KBODY }
        }
        if (wr == 0) PG8_BAR;
        E(acc, cur, wr, wc, fr, fq);
        if (!has_next) break;
#pragma unroll
        for (int a = 0; a < 2; ++a)
#pragma unroll
            for (int b = 0; b < 2; ++b)
#pragma unroll
                for (int m = 0; m < 4; ++m)
#pragma unroll
                    for (int n = 0; n < 2; ++n) acc[a][b][m][n] = (f32x4){0.f, 0.f, 0.f, 0.f};
        cur = nxt; cA = nA; cB = nB; ++ui;
        if (wr == 1) PG8_BAR;
    }
    PG8_WAIT_V(0);
    PG8_BAR;
#undef PG8_KBODY
#undef PG8_SA
#undef PG8_SB
#undef PG8_STAGE
#undef PG8_LDA
#undef PG8_LDB
#undef PG8_MMA
#undef PG8_WAIT_V
#undef PG8_WAIT_L
#undef PG8_BAR
#undef PG8_SCHED
}
}

struct SResid {
    const float* base; float* out; h16* outh; float* ssq; float alpha;
    __device__ __forceinline__ void operator()(f32x4 sa, f32x4 sb, int row, int col, int pc, int t) const {
        const f32x4 bv = *(const f32x4*)(base + (size_t)row * D + col); const f32x4 o = bv + (sa + sb) * alpha;
        *(f32x4*)(out + (size_t)row * D + col) = o;
        if (outh) { u32x2 w; w.x = pkh(o.x, o.y); w.y = pkh(o.z, o.w); *(u32x2*)(outh + (size_t)row * D + col) = w; }
        float s = (o.x * o.x + o.y * o.y) + (o.z * o.z + o.w * o.w);
        s = row_sum16(s);
        if ((t & 15) == 0) ssq[(size_t)row * 16 + pc] = s;
    }
};
struct SMerge {
    const h16* gt; h16* O;
    __device__ __forceinline__ void operator()(f32x4 sa, f32x4 sb, int row, int col, int pc, int t) const {
        const f32x4 ga = unpk4(*(const u32x2*)(gt + (size_t)row * GT_P + col)), gb = unpk4(*(const u32x2*)(gt + (size_t)row * GT_P + 1024 + col));
        const f32x4 o = ga * sa + gb * sb;
        u32x2 w; w.x = pkh(o.x, o.y); w.y = pkh(o.z, o.w); *(u32x2*)(O + (size_t)row * D + col) = w;
    }
};
template <class SE>
__device__ __forceinline__ void sample_gemm(LAS unsigned char* lds, const h16* A, int lda, const h16* Bt, int K, const SE& E, int piece, int tid) {
    const int w = __builtin_amdgcn_readfirstlane(tid >> 6), lane = tid & 63, n = lane & 15, q = lane >> 4;
    const int pr = piece >> 4, pc = piece & 15, kw = K >> 3, kbeg = w * kw;
    f32x4 acc[2][4];
#pragma unroll
    for (int m = 0; m < 2; ++m)
#pragma unroll
        for (int nn = 0; nn < 4; ++nn) acc[m][nn] = (f32x4){0.f, 0.f, 0.f, 0.f};
    const h16* ap = A + (size_t)(MP + 32 * pr + n) * lda + kbeg + 8 * q;
    const h16* bp = Bt + (size_t)(64 * pc + n) * K + kbeg + 8 * q;
#pragma unroll 4
    for (int k0 = 0; k0 < kw; k0 += 32) {
        f16x8 av[2], bv[4];
#pragma unroll
        for (int m = 0; m < 2; ++m) av[m] = *(const f16x8*)(ap + (size_t)(16 * m) * lda + k0);
#pragma unroll
        for (int nn = 0; nn < 4; ++nn) bv[nn] = *(const f16x8*)(bp + (size_t)(16 * nn) * K + k0);
#pragma unroll
        for (int m = 0; m < 2; ++m)
#pragma unroll
            for (int nn = 0; nn < 4; ++nn) acc[m][nn] = __builtin_amdgcn_mfma_f32_16x16x32_f16(av[m], bv[nn], acc[m][nn], 0, 0, 0);
    }
    LAS float* P = (LAS float*)lds + w * 2048;
#pragma unroll
    for (int m = 0; m < 2; ++m)
#pragma unroll
        for (int nn = 0; nn < 4; ++nn)
#pragma unroll
            for (int i = 0; i < 4; ++i) P[(16 * m + 4 * q + i) * 64 + 16 * nn + n] = acc[m][nn][i];
    LDS_WAIT(); __builtin_amdgcn_s_barrier(); asm volatile("" ::: "memory");
    const int r = tid >> 4, c4 = (tid & 15) * 4;
    const LAS float* Q = (const LAS float*)lds + r * 64 + c4;
    f32x4 sa = *(const LAS f32x4*)(Q), sb = *(const LAS f32x4*)(Q + 4 * 2048);
#pragma unroll
    for (int ww = 1; ww < 4; ++ww) { sa += *(const LAS f32x4*)(Q + ww * 2048); sb += *(const LAS f32x4*)(Q + (4 + ww) * 2048); }
    E(sa, sb, MP + 32 * pr + r, 64 * pc + c4, pc, tid);
    LDS_WAIT(); __builtin_amdgcn_s_barrier(); asm volatile("" ::: "memory");
}

#define XB_TMO      128
#define XB_XCNT(j)  (256  + 64 * (j))
#define XB_XSUB(j)  (1280 + 64 * (j))
#define XB_XGEN(j)  (2304 + 64 * (j))
#define XB_TOP      3328
#define XB_TOPGEN   3392
#define XCD_BAR_WORDS 3456
#define XB_SPIN_CAP (1u << 18)
__device__ __forceinline__ unsigned xb_ld(unsigned* p)              { return __hip_atomic_load(p, __ATOMIC_RELAXED, __HIP_MEMORY_SCOPE_AGENT); }
__device__ __forceinline__ unsigned xb_add(unsigned* p, unsigned v) { return __hip_atomic_fetch_add(p, v, __ATOMIC_RELAXED, __HIP_MEMORY_SCOPE_AGENT); }
__device__ __forceinline__ unsigned xb_xcc_id() { return (unsigned)__builtin_amdgcn_s_getreg((3 << 11) | 20) & 0xFu; }
#define XB_SPIN(cond, bar) do { unsigned _sp = 0; while (cond) { __builtin_amdgcn_s_sleep(1); \
    if ((++_sp & 255u) == 0u) { if (xb_ld(&(bar)[XB_TMO])) break; if (_sp > XB_SPIN_CAP) { atomicAdd(&(bar)[XB_TMO], 1u); break; } } } } while (0)
struct XcdBarrier { unsigned* bar; unsigned x; volatile LAS unsigned* st; };
__device__ __forceinline__ XcdBarrier xcd_barrier_post(unsigned* bar, volatile LAS unsigned* st) {
    XcdBarrier b; b.bar = bar; b.x = xb_xcc_id(); b.st = st;
    if (threadIdx.x == 0) (void)xb_add(&bar[XB_XCNT(b.x)], 1u);
    return b;
}
__device__ __forceinline__ void xcd_barrier_complete(unsigned* bar, unsigned x, unsigned& nloc, unsigned& nx) {
    const unsigned G = gridDim.x * gridDim.y * gridDim.z;
    unsigned sum, cnt, mine, sp = 0u;
    for (;;) {
        sum = 0u; cnt = 0u; mine = 0u;
#pragma unroll
        for (unsigned j = 0; j < 16; ++j) { const unsigned c = xb_ld(&bar[XB_XCNT(j)]); sum += c; cnt += (c > 0u) ? 1u : 0u; mine = (j == x) ? c : mine; }
        if (sum == G) break;
        __builtin_amdgcn_s_sleep(1);
        if ((++sp & 255u) == 0u) { if (xb_ld(&bar[XB_TMO])) break; if (sp > XB_SPIN_CAP) { atomicAdd(&bar[XB_TMO], 1u); break; } }
    }
    nloc = mine > 0u ? mine : 1u; nx = cnt > 0u ? cnt : 1u;
}
__device__ __forceinline__ void xcd_barrier(const XcdBarrier& b) {
    asm volatile("s_waitcnt vmcnt(0)" ::: "memory");
    __syncthreads();
    if (threadIdx.x == 0) {
        unsigned* bar = b.bar;
        __builtin_amdgcn_s_waitcnt(0);
        unsigned nloc = b.st[0], nx = b.st[1];
        if (nloc == 0u) { xcd_barrier_complete(bar, b.x, nloc, nx); b.st[0] = nloc; b.st[1] = nx; }
        const unsigned old = xb_add(&bar[XB_XSUB(b.x)], 1u);
        const unsigned gen = old / nloc;
        if (old + 1u == (gen + 1u) * nloc) {
            __builtin_amdgcn_fence(__ATOMIC_RELEASE, "agent");
            asm volatile("s_waitcnt vmcnt(0)" ::: "memory");
            const unsigned og = xb_add(&bar[XB_TOP], 1u);
            const unsigned tg = og / nx;
            if (og + 1u == (tg + 1u) * nx) xb_add(&bar[XB_TOPGEN], 1u);
            else XB_SPIN(xb_ld(&bar[XB_TOPGEN]) == tg, bar);
            __builtin_amdgcn_fence(__ATOMIC_ACQUIRE, "agent");
            xb_add(&bar[XB_XGEN(b.x)], 1u);
            asm volatile("s_waitcnt vmcnt(0)" ::: "memory");
        } else {
            XB_SPIN(xb_ld(&bar[XB_XGEN(b.x)]) == gen, bar);
            __builtin_amdgcn_fence(__ATOMIC_ACQUIRE, "agent");
            asm volatile("s_waitcnt vmcnt(0)" ::: "memory");
        }
    }
    __syncthreads();
}

struct Args { const float* in[35]; float* out; unsigned char* ws; int ph_lo, ph_hi, li, pad; };
typedef const Args __attribute__((address_space(4)))* KArgs;

struct Frame {
    LAS unsigned char* lds; int tid, lane, wave, G, bx;
};

__device__ __forceinline__ void tr_item(const float* W, int ldw, int k0, int src_col0, const float* kscale, h16* WT, int ldwt, int dst_row0, int dst_k0, LAS float* scr, int lane) {
    float vv[32];
#pragma unroll
    for (int i = 0; i < 32; ++i) { const int kk = 2 * i + (lane >> 5); vv[i] = W[(size_t)(k0 + kk) * ldw + src_col0 + (lane & 31)]; }
    if (kscale) {
#pragma unroll
        for (int i = 0; i < 32; ++i) vv[i] *= kscale[k0 + 2 * i + (lane >> 5)];
    }
#pragma unroll
    for (int i = 0; i < 32; ++i) { const int kk = 2 * i + (lane >> 5); scr[kk * 33 + (lane & 31)] = vv[i]; }
    LDS_WAIT(); asm volatile("" ::: "memory");
    const int c = lane & 7;
#pragma unroll
    for (int j = 0; j < 4; ++j) { const int n = (lane >> 3) + 8 * j; const LAS float* s = scr + (8 * c) * 33 + n;
        u32x4 o; o.x = pkh(s[0 * 33], s[1 * 33]); o.y = pkh(s[2 * 33], s[3 * 33]); o.z = pkh(s[4 * 33], s[5 * 33]); o.w = pkh(s[6 * 33], s[7 * 33]);
        *(u32x4*)(WT + (size_t)(dst_row0 + n) * ldwt + dst_k0 + 8 * c) = o; }
    LDS_WAIT(); asm volatile("" ::: "memory");
}
__device__ __forceinline__ void tr_up_item(const float* Wg, const float* Wu, const float* nrm, h16* WT, int item, LAS float* scr, int lane) {
    const int nblk = 5632 / 32, kb = item / nblk, nb = item % nblk, d0 = nb * 32, pn = d0 >> 8, j0 = d0 & 255;
    const float* src = (j0 < 128) ? Wg : Wu; const int col = 128 * pn + (j0 & 127);
    tr_item(src, FF, 64 * kb, col, nrm, WT, D, d0, 64 * kb, scr, lane);
}
__device__ __forceinline__ void p0_prologue(KArgs a, Frame& F) {
    unsigned char* ws = a->ws; unsigned char* dob = (unsigned char*)a->out;
    LAS float* scr = (LAS float*)(F.lds + F.wave * 16384);
    const int gw = F.bx * NWAVES + F.wave, NGW = F.G * NWAVES;
    constexpr int I_UP = 16 * 176, I_DN = 44 * 32, I_IN = 16 * 184;
    constexpr int NITEMS = I_UP + I_DN + I_IN;
    for (int it = gw; it < NITEMS; it += NGW) {
        int r = it;
        if (r < I_UP) { tr_up_item(a->in[7], a->in[8], a->in[6], (h16*)(dob + DO_W1UP), r, scr, F.lane); continue; } r -= I_UP;
        if (r < I_DN) { const int kb = r / 32, nb = r % 32; tr_item(a->in[9], D, 64 * kb, 32 * nb, nullptr, (h16*)(dob + DO_W1DN), FF, 32 * nb, 64 * kb, scr, F.lane); continue; } r -= I_DN;
        { const int kb = r / 184, nb = r % 184, d0 = 32 * nb; tr_item(a->in[11], 5896, 64 * kb, d0 + (d0 >= PAQ_W ? 8 : 0), a->in[10], (h16*)(dob + DO_WIN), D, d0, 64 * kb, scr, F.lane); }
    }
    {
        const int gt = F.bx * NTHREADS + F.tid, NGT = F.G * NTHREADS;
        h16* wab = (h16*)(ws + WS_WAB); h16* w2t = (h16*)(ws + WS_W2T); h16* a2t = (h16*)(ws + WS_A2T); h16* g2t = (h16*)(ws + WS_G2T);
        for (int i = gt; i < 16 * 1024; i += NGT) { const int j = i >> 10, k = i & 1023; const float v = (j < 8) ? a->in[11][(size_t)k * 5896 + PAQ_W + j] * a->in[10][k] : 0.f; wab[i] = __builtin_bit_cast(h16, (_Float16)v); }
        for (int i = gt; i < 512 * 64; i += NGT) { const int n = i >> 6, k = i & 63; w2t[i] = __builtin_bit_cast(h16, (_Float16)a->in[14][k * 512 + n]); a2t[i] = __builtin_bit_cast(h16, (_Float16)a->in[16][k * 512 + n]); }
        for (int i = gt; i < 512 * 128; i += NGT) { const int n = i >> 7, k = i & 127; g2t[i] = __builtin_bit_cast(h16, (_Float16)a->in[17][k * 512 + n]); }
    }
    h16* xh = (h16*)(ws + WS_A); float* ssq0 = (float*)(ws + WS_SSQ0);
    for (int m0 = gw; m0 < M; m0 += 4 * NGW) {
        f32x4 v[4][4];
#pragma unroll
        for (int r = 0; r < 4; ++r) { const int m = m0 + r * NGW; if (m < M) { const float* xrow = (m < MP) ? a->in[0] + (size_t)m * D : a->in[1] + (size_t)(m - MP) * D; const f32x4* xr = (const f32x4*)xrow + F.lane;
#pragma unroll
            for (int j = 0; j < 4; ++j) v[r][j] = xr[64 * j]; } }
#pragma unroll
        for (int r = 0; r < 4; ++r) { const int m = m0 + r * NGW; if (m < M) { u32x2* o8 = (u32x2*)(xh + (size_t)m * D) + F.lane; float s = 0.f;
#pragma unroll
            for (int j = 0; j < 4; ++j) { const f32x4 t = v[r][j]; s += (t.x * t.x + t.y * t.y) + (t.z * t.z + t.w * t.w); u32x2 w; w.x = pkh(t.x, t.y); w.y = pkh(t.z, t.w); o8[64 * j] = w; }
            s = wave_sum(s);
            if (F.lane == 0) ssq0[(size_t)m * 16] = s; } }
    }
}

__device__ __forceinline__ void ab_gemv(KArgs a, Frame& F) {
    const h16* hh = (const h16*)(a->ws + WS_A); const h16* wab = (const h16*)(a->ws + WS_WAB); float* ab = (float*)(a->ws + WS_AB);
    pg8::RowScale rs{(const float*)(a->ws + WS_SSQ1), 16};
    const int gw = F.bx * NWAVES + F.wave, NGW = F.G * NWAVES, n = F.lane & 15, q = F.lane >> 4;
    for (int tile = gw; tile < M / 16; tile += NGW) {
        const h16* ap = hh + (size_t)(tile * 16 + n) * D + 8 * q; const h16* bp = wab + (size_t)n * D + 8 * q;
        f32x4 acc0 = (f32x4){0.f, 0.f, 0.f, 0.f}, acc1 = acc0;
#pragma unroll 8
        for (int st = 0; st < 32; st += 2) {
            const f16x8 a0 = *(const f16x8*)(ap + 32 * st), b0 = *(const f16x8*)(bp + 32 * st), a1 = *(const f16x8*)(ap + 32 * st + 32), b1 = *(const f16x8*)(bp + 32 * st + 32);
            acc0 = __builtin_amdgcn_mfma_f32_16x16x32_f16(a0, b0, acc0, 0, 0, 0); acc1 = __builtin_amdgcn_mfma_f32_16x16x32_f16(a1, b1, acc1, 0, 0, 0);
        }
        if (n < 8) {
#pragma unroll
            for (int i = 0; i < 4; ++i) { const int row = tile * 16 + 4 * q + i; ab[(size_t)row * 8 + n] = (acc0[i] + acc1[i]) * rs(row); }
        }
    }
}

__device__ __forceinline__ void gdn_prep(KArgs a, Frame& F) {
    const h16* PAQ = (const h16*)(a->ws + WS_PAQ); h16* QK = (h16*)(a->ws + WS_A);
    const float* cwp = a->in[23];
    const int lane = F.lane, arr = lane >> 5, c4 = (lane & 31) * 4;
    const int gw = F.bx * NWAVES + F.wave, NGW = F.G * NWAVES;
    for (int item = gw; item < (M / 4) * 4; item += NGW) {
        const int hh = item & 3, run = item >> 2, row0 = 4 * run;
        const int qcol = (arr ? C_GK : C_Q) + hh * 128 + c4, qch = qcol - C_Q;
        f32x4 cwq[4];
#pragma unroll
        for (int i = 0; i < 4; ++i) cwq[i] = *(const f32x4*)(cwp + i * CONVCH + qch);
        const float qscale = arr ? 1.0f : 0.08838834764831845f;
        const h16* pq = PAQ + (size_t)row0 * PAQ_W + qcol;
        f32x4 w0, w1, w2;
        if (row0 >= MP) { const float* sc = a->in[5] + (size_t)((row0 - MP) >> 2) * 3 * CONVCH + qch; w0 = *(const f32x4*)sc; w1 = *(const f32x4*)(sc + CONVCH); w2 = *(const f32x4*)(sc + 2 * CONVCH); }
        else if ((row0 & (SEQ - 1)) == 0) { w0 = w1 = w2 = (f32x4){0.f, 0.f, 0.f, 0.f}; }
        else { w0 = unpk4(*(const u32x2*)(pq - 3 * PAQ_W)); w1 = unpk4(*(const u32x2*)(pq - 2 * PAQ_W)); w2 = unpk4(*(const u32x2*)(pq - PAQ_W)); }
        f32x4 xs[4];
#pragma unroll
        for (int i = 0; i < 4; ++i) xs[i] = unpk4(*(const u32x2*)(pq + (size_t)i * PAQ_W));
#pragma unroll
        for (int i = 0; i < 4; ++i) {
            f32x4 cv = w0 * cwq[0] + w1 * cwq[1] + w2 * cwq[2] + xs[i] * cwq[3];
            cv.x = fsilu(cv.x); cv.y = fsilu(cv.y); cv.z = fsilu(cv.z); cv.w = fsilu(cv.w);
            float ss = (cv.x * cv.x + cv.y * cv.y) + (cv.z * cv.z + cv.w * cv.w);
            ss = row_sum16(ss); ss += __shfl_xor(ss, 16);
            const float sc = __builtin_amdgcn_rsqf(ss + 1e-6f) * qscale;
            cv = cv * sc;
            u32x2 o; o.x = pkh(cv.x, cv.y); o.y = pkh(cv.z, cv.w);
            *(u32x2*)(QK + (size_t)(row0 + i) * D + arr * 512 + hh * 128 + c4) = o;
            w0 = w1; w1 = w2; w2 = xs[i];
        }
    }
    const int gt = F.bx * NTHREADS + F.tid, NGT = F.G * NTHREADS;
    for (int i = gt; i < NB_P * APROJ; i += NGT) { const int bb = i / APROJ, cc = i % APROJ; a->out[O_SHIFT_P + i] = h2f(PAQ[(size_t)(bb * SEQ + SEQ - 1) * PAQ_W + cc]); }
    for (int i = gt; i < NB_S * APROJ; i += NGT) { const int bb = i / APROJ, cc = i % APROJ; a->out[O_SHIFT_S + i] = h2f(PAQ[(size_t)(MP + bb * TS + TS - 1) * PAQ_W + cc]); }
    for (int i = gt; i < NB_P * 3 * CONVCH; i += NGT) { const int bb = i / (3 * CONVCH), r = (i / CONVCH) % 3, cc = i % CONVCH; a->out[O_CONV_P + i] = h2f(PAQ[(size_t)(bb * SEQ + SEQ - 3 + r) * PAQ_W + C_Q + cc]); }
    for (int i = gt; i < NB_S * 3 * CONVCH; i += NGT) { const int bb = i / (3 * CONVCH), r = (i / CONVCH) % 3, cc = i % CONVCH; a->out[O_CONV_S + i] = h2f(PAQ[(size_t)(MP + bb * TS + 1 + r) * PAQ_W + C_Q + cc]); }
}

constexpr int NBLK_P = SEQ / 16, NBLK = NBLK_P + 4;
constexpr int RX_BYTES = 8192, RY_BYTES = 12288, GY_BYTES = 10752;
constexpr int R_X = 0, R_Y = R_X + 2 * RX_BYTES, G_Y = 0;
static_assert(R_Y + 3 * RY_BYTES <= RING_BYTES && G_Y + 2 * GY_BYTES <= RING_BYTES, "scan LDS");

__device__ __forceinline__ int blk_row0(int j, int b, int sgrp) { return (j < NBLK_P) ? b * SEQ + 16 * j : MP + 16 * (4 * sgrp + (j - NBLK_P)); }
#define WG_BAR() do { asm volatile("s_waitcnt lgkmcnt(0)" ::: "memory"); __builtin_amdgcn_s_barrier(); asm volatile("" ::: "memory"); } while (0)

struct RwkvPre { u32x2 cr, cw, ck, ca, pr, pw, pk, pa; };
struct RwkvOps { u32x2 r, d, k, q, b; unsigned v; };
__device__ __forceinline__ RwkvOps rwkv_ld(const LAS unsigned char* Y, int s, int kq, int vi) {
    RwkvOps o; const LAS unsigned char* p = Y + s * 128 + kq * 8;
    o.r = *(const LAS u32x2*)(p); o.d = *(const LAS u32x2*)(p + 2048); o.k = *(const LAS u32x2*)(p + 4096); o.q = *(const LAS u32x2*)(p + 6144); o.b = *(const LAS u32x2*)(p + 8192);
    o.v = *(const LAS unsigned*)(Y + 10240 + s * 128 + vi * 4);
    return o;
}
__device__ __forceinline__ float rwkv_step(h2& S0, h2& S1, const RwkvOps& p) {
    float sa = __builtin_amdgcn_fdot2(S0, u2h(p.q.x), 0.f, false); sa = __builtin_amdgcn_fdot2(S1, u2h(p.q.y), sa, false);
    sa = -row_sum16(sa);
    const h2 sah = bc2(sa), vv = u2h(p.v);
    S0 = __builtin_elementwise_fma(S0, u2h(p.d.x), __builtin_elementwise_fma(vv, u2h(p.k.x), sah * u2h(p.b.x)));
    S1 = __builtin_elementwise_fma(S1, u2h(p.d.y), __builtin_elementwise_fma(vv, u2h(p.k.y), sah * u2h(p.b.y)));
    float o = __builtin_amdgcn_fdot2(S0, u2h(p.r.x), 0.f, false); o = __builtin_amdgcn_fdot2(S1, u2h(p.r.y), o, false);
    return row_sum16(o);
}

__device__ __forceinline__ void rwkv_role(KArgs a, Frame& F, int c, int mode) {
    const bool do_stage = (mode != 6), do_scan = (mode != 5), do_write = (mode < 3);
    const int w = F.wave, lane = F.lane;
    const int b = c >> 4, h = (c >> 1) & 7, half = c & 1;
    const h16* PAQ = (const h16*)(a->ws + WS_PAQ); h16* OB = (h16*)(a->ws + WS_PAQ) + C_Q; float* bon = (float*)(a->ws + WS_BON);
    const float* mu = a->in[12];
    LAS unsigned char* lds = F.lds;
    const int tsl = lane >> 4, kq = lane & 15;
    const int rwA = w & 3;
    const f32x4 mu_r = *(const f32x4*)(mu + C_R + h * 64 + 4 * kq), mu_w = *(const f32x4*)(mu + C_WD + 4 * kq), mu_k = *(const f32x4*)(mu + C_K + h * 64 + 4 * kq), mu_a = *(const f32x4*)(mu + C_AD + 4 * kq);
    const f32x4 kkw = *(const f32x4*)(a->in[18] + h * 64 + 4 * kq);
    const int o_r = C_R + h * 64 + 4 * kq, o_w = C_WD + 4 * kq, o_k = C_K + h * 64 + 4 * kq, o_a = C_AD + 4 * kq;
    const int sA = 4 * rwA + tsl;
    const int sVv = 2 * w + (lane >> 5), vloc = lane & 31, vcolp = C_V + h * 64 + 32 * half + vloc; const float mu_v = mu[vcolp];
    const int kb = 16 * rwA + kq;
    const float w0b = a->in[13][h * 64 + kb], a0b = a->in[15][h * 64 + kb], kab = a->in[19][h * 64 + kb], rkb = a->in[20][h * 64 + kb];
    f16x8 w2f[2], a2f[2];
    { const h16* w2t = (const h16*)(a->ws + WS_W2T) + (size_t)(h * 64 + kb) * 64 + 8 * tsl; const h16* a2t = (const h16*)(a->ws + WS_A2T) + (size_t)(h * 64 + kb) * 64 + 8 * tsl;
      w2f[0] = *(const f16x8*)w2t; w2f[1] = *(const f16x8*)(w2t + 32); a2f[0] = *(const f16x8*)a2t; a2f[1] = *(const f16x8*)(a2t + 32); }
    const int vi = 4 * w + tsl, vrow = 32 * half + vi;
    h2 S0 = (h2){0, 0}, S1 = (h2){0, 0};
    const int sgrp = b;

#define RW_PREFETCH(j) do { const int row_ = b * SEQ + 16 * (j) + sA; const h16* pc_ = PAQ + (size_t)row_ * PAQ_W; const h16* pp_ = pc_ - (((j) == 0 && sA == 0) ? 0 : PAQ_W); \
        pre.cr = *(const u32x2*)(pc_ + o_r); pre.cw = *(const u32x2*)(pc_ + o_w); pre.ck = *(const u32x2*)(pc_ + o_k); pre.ca = *(const u32x2*)(pc_ + o_a); \
        pre.pr = *(const u32x2*)(pp_ + o_r); pre.pw = *(const u32x2*)(pp_ + o_w); pre.pk = *(const u32x2*)(pp_ + o_k); pre.pa = *(const u32x2*)(pp_ + o_a); } while (0)
#define RW_STAGE_A(j, cr, cw, ck, ca, pr, pw, pk, pa) do { \
        LAS unsigned char* X_ = lds + R_X + ((j) & 1) * RX_BYTES; LAS unsigned char* Y_ = lds + R_Y + ((j) % 3) * RY_BYTES; \
        const f32x4 r_ = cr + (pr - cr) * mu_r, w_ = cw + (pw - cw) * mu_w, k_ = ck + (pk - ck) * mu_k, a_ = ca + (pa - ca) * mu_a; \
        { u32x2 t_; t_.x = pkh(r_.x, r_.y); t_.y = pkh(r_.z, r_.w); *(LAS u32x2*)(Y_ + 0 + sA * 128 + kq * 8) = t_; } \
        { u32x2 t_; t_.x = pkh(ftanh(w_.x), ftanh(w_.y)); t_.y = pkh(ftanh(w_.z), ftanh(w_.w)); *(LAS u32x2*)(X_ + 0 + sA * 128 + kq * 8) = t_; } \
        { u32x2 t_; t_.x = pkh(a_.x, a_.y); t_.y = pkh(a_.z, a_.w); *(LAS u32x2*)(X_ + 2048 + sA * 128 + kq * 8) = t_; } \
        *(LAS f32x4*)(X_ + 4096 + sA * 256 + kq * 16) = k_; \
        const f32x4 kkr_ = k_ * kkw; \
        float ss_ = (kkr_.x * kkr_.x + kkr_.y * kkr_.y) + (kkr_.z * kkr_.z + kkr_.w * kkr_.w); \
        ss_ = row_sum16(ss_); \
        const float inv_ = frcp(fmaxf(__builtin_amdgcn_sqrtf(ss_), 1e-12f)); \
        { const f32x4 kn_ = kkr_ * inv_; u32x2 t_; t_.x = pkh(kn_.x, kn_.y); t_.y = pkh(kn_.z, kn_.w); *(LAS u32x2*)(Y_ + 6144 + sA * 128 + kq * 8) = t_; } } while (0)
#define RW_STAGE_V(j, cv, pv) do { LAS unsigned char* Y_ = lds + R_Y + ((j) % 3) * RY_BYTES; \
        const float vl_ = (cv) + ((pv) - (cv)) * mu_v; *(LAS unsigned*)(Y_ + 10240 + sVv * 128 + vloc * 4) = pkh(vl_, vl_); } while (0)
#define RW_STAGE_B(j) do { \
        LAS unsigned char* X_ = lds + R_X + ((j) & 1) * RX_BYTES; LAS unsigned char* Y_ = lds + R_Y + ((j) % 3) * RY_BYTES; \
        f32x4 wacc_ = (f32x4){0.f, 0.f, 0.f, 0.f}, aacc_ = (f32x4){0.f, 0.f, 0.f, 0.f}; \
        _Pragma("unroll") for (int st_ = 0; st_ < 2; ++st_) { \
            const f16x8 ta_ = *(const LAS f16x8*)(X_ + 0 + kq * 128 + tsl * 16 + st_ * 64); \
            const f16x8 aa_ = *(const LAS f16x8*)(X_ + 2048 + kq * 128 + tsl * 16 + st_ * 64); \
            wacc_ = __builtin_amdgcn_mfma_f32_16x16x32_f16(ta_, w2f[st_], wacc_, 0, 0, 0); \
            aacc_ = __builtin_amdgcn_mfma_f32_16x16x32_f16(aa_, a2f[st_], aacc_, 0, 0, 0); } \
        const int row0_ = blk_row0((j), b, sgrp); \
        _Pragma("unroll") for (int i_ = 0; i_ < 4; ++i_) { \
            const int s_ = 4 * tsl + i_; \
            const float dd_ = fexp(-0.60653065971f * fsigmoid(w0b + wacc_[i_])); \
            const float av_ = fsigmoid(a0b + aacc_[i_]); \
            const float kr_ = *(const LAS float*)(X_ + 4096 + s_ * 256 + kb * 4); \
            const float kkv_ = h2f(*(const LAS h16*)(Y_ + 6144 + s_ * 128 + kb * 2)); \
            const float rv_ = h2f(*(const LAS h16*)(Y_ + 0 + s_ * 128 + kb * 2)); \
            const float kp_ = kr_ * (1.0f + (av_ - 1.0f) * kab); \
            *(LAS h16*)(Y_ + 2048 + s_ * 128 + kb * 2) = __builtin_bit_cast(h16, (_Float16)dd_); \
            *(LAS h16*)(Y_ + 4096 + s_ * 128 + kb * 2) = __builtin_bit_cast(h16, (_Float16)kp_); \
            *(LAS h16*)(Y_ + 8192 + s_ * 128 + kb * 2) = __builtin_bit_cast(h16, (_Float16)(kkv_ * av_)); \
            const float bp_ = row_sum16(rv_ * kp_ * rkb); \
            if (do_write && half == 0 && kq == 0) bon[(size_t)(row0_ + s_) * 32 + h * 4 + rwA] = bp_; } } while (0)

    RwkvPre pre; h16 pcv = 0, ppv = 0;
#define RW_PREFETCH_V(j) do { const int row_ = b * SEQ + 16 * (j) + sVv; pcv = PAQ[(size_t)row_ * PAQ_W + vcolp]; ppv = PAQ[(size_t)(row_ - (((j) == 0 && sVv == 0) ? 0 : 1)) * PAQ_W + vcolp]; } while (0)
    if (w < 4) RW_PREFETCH(0);
    RW_PREFETCH_V(0);
    for (int it = 0; it < NBLK_P + 2; ++it) {
        if (do_stage && it < NBLK_P) {
            if (w < 4) {
                const f32x4 cr = unpk4(pre.cr), cw = unpk4(pre.cw), ck = unpk4(pre.ck), ca = unpk4(pre.ca);
                f32x4 pr = unpk4(pre.pr), pw = unpk4(pre.pw), pk = unpk4(pre.pk), pa = unpk4(pre.pa);
                if (it == 0 && sA == 0) { pr = pw = pk = pa = (f32x4){0.f, 0.f, 0.f, 0.f}; }
                RW_STAGE_A(it, cr, cw, ck, ca, pr, pw, pk, pa);
                if (it + 1 < NBLK_P) RW_PREFETCH(it + 1);
            }
            { const float cv = h2f(pcv); float pv = h2f(ppv); if (it == 0 && sVv == 0) pv = 0.f; RW_STAGE_V(it, cv, pv); if (it + 1 < NBLK_P) RW_PREFETCH_V(it + 1); }
        }
        if (do_stage && w >= 4 && it >= 1 && it - 1 < NBLK_P) RW_STAGE_B(it - 1);
        if (do_scan && it >= 2) {
            const int j = it - 2;
            const LAS unsigned char* Y = lds + R_Y + (j % 3) * RY_BYTES;
            float osave = 0.f;
            RwkvOps cur = rwkv_ld(Y, 0, kq, vi);
#pragma unroll
            for (int s = 0; s < 16; ++s) {
                RwkvOps nxt = cur; if (s < 15) nxt = rwkv_ld(Y, s + 1, kq, vi);
                const float o = rwkv_step(S0, S1, cur);
                osave = (kq == s) ? o : osave; cur = nxt;
            }
            if (do_write) OB[(size_t)(b * SEQ + 16 * j + kq) * PAQ_W + h * 64 + vrow] = __builtin_bit_cast(h16, (_Float16)osave); else asm volatile("" :: "v"(osave));
        }
        WG_BAR();
    }
    if (!do_write) { asm volatile("" :: "v"(S0), "v"(S1)); return; }
    { float* sp = a->out + O_RWKV_P + ((size_t)(b * 8 + h)) * 4096 + vrow * 64 + 4 * kq; *(f32x4*)sp = (f32x4){(float)S0.x, (float)S0.y, (float)S1.x, (float)S1.y}; }
    for (int it = 0; it < 6; ++it) {
        if (it < 4) {
            const int j = NBLK_P + it, row0 = blk_row0(j, b, sgrp);
            if (w < 4) {
                const int row = row0 + sA; const h16* pc = PAQ + (size_t)row * PAQ_W;
                const f32x4 cr = unpk4(*(const u32x2*)(pc + o_r)), cw = unpk4(*(const u32x2*)(pc + o_w)), ck = unpk4(*(const u32x2*)(pc + o_k)), ca = unpk4(*(const u32x2*)(pc + o_a));
                f32x4 pr, pw, pk, pa;
                if ((sA & 3) == 0) {
                    const float* sp = a->in[3] + (size_t)((row - MP) >> 2) * APROJ;
                    pr = *(const f32x4*)(sp + o_r); pw = *(const f32x4*)(sp + o_w); pk = *(const f32x4*)(sp + o_k); pa = *(const f32x4*)(sp + o_a);
                } else {
                    const h16* pp = pc - PAQ_W;
                    pr = unpk4(*(const u32x2*)(pp + o_r)); pw = unpk4(*(const u32x2*)(pp + o_w)); pk = unpk4(*(const u32x2*)(pp + o_k)); pa = unpk4(*(const u32x2*)(pp + o_a));
                }
                RW_STAGE_A(j, cr, cw, ck, ca, pr, pw, pk, pa);
            }
            { const int row = row0 + sVv; const float cv = h2f(PAQ[(size_t)row * PAQ_W + vcolp]);
              const float pv = ((sVv & 3) == 0) ? a->in[3][(size_t)((row - MP) >> 2) * APROJ + vcolp] : h2f(PAQ[(size_t)(row - 1) * PAQ_W + vcolp]);
              RW_STAGE_V(j, cv, pv); }
        }
        if (w >= 4 && it >= 1 && it - 1 < 4) RW_STAGE_B(NBLK_P + it - 1);
        if (it >= 2) {
            const int j = NBLK_P + it - 2; const int row0 = blk_row0(j, b, sgrp);
            const LAS unsigned char* Y = lds + R_Y + (j % 3) * RY_BYTES;
            const size_t sbase = ((size_t)((row0 - MP) >> 2) * 8 + h) * 4096 + vrow * 64 + 4 * kq;
            f32x4 st[4];
#pragma unroll
            for (int q = 0; q < 4; ++q) st[q] = *(const f32x4*)(a->in[2] + sbase + (size_t)q * 8 * 4096);
            float osave = 0.f;
#pragma unroll
            for (int q = 0; q < 4; ++q) {
                S0 = (h2){(_Float16)st[q].x, (_Float16)st[q].y}; S1 = (h2){(_Float16)st[q].z, (_Float16)st[q].w};
#pragma unroll
                for (int s = 4 * q; s < 4 * q + 4; ++s) { const RwkvOps p = rwkv_ld(Y, s, kq, vi); const float o = rwkv_step(S0, S1, p); osave = (kq == s) ? o : osave; }
                *(f32x4*)(a->out + O_RWKV_S + sbase + (size_t)q * 8 * 4096) = (f32x4){(float)S0.x, (float)S0.y, (float)S1.x, (float)S1.y};
            }
            OB[(size_t)(row0 + kq) * PAQ_W + h * 64 + vrow] = __builtin_bit_cast(h16, (_Float16)osave);
        }
        WG_BAR();
    }
#undef RW_PREFETCH
#undef RW_PREFETCH_V
#undef RW_STAGE_A
#undef RW_STAGE_V
#undef RW_STAGE_B
}

struct GdnPre { u32x4 qk; h16 v[4]; float ain, bin, vb; };
struct GdnOps { u32x4 q, k; unsigned v; float eg, beta; unsigned meh; };
__device__ __forceinline__ GdnOps gdn_ld(const LAS unsigned char* Y, int s, int kq, int vi) {
    GdnOps o;
    o.q = *(const LAS u32x4*)(Y + 0 + s * 256 + kq * 16); o.k = *(const LAS u32x4*)(Y + 4096 + s * 256 + kq * 16);
    o.v = *(const LAS unsigned*)(Y + 8192 + s * 128 + vi * 4); o.eg = *(const LAS float*)(Y + 10240 + s * 16); o.beta = *(const LAS float*)(Y + 10240 + s * 16 + 4); o.meh = *(const LAS unsigned*)(Y + 10240 + s * 16 + 8);
    return o;
}
__device__ __forceinline__ float gdn_step(h2 (&S)[4], const GdnOps& p) {
    float ks = __builtin_amdgcn_fdot2(S[1], u2h(p.k.y), __builtin_amdgcn_fdot2(S[0], u2h(p.k.x), 0.f, false), false) + __builtin_amdgcn_fdot2(S[3], u2h(p.k.w), __builtin_amdgcn_fdot2(S[2], u2h(p.k.z), 0.f, false), false);
    ks = row_sum16(ks);
    const float vv = (float)u2h(p.v).x;
    const float dl = vv - p.eg * ks;
    const h2 dlh = bc2(dl), meh = u2h(p.meh);
    S[0] = __builtin_elementwise_fma(u2h(p.k.x), dlh, __builtin_elementwise_fma(S[0], meh, S[0])); S[1] = __builtin_elementwise_fma(u2h(p.k.y), dlh, __builtin_elementwise_fma(S[1], meh, S[1]));
    S[2] = __builtin_elementwise_fma(u2h(p.k.z), dlh, __builtin_elementwise_fma(S[2], meh, S[2])); S[3] = __builtin_elementwise_fma(u2h(p.k.w), dlh, __builtin_elementwise_fma(S[3], meh, S[3]));
    float o = __builtin_amdgcn_fdot2(S[0], u2h(p.q.x), 0.f, false); o = __builtin_amdgcn_fdot2(S[1], u2h(p.q.y), o, false);
    o = __builtin_amdgcn_fdot2(S[2], u2h(p.q.z), o, false); o = __builtin_amdgcn_fdot2(S[3], u2h(p.q.w), o, false);
    return row_sum16(o);
}

__device__ __forceinline__ void gdn_role(KArgs a, Frame& F, int cc, int mode) {
    const bool do_stage = (mode != 4), do_scan = (mode != 3), do_write = (mode < 3);
    const int w = F.wave, lane = F.lane;
    const int b = cc >> 4, hh = (cc >> 2) & 3, qt = cc & 3;
    const h16* PAQ = (const h16*)(a->ws + WS_PAQ); h16* OB = (h16*)(a->ws + WS_PAQ) + C_Q; const float* ab = (const float*)(a->ws + WS_AB);
    const float* cwp = a->in[23];
    LAS unsigned char* lds = F.lds;
    const h16* QK = (const h16*)(a->ws + WS_A);
    const int qarr = w >> 2, qslot = ((w & 3) << 2) + (lane >> 4), qj = lane & 15;
    const int qkoff = qarr * 512 + hh * 128 + 8 * qj;
    const int tsl = lane >> 4, kq = lane & 15;
    const int sV = 2 * w + (lane >> 5), vloc = lane & 31, vcolp = C_GV + hh * 128 + 32 * qt + vloc, vch = vcolp - C_Q;
    float cwv[4];
#pragma unroll
    for (int i = 0; i < 4; ++i) cwv[i] = cwp[i * CONVCH + vch];
    const float negA = -fexp(a->in[24][hh]), dtb = a->in[25][hh];
    const int vi = 4 * w + tsl, vcol = 32 * qt + vi;
    const int sgrp = b;

#define GD_QK(Y_, v_) do { *(LAS u32x4*)((Y_) + qarr * 4096 + qslot * 256 + qj * 16) = (v_); } while (0)
#define GD_GB(Y_, ain_, bin_) do { if (w == 0 && lane < 16) { const float xx_ = (ain_) + dtb; const float sp_ = (xx_ > 20.f) ? xx_ : __logf(1.0f + fexp(xx_)); \
        const float eg_ = fexp(negA * sp_), me_ = eg_ - 1.0f, bt_ = fsigmoid(bin_); *(LAS u32x4*)((Y_) + 10240 + lane * 16) = (u32x4){__builtin_bit_cast(unsigned, bt_ * eg_), __builtin_bit_cast(unsigned, bt_), pkh(me_, me_), 0u}; } } while (0)
#define GD_PREFETCH(j) do { pre.qk = *(const u32x4*)(QK + (size_t)(b * SEQ + 16 * (j) + qslot) * D + qkoff); \
        const int rowv_ = b * SEQ + 16 * (j) + sV; \
        _Pragma("unroll") for (int i_ = 0; i_ < 4; ++i_) { int rr_ = rowv_ - 3 + i_; rr_ = rr_ < b * SEQ ? b * SEQ : rr_; pre.v[i_] = PAQ[(size_t)rr_ * PAQ_W + vcolp]; } \
        pre.vb = ab[(size_t)rowv_ * 8 + 4 + hh]; \
        if (w == 0 && lane < 16) { const int rg_ = b * SEQ + 16 * (j) + lane; pre.ain = ab[(size_t)rg_ * 8 + hh]; pre.bin = ab[(size_t)rg_ * 8 + 4 + hh]; } } while (0)

    {
        constexpr int KP = 272, VP = 80, TP = 68;
        constexpr int GC_KBE = 0, GC_QD = 16 * KP, GC_KD = 32 * KP, GC_QKM = 48 * KP, GC_VB = GC_QKM + 512, GC_EG = GC_VB + 32 * VP, GC_TF = GC_EG + 16, GC_SLOT = ((GC_TF + 16 * TP + 63) / 64) * 64;
        constexpr int RD = 6, TA0 = 2 * GC_SLOT, KQ0 = TA0 + 2048, AB0 = KQ0 + RD * 8192, VR0 = AB0 + RD * 1024, GC_END = VR0 + 8 * 1024;
        static_assert(GC_END <= RING_BYTES, "chunk LDS");
        const int n = lane & 15, q = lane >> 4;
        const int wu = __builtin_amdgcn_readfirstlane(w);
        const int only = (mode >= 11) ? mode - 11 : -1;
#define ROLE_ON(r_) (only < 0 || only == (r_))
#define GC_GATES(a_cur_, b_cur_) \
                const float xx = (a_cur_) + dtb; const float sp = (xx > 20.f) ? xx : __logf(1.0f + fexp(xx)); \
                const float bet = fsigmoid(b_cur_); float gc = negA * sp; \
                gc += dppf<0x111>(gc); gc += dppf<0x112>(gc); gc += dppf<0x114>(gc); gc += dppf<0x118>(gc); \
                const float egi = fexp(gc);
        const int rko = n * 256 + ((q & 1) << 3), rkx = (q >> 1) ^ n;
#define GC_RAWK(j, t_) (*(const LAS u32x2*)(lds + KQ0 + ((j) % RD) * 8192 + rko + (((2 * (t_)) ^ rkx) << 4)))
#define GC_RAWQ(j, t_) (*(const LAS u32x2*)(lds + KQ0 + ((j) % RD) * 8192 + 4096 + rko + (((2 * (t_)) ^ rkx) << 4)))
#define GC_LD_AB(j) do { const LAS unsigned char* abp_ = lds + AB0 + ((j) % RD) * 1024 + n * 32 + hh * 4; pa_in = *(const LAS float*)abp_; pb_in = *(const LAS float*)(abp_ + 16); } while (0)
        if (wu < 2) {
            f32x4 Sc[8];
#pragma unroll
            for (int t = 0; t < 8; ++t) Sc[t] = (f32x4){0.f, 0.f, 0.f, 0.f};
            WG_BAR();
            for (int it = -1; it <= NBLK_P; ++it) {
                if (it >= 1 && ROLE_ON(4)) {
                    const int jc = it - 1; const LAS unsigned char* L = lds + (jc & 1) * GC_SLOT;
                    f16x4 Sb[8];
#pragma unroll
                    for (int t = 0; t < 8; ++t) Sb[t] = cvt4(Sc[t]);
                    f32x4 X = *(const LAS f32x4*)(L + GC_VB + (16 * w + n) * VP + 16 * q);
                    f32x4 Oa = (f32x4){0.f, 0.f, 0.f, 0.f};
#pragma unroll
                    for (int t = 0; t < 8; ++t) {
                        X = MFMA16(*(const LAS f16x4*)(L + GC_KBE + n * KP + (16 * t + 4 * q) * 2), Sb[t], X);
                        Oa = MFMA16(*(const LAS f16x4*)(L + GC_QD + n * KP + (16 * t + 4 * q) * 2), Sb[t], Oa);
                    }
                    f32x4 VN = (f32x4){0.f, 0.f, 0.f, 0.f};
#pragma unroll
                    for (int s_ = 0; s_ < 4; ++s_) VN = __builtin_amdgcn_mfma_f32_16x16x4f32(*(const LAS float*)(L + GC_TF + n * TP + (4 * q + s_) * 4), X[s_], VN, 0, 0, 0);
                    const f16x4 VNb = cvt4(VN);
                    Oa = MFMA16(*(const LAS f16x4*)(L + GC_QKM + n * 32 + 8 * q), VNb, Oa);
                    const float eg15 = *(const LAS float*)(L + GC_EG);
                    const LAS unsigned char* kdp = L + GC_KD + (4 * q + (n >> 2)) * KP + (4 * (n & 3)) * 2;
#pragma unroll
                    for (int t = 0; t < 8; ++t) {
                        const f16x4 kdt = __builtin_bit_cast(f16x4, __builtin_amdgcn_ds_read_tr16_b64_v4i16((LAS v4i16_t*)(kdp + 32 * t)));
                        Sc[t] = MFMA16(kdt, VNb, Sc[t] * eg15);
                    }
                    if (do_write) {
#pragma unroll
                        for (int r = 0; r < 4; ++r) OB[(size_t)(b * SEQ + 16 * jc + 4 * q + r) * PAQ_W + 512 + hh * 128 + 32 * qt + 16 * w + n] = __builtin_bit_cast(h16, (_Float16)Oa[r]);
                    }
                }
                WG_BAR();
            }
            if (do_write) {
#pragma unroll
                for (int t = 0; t < 8; ++t)
#pragma unroll
                    for (int r = 0; r < 4; ++r) a->out[O_DELTA_P + ((size_t)(b * 4 + hh)) * 16384 + (size_t)(16 * t + 4 * q + r) * 128 + 32 * qt + 16 * w + n] = Sc[t][r];
            }
        } else if (wu < 4) {
            const int tp = wu - 2;
            LAS unsigned char* TA = lds + 2 * GC_SLOT + tp * 1024;
            float pa_in = 0.f, pb_in = 0.f;
            float tc[16];
#pragma unroll
            for (int r = 0; r < 16; ++r) tc[r] = 0.f;
            WG_BAR();
            for (int it = -1; it <= NBLK_P; ++it) {
                const int c1 = it + 1;
                if (!ROLE_ON(0)) {} else if ((c1 & 1) == tp && c1 < NBLK_P) {
                    GC_LD_AB(c1);
                    u32x2 kfr[8];
#pragma unroll
                    for (int t = 0; t < 8; ++t) kfr[t] = GC_RAWK(c1, t);
                    GC_GATES(pa_in, pb_in) (void)egi;
                    f32x4 kk = (f32x4){0.f, 0.f, 0.f, 0.f};
#pragma unroll
                    for (int t = 0; t < 8; ++t) kk = MFMA16(u2q(kfr[t]), u2q(kfr[t]), kk);
#pragma unroll
                    for (int r = 0; r < 4; ++r) { const int i = 4 * q + r; const float gci = __shfl(gc, i + (lane & 48)), bi = __shfl(bet, i + (lane & 48));
                        *(LAS float*)(TA + (i * 16 + n) * 4) = (i > n) ? bi * kk[r] * fexp(fminf(gci - gc, 0.f)) : 0.f; }
                    LDS_WAIT();
#pragma unroll
                    for (int r = 0; r < 8; ++r) {
                        float arow[8];
#pragma unroll
                        for (int m4 = 0; 4 * m4 < r; ++m4) { const f32x4 av = *(const LAS f32x4*)(TA + (r * 16 + 4 * m4) * 4); arow[4 * m4] = av.x; arow[4 * m4 + 1] = av.y; arow[4 * m4 + 2] = av.z; arow[4 * m4 + 3] = av.w; }
                        float a0 = (r == n) ? 1.0f : 0.0f, a1 = 0.f;
#pragma unroll
                        for (int m = 0; m + 1 < r; m += 2) { a0 -= arow[m] * tc[m]; a1 -= arow[m + 1] * tc[m + 1]; }
                        if (r & 1) a0 -= arow[r - 1] * tc[r - 1];
                        tc[r] = a0 + a1;
                    }
                } else if ((it & 1) == tp && it >= 0 && it < NBLK_P) {
                    LAS unsigned char* L = lds + (it & 1) * GC_SLOT;
#pragma unroll
                    for (int r = 8; r < 16; ++r) {
                        float arow[16];
#pragma unroll
                        for (int m4 = 0; 4 * m4 < r; ++m4) { const f32x4 av = *(const LAS f32x4*)(TA + (r * 16 + 4 * m4) * 4); arow[4 * m4] = av.x; arow[4 * m4 + 1] = av.y; arow[4 * m4 + 2] = av.z; arow[4 * m4 + 3] = av.w; }
                        float a0 = (r == n) ? 1.0f : 0.0f, a1 = 0.f;
#pragma unroll
                        for (int m = 0; m + 1 < r; m += 2) { a0 -= arow[m] * tc[m]; a1 -= arow[m + 1] * tc[m + 1]; }
                        if (r & 1) a0 -= arow[r - 1] * tc[r - 1];
                        tc[r] = a0 + a1;
                    }
                    if (q == 0) {
#pragma unroll
                        for (int r = 0; r < 16; ++r) *(LAS float*)(L + GC_TF + r * TP + n * 4) = tc[r];
                    }
                }
                WG_BAR();
            }
        } else if (wu == 4) {
            float pa_in = 0.f, pb_in = 0.f;
            WG_BAR();
            for (int it = -1; it <= NBLK_P; ++it) {
                if (it >= 0 && it < NBLK_P && ROLE_ON(1)) {
                    LAS unsigned char* L = lds + (it & 1) * GC_SLOT;
                    GC_LD_AB(it);
                    u32x2 kfr[8], qfr[8];
#pragma unroll
                    for (int t = 0; t < 8; ++t) { kfr[t] = GC_RAWK(it, t); qfr[t] = GC_RAWQ(it, t); }
                    GC_GATES(pa_in, pb_in)
                    const _Float16 s1 = (_Float16)(-bet * egi), s2 = (_Float16)egi, s3 = (_Float16)fexp(__shfl(gc, 15 + (lane & 48)) - gc);
#pragma unroll
                    for (int t = 0; t < 8; ++t) {
                        *(LAS f16x4*)(L + GC_KBE + n * KP + (16 * t + 4 * q) * 2) = u2q(kfr[t]) * s1;
                        *(LAS f16x4*)(L + GC_QD + n * KP + (16 * t + 4 * q) * 2) = u2q(qfr[t]) * s2;
                        *(LAS f16x4*)(L + GC_KD + n * KP + (16 * t + 4 * q) * 2) = u2q(kfr[t]) * s3;
                    }
                    if (lane == 15) *(LAS float*)(L + GC_EG) = egi;
                }
                WG_BAR();
            }
        } else if (wu < 7) {
            float pa_in = 0.f, pb_in = 0.f;
            const int cv_ = C_GV + hh * 128 + 32 * qt + 16 * (wu - 5) + 4 * q;
            f32x4 cw4[4];
#pragma unroll
            for (int i = 0; i < 4; ++i) cw4[i] = *(const f32x4*)(cwp + i * CONVCH + (cv_ - C_Q));
            unsigned go[4];
#pragma unroll
            for (int j = 0; j < 4; ++j) { const int tk = 4 * j + q; go[j] = (unsigned)((tk * D + (wu == 5 ? 512 : 0) + hh * 128 + 8 * (n ^ tk)) * 2); }
            const unsigned go4 = (wu == 5) ? (unsigned)(lane * 16) : (unsigned)((((lane >> 2) * PAQ_W) + C_GV + hh * 128 + 32 * qt + 8 * (lane & 3)) * 2);
            const unsigned char* g4 = (wu == 5) ? (const unsigned char*)(ab + (size_t)(b * SEQ) * 8) : (const unsigned char*)(PAQ + (size_t)(b * SEQ) * PAQ_W);
            const size_t g4s = (wu == 5) ? 16 * 8 * 4 : (size_t)16 * PAQ_W * 2;
            const unsigned char* gkq = (const unsigned char*)(QK + (size_t)(b * SEQ) * D);
#define GC_DMA(j) do { const unsigned char* gb_ = gkq + (size_t)(j) * (16 * D * 2); LAS unsigned char* ld_ = lds + KQ0 + ((j) % RD) * 8192 + (wu == 5 ? 0 : 4096); \
                _Pragma("unroll") for (int j_ = 0; j_ < 4; ++j_) __builtin_amdgcn_global_load_lds((const unsigned*)(gb_ + go[j_]), (LAS unsigned*)(ld_ + j_ * 1024), 16, 0, 0); \
                __builtin_amdgcn_global_load_lds((const unsigned*)(g4 + (size_t)(j) * g4s + go4), (LAS unsigned*)(lds + (wu == 5 ? AB0 + ((j) % RD) * 1024 : VR0 + ((j) & 7) * 1024)), 16, 0, 0); } while (0)
#pragma unroll
            for (int j = 0; j < RD - 2; ++j) GC_DMA(j);
            asm volatile("s_waitcnt vmcnt(0)" ::: "memory");
            WG_BAR();
            for (int it = -1; it <= NBLK_P; ++it) {
                if (it + RD - 1 < NBLK_P) GC_DMA(it + RD - 1);
                if (it >= 0 && it < NBLK_P && ROLE_ON(2)) {
                    LAS unsigned char* L = lds + (it & 1) * GC_SLOT;
                    GC_LD_AB(it);
                    const float bet = fsigmoid(pb_in);
                    const int tt = 16 * it + n;
                    f32x4 acc = (f32x4){0.f, 0.f, 0.f, 0.f};
#pragma unroll
                    for (int i = 0; i < 4; ++i) { const f32x4 x = unpk4(*(const LAS u32x2*)(lds + VR0 + ((tt - 3 + i) & 127) * 64 + (wu - 5) * 32 + q * 8)); if (tt - 3 + i >= 0) acc += x * cw4[i]; }
#pragma unroll
                    for (int e = 0; e < 4; ++e) *(LAS float*)(L + GC_VB + (16 * (wu - 5) + 4 * q + e) * VP + n * 4) = bet * fsilu(acc[e]);
                }
                if (it + RD - 1 < NBLK_P) asm volatile("s_waitcnt vmcnt(%0)" :: "n"(5 * (RD - 3)) : "memory"); else asm volatile("s_waitcnt vmcnt(0)" ::: "memory");
                WG_BAR();
            }
#undef GC_DMA
        } else {
            float pa_in = 0.f, pb_in = 0.f;
            WG_BAR();
            for (int it = -1; it <= NBLK_P; ++it) {
                if (it >= 0 && it < NBLK_P && ROLE_ON(3)) {
                    LAS unsigned char* L = lds + (it & 1) * GC_SLOT;
                    GC_LD_AB(it);
                    u32x2 kfr[8], qfr[8];
#pragma unroll
                    for (int t = 0; t < 8; ++t) { kfr[t] = GC_RAWK(it, t); qfr[t] = GC_RAWQ(it, t); }
                    GC_GATES(pa_in, pb_in) (void)egi; (void)bet;
                    f32x4 qk = (f32x4){0.f, 0.f, 0.f, 0.f};
#pragma unroll
                    for (int t = 0; t < 8; ++t) qk = MFMA16(u2q(qfr[t]), u2q(kfr[t]), qk);
#pragma unroll
                    for (int r = 0; r < 4; ++r) { const int i = 4 * q + r; const float gci = __shfl(gc, i + (lane & 48));
                        const float vq = (i >= n) ? qk[r] * fexp(fminf(gci - gc, 0.f)) : 0.f;
                        *(LAS h16*)(L + GC_QKM + i * 32 + n * 2) = __builtin_bit_cast(h16, (_Float16)vq); }
                }
                WG_BAR();
            }
        }
#undef GC_GATES
#undef GC_LD_AB
#undef GC_RAWK
#undef GC_RAWQ
        if (!do_write && mode != 16 && mode != 17) return;
    }
    static_assert(G_Y + 4 * GY_BYTES <= RING_BYTES, "sample LDS");
    float Sn[32];
#define GD_LDS_STATE(jb_) do { const int row0_ = blk_row0(NBLK_P + (jb_), b, sgrp); \
        const float* sp_ = a->in[4] + ((size_t)((row0_ - MP) >> 2) * 4 + hh) * 16384 + (size_t)(8 * kq) * 128 + vcol; \
        _Pragma("unroll") for (int q_ = 0; q_ < 4; ++q_) _Pragma("unroll") for (int i_ = 0; i_ < 8; ++i_) Sn[q_ * 8 + i_] = (mode == 17) ? 0.f : sp_[(size_t)q_ * 4 * 16384 + i_ * 128]; } while (0)
    GD_LDS_STATE(0);
#pragma unroll
    for (int jb = 0; jb < 4; ++jb) {
        LAS unsigned char* Y = lds + G_Y + jb * GY_BYTES;
        const int row0 = blk_row0(NBLK_P + jb, b, sgrp);
        { const u32x4 qv = *(const u32x4*)(QK + (size_t)(row0 + qslot) * D + qkoff); GD_QK(Y, qv); }
        { const int row = row0 + sV, t = sV & 3; float accv = 0.f;
#pragma unroll
          for (int i = 0; i < 4; ++i) { const int tt = t - 3 + i;
              const float xp = h2f(PAQ[(size_t)(row - 3 + i) * PAQ_W + vcolp]);
              const float xs = a->in[5][((size_t)((row - MP) >> 2) * 3 + (tt < 0 ? 3 + tt : 0)) * CONVCH + vch];
              accv += ((tt >= 0) ? xp : xs) * cwv[i]; }
          const float sv = fsilu(accv) * fsigmoid(ab[(size_t)row * 8 + 4 + hh]); *(LAS unsigned*)(Y + 8192 + sV * 128 + vloc * 4) = pkh(sv, sv); }
        { float ain = 0.f, bin = 0.f; if (w == 0 && lane < 16) { ain = ab[(size_t)(row0 + lane) * 8 + hh]; bin = ab[(size_t)(row0 + lane) * 8 + 4 + hh]; } GD_GB(Y, ain, bin); }
    }
    WG_BAR();
#pragma unroll
    for (int jb = 0; jb < 4; ++jb) {
        const int row0 = blk_row0(NBLK_P + jb, b, sgrp);
        const LAS unsigned char* Y = lds + G_Y + jb * GY_BYTES;
        const size_t sbase = ((size_t)((row0 - MP) >> 2) * 4 + hh) * 16384 + (size_t)(8 * kq) * 128 + vcol;
        h2 Sq[4][4];
#pragma unroll
        for (int q = 0; q < 4; ++q)
#pragma unroll
            for (int i = 0; i < 4; ++i) Sq[q][i] = (h2){(_Float16)Sn[q * 8 + 2 * i], (_Float16)Sn[q * 8 + 2 * i + 1]};
        if (jb + 1 < 4) GD_LDS_STATE(jb + 1);
        float osave = 0.f;
#pragma unroll
        for (int q = 0; q < 4; ++q) {
#pragma unroll
            for (int s = 4 * q; s < 4 * q + 4; ++s) { const GdnOps p = gdn_ld(Y, s, kq, vi); const float o = gdn_step(Sq[q], p); osave = (kq == s) ? o : osave; }
            float* so = a->out + O_DELTA_S + sbase + (size_t)q * 4 * 16384;
            if (do_write) {
#pragma unroll
            for (int i = 0; i < 4; ++i) { so[(2 * i) * 128] = (float)Sq[q][i].x; so[(2 * i + 1) * 128] = (float)Sq[q][i].y; } }
        }
        if (do_write || osave == 123.456f) OB[(size_t)(row0 + kq) * PAQ_W + 512 + hh * 128 + vcol] = __builtin_bit_cast(h16, (_Float16)osave);
    }
    WG_BAR();
#undef GD_LDS_STATE
#undef GD_QK
#undef GD_GB
#undef GD_PREFETCH
}

__device__ __forceinline__ void post_phase(KArgs a, Frame& F) {
    const h16* PAQ = (const h16*)(a->ws + WS_PAQ); const h16* Z = (const h16*)(a->ws + WS_Z); const h16* OI = (const h16*)(a->ws + WS_PAQ) + C_Q; h16* OB = (h16*)(a->ws + WS_A); const float* bon = (const float*)(a->ws + WS_BON);
    const float* mu = a->in[12];
    LAS unsigned char* lds = F.lds;
    const int lane = F.lane, w = F.wave, tsl = lane >> 4, n = lane & 15;
    const h16* g2t = (const h16*)(a->ws + WS_G2T);
    for (int blk = F.bx; blk < M / 16; blk += F.G) {
        const int row0 = blk * 16;
        {
            const int tok = F.tid >> 5, c4 = (F.tid & 31) * 4, row = row0 + tok;
            const bool smp = row >= MP; const int t = smp ? ((row - MP) & 3) : (row & (SEQ - 1));
            const f32x4 cg = unpk4(*(const u32x2*)(PAQ + (size_t)row * PAQ_W + C_GD + c4));
            f32x4 pg;
            if (t > 0) pg = unpk4(*(const u32x2*)(PAQ + (size_t)(row - 1) * PAQ_W + C_GD + c4));
            else if (smp) pg = *(const f32x4*)(a->in[3] + (size_t)((row - MP) >> 2) * APROJ + C_GD + c4);
            else pg = (f32x4){0.f, 0.f, 0.f, 0.f};
            const f32x4 m4 = *(const f32x4*)(mu + C_GD + c4);
            const f32x4 g = cg + (pg - cg) * m4;
            u32x2 o; o.x = pkh(fsigmoid(g.x), fsigmoid(g.y)); o.y = pkh(fsigmoid(g.z), fsigmoid(g.w));
            *(LAS u32x2*)(lds + tok * 256 + c4 * 2) = o;
        }
        __syncthreads();
        {
            f32x4 gacc[4];
#pragma unroll
            for (int nt = 0; nt < 4; ++nt) gacc[nt] = (f32x4){0.f, 0.f, 0.f, 0.f};
#pragma unroll
            for (int st = 0; st < 4; ++st) {
                const f16x8 av = *(const LAS f16x8*)(lds + n * 256 + tsl * 16 + st * 64);
#pragma unroll
                for (int nt = 0; nt < 4; ++nt) {
                    const f16x8 bv = *(const f16x8*)(g2t + (size_t)(w * 64 + nt * 16 + n) * 128 + 8 * tsl + 32 * st);
                    gacc[nt] = __builtin_amdgcn_mfma_f32_16x16x32_f16(av, bv, gacc[nt], 0, 0, 0);
                }
            }
#pragma unroll
            for (int i = 0; i < 4; ++i) {
                const int row = row0 + 4 * tsl + i;
                const bool smp = row >= MP; const int t = smp ? ((row - MP) & 3) : (row & (SEQ - 1));
                float o[4], sum = 0.f;
#pragma unroll
                for (int nt = 0; nt < 4; ++nt) { o[nt] = h2f(OI[(size_t)row * PAQ_W + w * 64 + nt * 16 + n]); sum += o[nt]; }
                const float mean = row_sum16(sum) * (1.0f / 64.0f);
                float var = 0.f;
#pragma unroll
                for (int nt = 0; nt < 4; ++nt) { o[nt] -= mean; var += o[nt] * o[nt]; }
                const float rstd = __builtin_amdgcn_rsqf(row_sum16(var) * (1.0f / 64.0f) + LNX_EPS);
                const f32x4 bp = *(const f32x4*)(bon + (size_t)row * 32 + w * 4);
                const float bonus = (bp.x + bp.y) + (bp.z + bp.w);
#pragma unroll
                for (int nt = 0; nt < 4; ++nt) {
                    const int col = w * 64 + nt * 16 + n;
                    const float cv = h2f(PAQ[(size_t)row * PAQ_W + C_V + col]); float pv;
                    if (t > 0) pv = h2f(PAQ[(size_t)(row - 1) * PAQ_W + C_V + col]); else if (smp) pv = a->in[3][(size_t)((row - MP) >> 2) * APROJ + C_V + col]; else pv = 0.f;
                    const float vl = cv + (pv - cv) * mu[C_V + col];
                    const float val = (o[nt] * rstd * a->in[21][col] + a->in[22][col] + bonus * vl) * gacc[nt][i];
                    o[nt] = val;
                }
                asm volatile("" ::: "memory");
#pragma unroll
                for (int nt = 0; nt < 4; ++nt) OB[(size_t)row * D + w * 64 + nt * 16 + n] = __builtin_bit_cast(h16, (_Float16)o[nt]);
            }
        }
#pragma unroll
        for (int i = 0; i < 2; ++i) {
            const int row = row0 + 2 * w + i, col = tsl * 128 + n * 8;
            const u32x4 ov = *(const u32x4*)(OI + (size_t)row * PAQ_W + 512 + col); const u32x4 zv = *(const u32x4*)(Z + (size_t)row * Z_W + col);
            const f32x4 o0 = unpk4((u32x2){ov.x, ov.y}), o1 = unpk4((u32x2){ov.z, ov.w}), z0 = unpk4((u32x2){zv.x, zv.y}), z1 = unpk4((u32x2){zv.z, zv.w});
            float ss = ((o0.x * o0.x + o0.y * o0.y) + (o0.z * o0.z + o0.w * o0.w)) + ((o1.x * o1.x + o1.y * o1.y) + (o1.z * o1.z + o1.w * o1.w));
            const float rstd = __builtin_amdgcn_rsqf(row_sum16(ss) * (1.0f / 128.0f) + RMS_EPS);
            const f32x4 n0 = *(const f32x4*)(a->in[26] + n * 8), n1 = *(const f32x4*)(a->in[26] + n * 8 + 4);
            f32x4 r0 = o0 * rstd * n0, r1 = o1 * rstd * n1;
            r0.x *= fsilu(z0.x); r0.y *= fsilu(z0.y); r0.z *= fsilu(z0.z); r0.w *= fsilu(z0.w);
            r1.x *= fsilu(z1.x); r1.y *= fsilu(z1.y); r1.z *= fsilu(z1.z); r1.w *= fsilu(z1.w);
            u32x4 wv; wv.x = pkh(r0.x, r0.y); wv.y = pkh(r0.z, r0.w); wv.z = pkh(r1.x, r1.y); wv.w = pkh(r1.z, r1.w);
            *(u32x4*)(OB + (size_t)row * D + 512 + col) = wv;
        }
        __syncthreads();
    }
}

__device__ __forceinline__ void final_norm(KArgs a, Frame& F) {
    pg8::RowScale rs{(const float*)(a->ws + WS_SSQ3), 16};
    const int gw = F.bx * NWAVES + F.wave, NGW = F.G * NWAVES;
    const f32x4* fw = (const f32x4*)a->in[34] + F.lane; f32x4 wv[4];
#pragma unroll
    for (int j = 0; j < 4; ++j) wv[j] = fw[64 * j];
    for (int m = gw; m < M; m += NGW) {
        f32x4* xr = (f32x4*)(a->out + (size_t)m * D) + F.lane; const float s = rs(m);
#pragma unroll
        for (int j = 0; j < 4; ++j) { const f32x4 v = xr[64 * j]; xr[64 * j] = v * s * wv[j]; }
    }
}

__device__ __forceinline__ void late_convert(KArgs a, Frame& F, int part, int nparts) {
    unsigned char* ws = a->ws;
    LAS float* scr = (LAS float*)(F.lds + F.wave * 16384);
    const int gw = part * NWAVES + F.wave, NGW = nparts * NWAVES;
    constexpr int I_UP = 16 * 176, I_DN = 44 * 32, I_PJ = 8 * 32, I_WO = 16 * 32;
    constexpr int NITEMS = I_UP + I_DN + 2 * I_PJ + I_WO;
    for (int it = gw; it < NITEMS; it += NGW) {
        int r = it;
        if (r < I_UP) { tr_up_item(a->in[31], a->in[32], a->in[30], (h16*)(ws + WS_W2UP), r, scr, F.lane); continue; } r -= I_UP;
        if (r < I_DN) { const int kb = r / 32, nb = r % 32; tr_item(a->in[33], D, 64 * kb, 32 * nb, nullptr, (h16*)(ws + WS_W2DN), FF, 32 * nb, 64 * kb, scr, F.lane); continue; } r -= I_DN;
        if (r < I_PJ) { const int kb = r / 32, nb = r % 32; tr_item(a->in[27], D, 64 * kb, 32 * nb, nullptr, (h16*)(ws + WS_WPT), D, 32 * nb, 64 * kb, scr, F.lane); continue; } r -= I_PJ;
        if (r < I_PJ) { const int kb = r / 32, nb = r % 32; tr_item(a->in[28], D, 64 * kb, 32 * nb, nullptr, (h16*)(ws + WS_WPT), D, 32 * nb, 512 + 64 * kb, scr, F.lane); continue; } r -= I_PJ;
        { const int kb = r / 32, nb = r % 32; tr_item(a->in[29], D, 64 * kb, 32 * nb, nullptr, (h16*)(ws + WS_WOUTT), D, 32 * nb, 64 * kb, scr, F.lane); }
    }
}

constexpr int N_PHASES = 12;
__global__ void __launch_bounds__(NTHREADS, 2) mk_fwd(Args args) {
    extern __shared__ __attribute__((aligned(16))) unsigned char lds_raw[];
    Frame F;
    F.lds = (LAS unsigned char*)lds_raw;
    F.tid = threadIdx.x; F.lane = F.tid & 63; F.wave = __builtin_amdgcn_readfirstlane(F.tid >> 6);
    F.G = gridDim.x; F.bx = blockIdx.x;
    volatile LAS unsigned* MISC = (volatile LAS unsigned*)(F.lds + MISC_OFF);
    for (int u = F.tid; u < (LDS_BYTES - LDSCTL_OFF) / 4; u += NTHREADS) ((LAS unsigned*)(F.lds + LDSCTL_OFF))[u] = 0u;
    __syncthreads();
    KArgs ka0 = (KArgs)__builtin_amdgcn_kernarg_segment_ptr();
    unsigned char* ws = ka0->ws;
    XcdBarrier bar; bar.bar = (unsigned*)(ws + WS_CTL) + 1024; bar.x = 0; bar.st = nullptr;
    if (MK_N_LAUNCHES == 1) bar = xcd_barrier_post((unsigned*)(ws + WS_CTL) + 1024, MISC + 8);
    const int lo = ka0->ph_lo, hi = ka0->ph_hi;
#ifndef PH_MASK
#define PH_MASK 0xfff
#endif
#define IN(k) (((PH_MASK >> (k)) & 1) && lo <= (k) && (k) < hi)
#define SEAM(k) do { if (IN(k) && IN((k) + 1)) xcd_barrier(bar); } while (0)
    const int c = F.bx;

#define NREP(k) ((PROBE_REP == (k)) ? 2 : 1)
    if (IN(0)) for (int rep_ = 0; rep_ < NREP(0); ++rep_) { KArgs args = ka0; asm volatile("" : "+s"(args)); unsigned char* ws = args->ws; unsigned char* dob = (unsigned char*)args->out; (void)ws; (void)dob; p0_prologue(args, F); } SEAM(0);
    if (IN(1)) for (int rep_ = 0; rep_ < NREP(1); ++rep_) { KArgs args = ka0; asm volatile("" : "+s"(args)); unsigned char* ws = args->ws; unsigned char* dob = (unsigned char*)args->out; (void)ws; (void)dob;
        pg8::Gemm g{(const h16*)(ws + WS_A), (const h16*)(dob + DO_W1UP), D, D}; pg8::StaticOrder S; S.init(M, 5632, F.G, c);
        pg8::EpiSwiglu E{(h16*)(ws + WS_HID), pg8::RowScale{(const float*)(ws + WS_SSQ0), 1}};
        pg8::gemm_phase(F.lds, g, S, E);
    } SEAM(1);
    if (IN(2)) for (int rep_ = 0; rep_ < NREP(2); ++rep_) { KArgs args = ka0; asm volatile("" : "+s"(args)); unsigned char* ws = args->ws; unsigned char* dob = (unsigned char*)args->out; (void)ws; (void)dob;
        pg8::Gemm g{(const h16*)(ws + WS_HID), (const h16*)(dob + DO_W1DN), FF, FF}; pg8::StaticOrder S; S.init(MP, D, F.G, c);
        pg8::EpiResid E{args->in[0], args->in[1], MP, args->out, (h16*)(ws + WS_A), (float*)(ws + WS_SSQ1), 0.5f};
        pg8::gemm_phase(F.lds, g, S, E);
        SResid SE{args->in[1] - (size_t)MP * D, args->out, (h16*)(ws + WS_A), (float*)(ws + WS_SSQ1), 0.5f};
        if (c < 256) sample_gemm(F.lds, g.A, FF, g.Bt, FF, SE, c, F.tid);
    } SEAM(2);
    if (IN(3)) for (int rep_ = 0; rep_ < NREP(3); ++rep_) { KArgs args = ka0; asm volatile("" : "+s"(args)); unsigned char* ws = args->ws; unsigned char* dob = (unsigned char*)args->out; (void)ws; (void)dob;
        pg8::Gemm g{(const h16*)(ws + WS_A), (const h16*)(dob + DO_WIN), D, D}; pg8::StaticOrder S; S.init(M, NIN, F.G, c);
        pg8::EpiP E{(h16*)(ws + WS_PAQ), (h16*)(ws + WS_Z), (h16*)(ws + WS_GT), pg8::RowScale{(const float*)(ws + WS_SSQ1), 16}};
        pg8::gemm_phase(F.lds, g, S, E);
        ab_gemv(args, F);
    } SEAM(3);
    if (IN(4)) for (int rep_ = 0; rep_ < NREP(4); ++rep_) { KArgs args = ka0; asm volatile("" : "+s"(args)); gdn_prep(args, F); } SEAM(4);
    if (IN(5)) for (int rep_ = 0; rep_ < NREP(5); ++rep_) { KArgs args = ka0; asm volatile("" : "+s"(args)); unsigned char* ws = args->ws; unsigned char* dob = (unsigned char*)args->out; (void)ws; (void)dob;
        const int mode = (MK_N_LAUNCHES == 1) ? 0 : args->pad;
        if (F.G == 256) { if (c < 128) { if (mode == 0 || mode == 1 || mode == 5 || mode == 6 || mode == 8 || mode == 9 || mode == 10) rwkv_role(args, F, c, mode); } else { if (mode == 0 || mode == 2 || mode == 3 || mode == 4 || mode >= 11) gdn_role(args, F, c - 128, mode); if (mode == 0) late_convert(args, F, c - 128, 128); } }
    } SEAM(5);
    if (IN(6)) for (int rep_ = 0; rep_ < NREP(6); ++rep_) { KArgs args = ka0; asm volatile("" : "+s"(args)); unsigned char* ws = args->ws; unsigned char* dob = (unsigned char*)args->out; (void)ws; (void)dob; post_phase(args, F); } SEAM(6);
    if (IN(7)) for (int rep_ = 0; rep_ < NREP(7); ++rep_) { KArgs args = ka0; asm volatile("" : "+s"(args)); unsigned char* ws = args->ws; unsigned char* dob = (unsigned char*)args->out; (void)ws; (void)dob;
        pg8::Gemm g{(const h16*)(ws + WS_A), (const h16*)(ws + WS_WPT), D, D}; pg8::StaticOrder S; S.init(MP, D, F.G, c);
        pg8::EpiMerge E{(const h16*)(ws + WS_GT), (h16*)(ws + WS_MRG), 8};
        pg8::gemm_phase(F.lds, g, S, E);
        SMerge SE{(const h16*)(ws + WS_GT), (h16*)(ws + WS_MRG)};
        if (c < 256) sample_gemm(F.lds, g.A, D, g.Bt, D, SE, c, F.tid);
    } SEAM(7);
    if (IN(8)) for (int rep_ = 0; rep_ < NREP(8); ++rep_) { KArgs args = ka0; asm volatile("" : "+s"(args)); unsigned char* ws = args->ws; unsigned char* dob = (unsigned char*)args->out; (void)ws; (void)dob;
        pg8::Gemm g{(const h16*)(ws + WS_MRG), (const h16*)(ws + WS_WOUTT), D, D}; pg8::StaticOrder S; S.init(MP, D, F.G, c);
        pg8::EpiResid E{args->out, args->out, M, args->out, (h16*)(ws + WS_A), (float*)(ws + WS_SSQ2), 1.0f};
        pg8::gemm_phase(F.lds, g, S, E);
        SResid SE{args->out, args->out, (h16*)(ws + WS_A), (float*)(ws + WS_SSQ2), 1.0f};
        if (c < 256) sample_gemm(F.lds, g.A, D, g.Bt, D, SE, c, F.tid);
    } SEAM(8);
    if (IN(9)) for (int rep_ = 0; rep_ < NREP(9); ++rep_) { KArgs args = ka0; asm volatile("" : "+s"(args)); unsigned char* ws = args->ws; unsigned char* dob = (unsigned char*)args->out; (void)ws; (void)dob;
        pg8::Gemm g{(const h16*)(ws + WS_A), (const h16*)(ws + WS_W2UP), D, D}; pg8::StaticOrder S; S.init(M, 5632, F.G, c);
        pg8::EpiSwiglu E{(h16*)(ws + WS_HID), pg8::RowScale{(const float*)(ws + WS_SSQ2), 16}};
        pg8::gemm_phase(F.lds, g, S, E);
    } SEAM(9);
    if (IN(10)) for (int rep_ = 0; rep_ < NREP(10); ++rep_) { KArgs args = ka0; asm volatile("" : "+s"(args)); unsigned char* ws = args->ws; unsigned char* dob = (unsigned char*)args->out; (void)ws; (void)dob;
        pg8::Gemm g{(const h16*)(ws + WS_HID), (const h16*)(ws + WS_W2DN), FF, FF}; pg8::StaticOrder S; S.init(MP, D, F.G, c);
        pg8::EpiResid E{args->out, args->out, M, args->out, nullptr, (float*)(ws + WS_SSQ3), 0.5f};
        pg8::gemm_phase(F.lds, g, S, E);
        SResid SE{args->out, args->out, nullptr, (float*)(ws + WS_SSQ3), 0.5f};
        if (c < 256) sample_gemm(F.lds, g.A, FF, g.Bt, FF, SE, c, F.tid);
    } SEAM(10);
    if (IN(11)) for (int rep_ = 0; rep_ < NREP(11); ++rep_) { KArgs args = ka0; asm volatile("" : "+s"(args)); unsigned char* ws = args->ws; unsigned char* dob = (unsigned char*)args->out; (void)ws; (void)dob; final_norm(args, F); }
#undef IN
#undef SEAM
}

extern "C" void kernel_launch(void* const* d_in, const int* in_sizes, int n_in, void* d_out, int out_size, void* d_ws, size_t ws_size, hipStream_t stream) {
    static int grid = 0;
    if (grid == 0) {
        if (n_in != 35 || in_sizes[0] != MP * D || in_sizes[1] != MS * D || (size_t)out_size != O_END || ws_size < WS_END) {
            fprintf(stderr, "kernel_launch: unexpected shapes: n_in %d in0 %d out %d ws %zu (need %zu)\n", n_in, n_in > 0 ? in_sizes[0] : -1, out_size, ws_size, (size_t)WS_END); grid = -1; return; }
        int dev = 0, cus = 0, per_cu = 0;
        if (hipGetDevice(&dev) != hipSuccess || hipDeviceGetAttribute(&cus, hipDeviceAttributeMultiprocessorCount, dev) != hipSuccess) { fprintf(stderr, "kernel_launch: device query failed\n"); grid = -1; return; }
        if (hipFuncSetAttribute((const void*)mk_fwd, hipFuncAttributeMaxDynamicSharedMemorySize, LDS_BYTES) != hipSuccess) { fprintf(stderr, "kernel_launch: hipFuncSetAttribute failed\n"); grid = -1; return; }
        if (hipOccupancyMaxActiveBlocksPerMultiprocessor(&per_cu, (const void*)mk_fwd, NTHREADS, LDS_BYTES) != hipSuccess || per_cu < 1) { fprintf(stderr, "kernel_launch: occupancy query says %d blocks per CU\n", per_cu); grid = -1; (void)hipGetLastError(); return; }
        (void)hipGetLastError();
        grid = cus;
        if (grid != 256) fprintf(stderr, "kernel_launch: %d CUs; the scan phase needs exactly 256 workgroups\n", grid);
    }
    if (grid < 0) return;
    (void)hipMemsetAsync((char*)d_ws + WS_CTL, 0, CTL_ZERO_BYTES, stream);
    Args a{};
    for (int i = 0; i < 35; ++i) a.in[i] = (const float*)d_in[i];
    a.out = (float*)d_out; a.ws = (unsigned char*)d_ws;
    if (MK_N_LAUNCHES == 1) {
        a.ph_lo = 0; a.ph_hi = N_PHASES; a.li = 0;
        hipLaunchKernelGGL(mk_fwd, dim3(grid), dim3(NTHREADS), LDS_BYTES, stream, a);
    } else {
        for (int li = 0; li < N_PHASES; ++li) { a.ph_lo = li; a.ph_hi = li + 1; a.li = li; hipLaunchKernelGGL(mk_fwd, dim3(grid), dim3(NTHREADS), LDS_BYTES, stream, a);
            if (li == PROBE_LREP) { a.pad = PROBE_MODE; for (int x_ = 0; x_ < PROBE_NX; ++x_) hipLaunchKernelGGL(mk_fwd, dim3(grid), dim3(NTHREADS), LDS_BYTES, stream, a); a.pad = 0; } }
    }
}
```

```cpp
#include <hip/hip_runtime.h>
#include <cstdio>
#include <cstdint>

#ifndef MK_N_LAUNCHES
#define MK_N_LAUNCHES 1
#endif

#ifndef PROBE_SCAN2
#define PROBE_SCAN2 0
#endif
#ifndef PROBE_MODE
#define PROBE_MODE 0
#endif
#ifndef PROBE_LREP
#define PROBE_LREP -1
#endif
#ifndef PROBE_NX
#define PROBE_NX 4
#endif
#ifndef PROBE_REP
#define PROBE_REP -1
#endif
#define LAS __attribute__((address_space(3)))
#define GAS __attribute__((address_space(1)))
typedef unsigned short h16;
typedef _Float16 f16x8 __attribute__((ext_vector_type(8)));
typedef _Float16 f16x4 __attribute__((ext_vector_type(4)));
typedef _Float16 f16x2 __attribute__((ext_vector_type(2)));
typedef _Float16 h2 __attribute__((ext_vector_type(2)));
typedef _Float16 f16x4 __attribute__((ext_vector_type(4)));
typedef float f32x4 __attribute__((ext_vector_type(4)));
typedef float f32x2 __attribute__((ext_vector_type(2)));
typedef unsigned u32x4 __attribute__((ext_vector_type(4)));
typedef unsigned u32x2 __attribute__((ext_vector_type(2)));
typedef short v4i16_t __attribute__((ext_vector_type(4)));
typedef GAS unsigned gu32;

constexpr int D = 1024, MP = 16384, MS = 512, M = MP + MS, SEQ = 2048, NB_P = 8, NB_S = 128, TS = 4;
constexpr int FF = 2816, APROJ = 1792, CONVCH = 1536;
constexpr int PAQ_W = 3328, Z_W = 512, GT_W = 2048, NIN = PAQ_W + Z_W + GT_W;
constexpr int GT_P = 2112;
constexpr float RMS_EPS = 1e-6f, LNX_EPS = 64e-5f;
constexpr int C_R = 0, C_WD = 512, C_K = 576, C_V = 1088, C_AD = 1600, C_GD = 1664, C_Q = 1792, C_GK = 2304, C_GV = 2816;
constexpr size_t O_Y = 0, O_RWKV_P = 17301504, O_SHIFT_P = 17563648, O_DELTA_P = 17577984, O_CONV_P = 18102272,
                 O_RWKV_S = 18139136, O_SHIFT_S = 22333440, O_DELTA_S = 22562816, O_CONV_S = 30951424, O_END = 31541248;

constexpr size_t MiB = 1u << 20;
constexpr size_t WS_CTL = 0, CTL_ZERO_BYTES = 64 * 1024;
constexpr size_t WS_SSQ0 = 1 * MiB, WS_SSQ1 = WS_SSQ0 + (size_t)M * 64, WS_SSQ2 = WS_SSQ1 + (size_t)M * 64, WS_SSQ3 = WS_SSQ2 + (size_t)M * 64;
constexpr size_t WS_AB = WS_SSQ3 + (size_t)M * 64;
constexpr size_t WS_BON = WS_AB + (size_t)M * 32;
constexpr size_t WS_WAB = WS_BON + (size_t)M * 128;
constexpr size_t WS_W2T = WS_WAB + 32768;
constexpr size_t WS_A2T = WS_W2T + 65536;
constexpr size_t WS_G2T = WS_A2T + 65536;
static_assert(WS_G2T + 131072 <= 8 * MiB, "small arrays");
constexpr size_t WS_A = 8 * MiB;
constexpr size_t WS_WPT = 41 * MiB, WS_WOUTT = 43 * MiB;
constexpr size_t WS_W2UP = 45 * MiB;
constexpr size_t WS_W2DN = 56 * MiB;
constexpr size_t WS_B = 62 * MiB;
constexpr size_t WS_HID = WS_B;
constexpr size_t WS_PAQ = WS_B;
constexpr size_t WS_Z = WS_PAQ + (size_t)M * PAQ_W * 2;
constexpr size_t WS_GT = WS_Z + (size_t)M * Z_W * 2;
constexpr size_t WS_MRG = WS_B;
constexpr size_t WS_END = WS_GT + (size_t)M * GT_P * 2;
static_assert(WS_END <= 256 * MiB, "workspace map");
static_assert(WS_A + (size_t)M * D * 2 <= WS_WPT, "region A");
constexpr size_t DO_W1UP = O_DELTA_S * 4;
constexpr size_t DO_W1DN = DO_W1UP + (size_t)5632 * 1024 * 2;
constexpr size_t DO_WIN = O_RWKV_S * 4;
static_assert(DO_W1DN + (size_t)1024 * 2816 * 2 <= O_CONV_S * 4 && DO_WIN + (size_t)NIN * 1024 * 2 <= O_SHIFT_S * 4, "d_out scratch");

constexpr int NWAVES = 8, NTHREADS = 512;
constexpr int RING_BYTES = 131072, LDSCTL_OFF = RING_BYTES, MISC_OFF = LDSCTL_OFF + 320, LDS_BYTES = 147456;

__device__ __forceinline__ unsigned pkh(float lo, float hi) { f16x2 v; v.x = (_Float16)lo; v.y = (_Float16)hi; return __builtin_bit_cast(unsigned, v); }
__device__ __forceinline__ f32x2 unpk(unsigned u) { f16x2 v = __builtin_bit_cast(f16x2, u); f32x2 r; r.x = (float)v.x; r.y = (float)v.y; return r; }
__device__ __forceinline__ f32x4 unpk4(u32x2 u) { f32x2 a = unpk(u.x), b = unpk(u.y); return (f32x4){a.x, a.y, b.x, b.y}; }
__device__ __forceinline__ float h2f(h16 v) { return (float)__builtin_bit_cast(_Float16, v); }
__device__ __forceinline__ h2 bc2(float x) { const _Float16 h = (_Float16)x; return (h2){h, h}; }
__device__ __forceinline__ h2 u2h(unsigned u) { return __builtin_bit_cast(h2, u); }
__device__ __forceinline__ float fexp(float x) { return __builtin_amdgcn_exp2f(x * 1.44269504089f); }
__device__ __forceinline__ float frcp(float x) { return __builtin_amdgcn_rcpf(x); }
__device__ __forceinline__ float fsigmoid(float x) { return frcp(1.0f + fexp(-x)); }
__device__ __forceinline__ float fsilu(float x) { return x * frcp(1.0f + fexp(-x)); }
__device__ __forceinline__ float ftanh(float x) { return 1.0f - 2.0f * frcp(1.0f + fexp(2.0f * x)); }
template <int CTRL> __device__ __forceinline__ float dppf(float x) { return __builtin_bit_cast(float, __builtin_amdgcn_update_dpp(0, __builtin_bit_cast(int, x), CTRL, 0xF, 0xF, false)); }
__device__ __forceinline__ float row_sum16(float x) { x += dppf<0x128>(x); x += dppf<0x124>(x); x += dppf<0x122>(x); x += dppf<0x121>(x); return x; }
__device__ __forceinline__ float wave_sum(float v) {
#pragma unroll
    for (int o = 1; o < 64; o <<= 1) v += __shfl_xor(v, o);
    return v;
}
#define MFMA16(a_, b_, c_) __builtin_amdgcn_mfma_f32_16x16x16f16(a_, b_, c_, 0, 0, 0)
__device__ __forceinline__ f16x4 cvt4(f32x4 v) { return (f16x4){(_Float16)v.x, (_Float16)v.y, (_Float16)v.z, (_Float16)v.w}; }
__device__ __forceinline__ f16x4 u2q(u32x2 u) { return __builtin_bit_cast(f16x4, u); }
#define LDS_WAIT() asm volatile("s_waitcnt lgkmcnt(0)" ::: "memory")
#define VM_WAIT() asm volatile("s_waitcnt vmcnt(0)" ::: "memory")
#define RLX_AGENT __ATOMIC_RELAXED, __HIP_MEMORY_SCOPE_AGENT

namespace pg8 {
constexpr int BM = 256, BK = 64, HALF = 128, HTB = HALF * BK * 2, STAGE_BYTES = 8 * HTB, NXCD = 8, WGM = 8;
__host__ __device__ __forceinline__ int lds_byte(int r, int c) { const int st = (r >> 4) * 2 + (c >> 5), rr = r & 15, cc = c & 31, ob = rr * 64 + cc * 2; return st * 1024 + (ob ^ (((ob >> 9) & 1) << 5)); }
__host__ __device__ __forceinline__ void stage_rc(int b, int& R, int& C) { const int st = b / 1024, sb = b % 1024, swz = sb ^ (((sb >> 9) & 1) << 5); R = (st >> 1) * 16 + swz / 64; C = (st & 1) * 32 + (swz % 64) / 2; }
__host__ __device__ __forceinline__ int perm32(int rho) { const int n = rho >> 4, i = rho & 15; return 8 * (i >> 2) + 4 * n + (i & 3); }

struct Unit { int pm, pn; };
struct Gemm { const h16* A; const h16* Bt; int lda, K; };

struct StaticOrder {
    int nM, nN, nwg, G, c;
    __device__ void init(int Mr, int N, int G_, int c_) { nM = Mr / BM; nN = N / BM; nwg = nM * nN; G = G_; c = c_; }
    __device__ bool next(int i, Unit& u) const {
        const long L = (long)i * G + c; if (L >= nwg) return false;
        int wgid = (int)L; { const int q = nwg / NXCD, r = nwg % NXCD, xcd = wgid % NXCD, off = wgid / NXCD; wgid = (xcd < r ? xcd * (q + 1) : r * (q + 1) + (xcd - r) * q) + off; }
        const int nig = WGM * nN, gid = wgid / nig, fm = gid * WGM, gsz = (nM - fm) < WGM ? (nM - fm) : WGM;
        u.pm = fm + ((wgid % nig) % gsz); u.pn = (wgid % nig) / gsz; return true;
    }
};

struct RowScale {
    const float* ssq; int np;
    __device__ __forceinline__ float operator()(int row) const {
        const f32x4* p = (const f32x4*)(ssq + (size_t)row * 16); float s;
        if (np == 1) s = ssq[(size_t)row * 16];
        else { f32x4 a = p[0], b = p[1], c = p[2], d = p[3]; s = ((a.x + a.y) + (a.z + a.w)) + ((b.x + b.y) + (b.z + b.w)) + ((c.x + c.y) + (c.z + c.w)) + ((d.x + d.y) + (d.z + d.w)); }
        return __builtin_amdgcn_rsqf(s * (1.0f / 1024.0f) + RMS_EPS);
    }
};

struct EpiSwiglu {
    static constexpr bool PERM = true, MID = false;
    h16* O; RowScale rs;
    __device__ __forceinline__ void operator()(const f32x4 (&acc)[2][2][4][2], const Unit& u, int wr, int wc, int fr, int fq) const {
        const int row0 = u.pm * BM + wr * 64 + fr, col0 = u.pn * 128 + wc * 32 + 8 * fq;
#pragma unroll
        for (int ai = 0; ai < 2; ++ai)
#pragma unroll
            for (int m = 0; m < 4; ++m) {
                const int row = row0 + ai * HALF + m * 16; const float s = rs(row);
                float o[8];
#pragma unroll
                for (int n = 0; n < 2; ++n)
#pragma unroll
                    for (int i = 0; i < 4; ++i) { const float g = acc[ai][0][m][n][i] * s, v = acc[ai][1][m][n][i] * s; o[4 * n + i] = fsilu(g) * v; }
                u32x4 w; w.x = pkh(o[0], o[1]); w.y = pkh(o[2], o[3]); w.z = pkh(o[4], o[5]); w.w = pkh(o[6], o[7]);
                *(u32x4*)(O + (size_t)row * FF + col0) = w;
            }
    }
};
struct EpiP {
    static constexpr bool PERM = true, MID = false;
    h16 *paq, *z, *gt; RowScale rs;
    __device__ __forceinline__ void operator()(const f32x4 (&acc)[2][2][4][2], const Unit& u, int wr, int wc, int fr, int fq) const {
        h16* base; int ld, colt;
        if (u.pn < 13) { base = paq; ld = PAQ_W; colt = u.pn * BM; } else if (u.pn < 15) { base = z; ld = Z_W; colt = (u.pn - 13) * BM; } else { base = gt; ld = GT_P; colt = (u.pn - 15) * BM; }
        const int row0 = u.pm * BM + wr * 64 + fr, col0 = colt + wc * 32 + 8 * fq;
#pragma unroll
        for (int ai = 0; ai < 2; ++ai)
#pragma unroll
            for (int m = 0; m < 4; ++m) {
                const int row = row0 + ai * HALF + m * 16; const float s = rs(row);
#pragma unroll
                for (int bj = 0; bj < 2; ++bj) {
                    f32x4 a = acc[ai][bj][m][0] * s, b = acc[ai][bj][m][1] * s;
                    if (u.pn >= 15) {
#pragma unroll
                        for (int i = 0; i < 4; ++i) { a[i] = fmaxf(fsigmoid(a[i]), 1e-7f); b[i] = fmaxf(fsigmoid(b[i]), 1e-7f); }
                    }
                    u32x4 w; w.x = pkh(a.x, a.y); w.y = pkh(a.z, a.w); w.z = pkh(b.x, b.y); w.w = pkh(b.z, b.w);
                    *(u32x4*)(base + (size_t)row * ld + col0 + bj * HALF) = w;
                }
            }
    }
};
struct EpiResid {
    static constexpr bool PERM = false, MID = false;
    const float* base0; const float* base1; int split_row;
    float* out; h16* outh; float* ssq; float alpha;
    __device__ __forceinline__ void operator()(const f32x4 (&acc)[2][2][4][2], const Unit& u, int wr, int wc, int fr, int fq) const {
        const int row0 = u.pm * BM + wr * 64 + fr, col0 = u.pn * BM + wc * 32 + 4 * fq;
#pragma unroll
        for (int ai = 0; ai < 2; ++ai)
#pragma unroll
            for (int m = 0; m < 4; ++m) {
                const int row = row0 + ai * HALF + m * 16;
                const float* bp = (row < split_row) ? base0 + (size_t)row * D : base1 + (size_t)(row - split_row) * D;
                float s = 0.f;
#pragma unroll
                for (int bj = 0; bj < 2; ++bj)
#pragma unroll
                    for (int n = 0; n < 2; ++n) {
                        const int col = col0 + bj * HALF + n * 16;
                        const f32x4 bv = *(const f32x4*)(bp + col); const f32x4 o = bv + acc[ai][bj][m][n] * alpha;
                        *(f32x4*)(out + (size_t)row * D + col) = o;
                        if (outh) { u32x2 w; w.x = pkh(o.x, o.y); w.y = pkh(o.z, o.w); *(u32x2*)(outh + (size_t)row * D + col) = w; }
                        s += (o.x * o.x + o.y * o.y) + (o.z * o.z + o.w * o.w);
                    }
                s += __shfl_xor(s, 16); s += __shfl_xor(s, 32);
                if (fq == 0) ssq[(size_t)row * 16 + u.pn * 4 + wc] = s;
            }
    }
};
struct EpiMerge {
    static constexpr bool PERM = true, MID = true;
    const h16* gt; h16* O; int mid_t;
    __device__ __forceinline__ void mid(f32x4 (&acc)[2][2][4][2], const Unit& u, int wr, int wc, int fr, int fq) const {
        asm volatile("" : "+v"(fr), "+v"(fq));
        const int row0 = u.pm * BM + wr * 64 + fr, col0 = u.pn * BM + wc * 32 + 8 * fq;
#pragma unroll
        for (int ai = 0; ai < 2; ++ai)
#pragma unroll
            for (int m = 0; m < 4; ++m) {
                const h16* gp = gt + (size_t)(row0 + ai * HALF + m * 16) * GT_P + col0;
#pragma unroll
                for (int bj = 0; bj < 2; ++bj) {
                    const u32x4 ga = *(const u32x4*)(gp + bj * HALF), gb = *(const u32x4*)(gp + 1024 + bj * HALF);
                    const f32x4 a0 = unpk4((u32x2){ga.x, ga.y}), a1 = unpk4((u32x2){ga.z, ga.w}), b0 = unpk4((u32x2){gb.x, gb.y}), b1 = unpk4((u32x2){gb.z, gb.w});
                    f32x4 r0, r1;
#pragma unroll
                    for (int i = 0; i < 4; ++i) { r0[i] = a0[i] * frcp(b0[i]); r1[i] = a1[i] * frcp(b1[i]); }
                    acc[ai][bj][m][0] *= r0; acc[ai][bj][m][1] *= r1;
                    asm volatile("" ::: "memory");
                }
            }
    }
    __device__ __forceinline__ void operator()(const f32x4 (&acc)[2][2][4][2], const Unit& u, int wr, int wc, int fr, int fq) const {
        const int row0 = u.pm * BM + wr * 64 + fr, col0 = u.pn * BM + wc * 32 + 8 * fq;
#pragma unroll
        for (int ai = 0; ai < 2; ++ai)
#pragma unroll
            for (int m = 0; m < 4; ++m) {
                const int row = row0 + ai * HALF + m * 16;
                const h16* gp = gt + (size_t)row * GT_P + 1024 + col0;
#pragma unroll
                for (int bj = 0; bj < 2; ++bj) {
                    const u32x4 gb = *(const u32x4*)(gp + bj * HALF);
                    const f32x4 b0 = unpk4((u32x2){gb.x, gb.y}), b1 = unpk4((u32x2){gb.z, gb.w});
                    f32x4 a = acc[ai][bj][m][0], b = acc[ai][bj][m][1];
#pragma unroll
                    for (int i = 0; i < 4; ++i) { a[i] *= b0[i]; b[i] *= b1[i]; }
                    u32x4 w; w.x = pkh(a.x, a.y); w.y = pkh(a.z, a.w); w.z = pkh(b.x, b.y); w.w = pkh(b.z, b.w);
                    *(u32x4*)(O + (size_t)row * D + col0 + bj * HALF) = w;
                }
            }
    }
};

template <class Epi, class Sched>
__device__ __forceinline__ void gemm_phase(LAS unsigned char* lds, const Gemm g, const Sched& S, const Epi& E) {
    const int tid = threadIdx.x, wid = __builtin_amdgcn_readfirstlane(tid >> 6), lane = tid & 63, wr = wid >> 2, wc = wid & 3, fr = lane & 15, fq = lane >> 4;
    const int K = g.K, nt = K / BK, lda = g.lda;
    unsigned voffA[2], voffB[2];
#pragma unroll
    for (int i = 0; i < 2; ++i) { int R, C; stage_rc(tid * 16 + i * 8192, R, C); const int Rb = Epi::PERM ? ((R & ~31) + perm32(R & 31)) : R;
        voffA[i] = (unsigned)(R * lda + C) * 2u; voffB[i] = (unsigned)(Rb * K + C) * 2u; }
    const size_t kstep = (size_t)(BK * 2);
    const size_t hstepA = (size_t)HALF * lda * 2, hstepB = (size_t)HALF * K * 2;
    const size_t tstepA = 2 * hstepA, tstepB = 2 * hstepB;
    const unsigned ldsw = (unsigned)wid * 1024u;
    const int aoff = lds_byte(wr * 64 + fr, fq * 8), boff = lds_byte(wc * 32 + fr, fq * 8);
#define PG8_SA(b, h) (((b) * 2 + (h)) * HTB)
#define PG8_SB(b, h) ((4 + (b) * 2 + (h)) * HTB)
#define PG8_STAGE(bufoff, gbase, voff) do { _Pragma("unroll") for (int _i = 0; _i < 2; ++_i) \
        __builtin_amdgcn_global_load_lds((const unsigned*)((const char*)(gbase) + (voff)[_i]), (LAS unsigned*)(lds + (bufoff) + ldsw + _i * 8192), 16, 0, 0); } while (0)
#define PG8_LDA(dst, b, h) do { _Pragma("unroll") for (int m = 0; m < 4; ++m) _Pragma("unroll") for (int k = 0; k < 2; ++k) dst[m][k] = *(const LAS f16x8*)(lds + PG8_SA(b, h) + aoff + m * 2048 + k * 1024); } while (0)
#define PG8_LDB(dst, b, h) do { _Pragma("unroll") for (int n = 0; n < 2; ++n) _Pragma("unroll") for (int k = 0; k < 2; ++k) dst[n][k] = *(const LAS f16x8*)(lds + PG8_SB(b, h) + boff + n * 2048 + k * 1024); } while (0)
#define PG8_MMA(ai, bj, At, Bt) do { __builtin_amdgcn_s_setprio(1); _Pragma("unroll") for (int m = 0; m < 4; ++m) _Pragma("unroll") for (int n = 0; n < 2; ++n) _Pragma("unroll") for (int k = 0; k < 2; ++k) \
        acc[ai][bj][m][n] = __builtin_amdgcn_mfma_f32_16x16x32_f16(Bt[n][k], At[m][k], acc[ai][bj][m][n], 0, 0, 0); __builtin_amdgcn_s_setprio(0); } while (0)
#define PG8_WAIT_V(n) asm volatile("s_waitcnt vmcnt(" #n ")" ::: "memory")
#define PG8_WAIT_L(n) asm volatile("s_waitcnt lgkmcnt(" #n ")" ::: "memory")
#define PG8_BAR __builtin_amdgcn_s_barrier()
#define PG8_SCHED __builtin_amdgcn_sched_barrier(0)
#define PG8_KBODY \
            const bool last = (t == nt - 2); \
            const char* a1 = cA + (size_t)(t + 1) * kstep; \
            const char* a2 = last ? nA : cA + (size_t)(t + 2) * kstep; const char* b2 = last ? nB : cB + (size_t)(t + 2) * kstep; \
            const char* a3 = a2 + kstep; const char* b3 = b2 + kstep; \
            PG8_LDB(B0, 0, 0); PG8_LDB(B1, 0, 1); PG8_SCHED; PG8_LDA(At, 0, 0); PG8_STAGE(PG8_SA(1, 1), a1 + hstepA, voffA); \
            PG8_WAIT_V(8); PG8_WAIT_L(0); PG8_BAR; PG8_MMA(0, 0, At, B0); PG8_MMA(0, 1, At, B1); PG8_BAR; PG8_SCHED; \
            PG8_LDA(At, 0, 1); PG8_STAGE(PG8_SB(0, 0), b2, voffB); PG8_STAGE(PG8_SB(0, 1), b2 + hstepB, voffB); PG8_STAGE(PG8_SA(0, 0), a2, voffA); \
            PG8_WAIT_V(8); PG8_WAIT_L(0); PG8_BAR; PG8_MMA(1, 0, At, B0); PG8_MMA(1, 1, At, B1); PG8_BAR; PG8_SCHED; \
            PG8_LDB(B0, 1, 0); PG8_LDB(B1, 1, 1); PG8_SCHED; PG8_LDA(At, 1, 0); PG8_STAGE(PG8_SA(0, 1), a2 + hstepA, voffA); \
            PG8_WAIT_V(8); PG8_WAIT_L(0); PG8_BAR; PG8_MMA(0, 0, At, B0); PG8_MMA(0, 1, At, B1); PG8_BAR; PG8_SCHED; \
            PG8_LDA(At, 1, 1); PG8_STAGE(PG8_SB(1, 0), b3, voffB); PG8_STAGE(PG8_SB(1, 1), b3 + hstepB, voffB); PG8_STAGE(PG8_SA(1, 0), a3, voffA); \
            PG8_WAIT_V(8); PG8_WAIT_L(0); PG8_BAR; PG8_MMA(1, 0, At, B0); PG8_MMA(1, 1, At, B1); PG8_BAR; PG8_SCHED;
    Unit cur, nxt; int ui = 0;
    if (!S.next(0, cur)) return;
    f32x4 acc[2][2][4][2];
#pragma unroll
    for (int a = 0; a < 2; ++a)
#pragma unroll
        for (int b = 0; b < 2; ++b)
#pragma unroll
            for (int m = 0; m < 4; ++m)
#pragma unroll
                for (int n = 0; n < 2; ++n) acc[a][b][m][n] = (f32x4){0.f, 0.f, 0.f, 0.f};
    f16x8 At[4][2], B0[2][2], B1[2][2];
    const char* cA = (const char*)g.A + (size_t)cur.pm * tstepA; const char* cB = (const char*)g.Bt + (size_t)cur.pn * tstepB;
    PG8_STAGE(PG8_SB(0, 0), cB, voffB); PG8_STAGE(PG8_SB(0, 1), cB + hstepB, voffB); PG8_STAGE(PG8_SA(0, 0), cA, voffA); PG8_STAGE(PG8_SA(0, 1), cA + hstepA, voffA);
    if (wr == 1) PG8_BAR;
    PG8_WAIT_V(2); PG8_BAR;
    PG8_STAGE(PG8_SB(1, 0), cB + kstep, voffB); PG8_STAGE(PG8_SA(1, 0), cA + kstep, voffA); PG8_STAGE(PG8_SB(1, 1), cB + hstepB + kstep, voffB);
    PG8_WAIT_V(6); PG8_BAR;
    for (;;) {
        const bool has_next = S.next(ui + 1, nxt);
        const char* nA = has_next ? (const char*)g.A + (size_t)nxt.pm * tstepA : cA; const char* nB = has_next ? (const char*)g.Bt + (size_t)nxt.pn * tstepB : cB;
        if constexpr (Epi::MID) {
            for (int t = 0; t < E.mid_t; t += 2) { PG8_KBODY }
            E.mid(acc, cur, wr, wc, fr, fq); PG8_SCHED;
            for (int t = E.mid_t; t < nt; t += 2) { PG8_KBODY }
        } else {
            for (int t = 0; t < nt; t += 2) { PG8_KBODY }
        }
        if (wr == 0) PG8_BAR;
        E(acc, cur, wr, wc, fr, fq);
        if (!has_next) break;
#pragma unroll
        for (int a = 0; a < 2; ++a)
#pragma unroll
            for (int b = 0; b < 2; ++b)
#pragma unroll
                for (int m = 0; m < 4; ++m)
#pragma unroll
                    for (int n = 0; n < 2; ++n) acc[a][b][m][n] = (f32x4){0.f, 0.f, 0.f, 0.f};
        cur = nxt; cA = nA; cB = nB; ++ui;
        if (wr == 1) PG8_BAR;
    }
    PG8_WAIT_V(0);
    PG8_BAR;
#undef PG8_KBODY
#undef PG8_SA
#undef PG8_SB
#undef PG8_STAGE
#undef PG8_LDA
#undef PG8_LDB
#undef PG8_MMA
#undef PG8_WAIT_V
#undef PG8_WAIT_L
#undef PG8_BAR
#undef PG8_SCHED
}
}

struct SResid {
    const float* base; float* out; h16* outh; float* ssq; float alpha;
    __device__ __forceinline__ void operator()(f32x4 sa, f32x4 sb, int row, int col, int pc, int t) const {
        const f32x4 bv = *(const f32x4*)(base + (size_t)row * D + col); const f32x4 o = bv + (sa + sb) * alpha;
        *(f32x4*)(out + (size_t)row * D + col) = o;
        if (outh) { u32x2 w; w.x = pkh(o.x, o.y); w.y = pkh(o.z, o.w); *(u32x2*)(outh + (size_t)row * D + col) = w; }
        float s = (o.x * o.x + o.y * o.y) + (o.z * o.z + o.w * o.w);
        s = row_sum16(s);
        if ((t & 15) == 0) ssq[(size_t)row * 16 + pc] = s;
    }
};
struct SMerge {
    const h16* gt; h16* O;
    __device__ __forceinline__ void operator()(f32x4 sa, f32x4 sb, int row, int col, int pc, int t) const {
        const f32x4 ga = unpk4(*(const u32x2*)(gt + (size_t)row * GT_P + col)), gb = unpk4(*(const u32x2*)(gt + (size_t)row * GT_P + 1024 + col));
        const f32x4 o = ga * sa + gb * sb;
        u32x2 w; w.x = pkh(o.x, o.y); w.y = pkh(o.z, o.w); *(u32x2*)(O + (size_t)row * D + col) = w;
    }
};
template <class SE>
__device__ __forceinline__ void sample_gemm(LAS unsigned char* lds, const h16* A, int lda, const h16* Bt, int K, const SE& E, int piece, int tid) {
    const int w = __builtin_amdgcn_readfirstlane(tid >> 6), lane = tid & 63, n = lane & 15, q = lane >> 4;
    const int pr = piece >> 4, pc = piece & 15, kw = K >> 3, kbeg = w * kw;
    f32x4 acc[2][4];
#pragma unroll
    for (int m = 0; m < 2; ++m)
#pragma unroll
        for (int nn = 0; nn < 4; ++nn) acc[m][nn] = (f32x4){0.f, 0.f, 0.f, 0.f};
    const h16* ap = A + (size_t)(MP + 32 * pr + n) * lda + kbeg + 8 * q;
    const h16* bp = Bt + (size_t)(64 * pc + n) * K + kbeg + 8 * q;
#pragma unroll 4
    for (int k0 = 0; k0 < kw; k0 += 32) {
        f16x8 av[2], bv[4];
#pragma unroll
        for (int m = 0; m < 2; ++m) av[m] = *(const f16x8*)(ap + (size_t)(16 * m) * lda + k0);
#pragma unroll
        for (int nn = 0; nn < 4; ++nn) bv[nn] = *(const f16x8*)(bp + (size_t)(16 * nn) * K + k0);
#pragma unroll
        for (int m = 0; m < 2; ++m)
#pragma unroll
            for (int nn = 0; nn < 4; ++nn) acc[m][nn] = __builtin_amdgcn_mfma_f32_16x16x32_f16(av[m], bv[nn], acc[m][nn], 0, 0, 0);
    }
    LAS float* P = (LAS float*)lds + w * 2048;
#pragma unroll
    for (int m = 0; m < 2; ++m)
#pragma unroll
        for (int nn = 0; nn < 4; ++nn)
#pragma unroll
            for (int i = 0; i < 4; ++i) P[(16 * m + 4 * q + i) * 64 + 16 * nn + n] = acc[m][nn][i];
    LDS_WAIT(); __builtin_amdgcn_s_barrier(); asm volatile("" ::: "memory");
    const int r = tid >> 4, c4 = (tid & 15) * 4;
    const LAS float* Q = (const LAS float*)lds + r * 64 + c4;
    f32x4 sa = *(const LAS f32x4*)(Q), sb = *(const LAS f32x4*)(Q + 4 * 2048);
#pragma unroll
    for (int ww = 1; ww < 4; ++ww) { sa += *(const LAS f32x4*)(Q + ww * 2048); sb += *(const LAS f32x4*)(Q + (4 + ww) * 2048); }
    E(sa, sb, MP + 32 * pr + r, 64 * pc + c4, pc, tid);
    LDS_WAIT(); __builtin_amdgcn_s_barrier(); asm volatile("" ::: "memory");
}

#define XB_TMO      128
#define XB_XCNT(j)  (256  + 64 * (j))
#define XB_XSUB(j)  (1280 + 64 * (j))
#define XB_XGEN(j)  (2304 + 64 * (j))
#define XB_TOP      3328
#define XB_TOPGEN   3392
#define XCD_BAR_WORDS 3456
#define XB_SPIN_CAP (1u << 18)
__device__ __forceinline__ unsigned xb_ld(unsigned* p)              { return __hip_atomic_load(p, __ATOMIC_RELAXED, __HIP_MEMORY_SCOPE_AGENT); }
__device__ __forceinline__ unsigned xb_add(unsigned* p, unsigned v) { return __hip_atomic_fetch_add(p, v, __ATOMIC_RELAXED, __HIP_MEMORY_SCOPE_AGENT); }
__device__ __forceinline__ unsigned xb_xcc_id() { return (unsigned)__builtin_amdgcn_s_getreg((3 << 11) | 20) & 0xFu; }
#define XB_SPIN(cond, bar) do { unsigned _sp = 0; while (cond) { __builtin_amdgcn_s_sleep(1); \
    if ((++_sp & 255u) == 0u) { if (xb_ld(&(bar)[XB_TMO])) break; if (_sp > XB_SPIN_CAP) { atomicAdd(&(bar)[XB_TMO], 1u); break; } } } } while (0)
struct XcdBarrier { unsigned* bar; unsigned x; volatile LAS unsigned* st; };
__device__ __forceinline__ XcdBarrier xcd_barrier_post(unsigned* bar, volatile LAS unsigned* st) {
    XcdBarrier b; b.bar = bar; b.x = xb_xcc_id(); b.st = st;
    if (threadIdx.x == 0) (void)xb_add(&bar[XB_XCNT(b.x)], 1u);
    return b;
}
__device__ __forceinline__ void xcd_barrier_complete(unsigned* bar, unsigned x, unsigned& nloc, unsigned& nx) {
    const unsigned G = gridDim.x * gridDim.y * gridDim.z;
    unsigned sum, cnt, mine, sp = 0u;
    for (;;) {
        sum = 0u; cnt = 0u; mine = 0u;
#pragma unroll
        for (unsigned j = 0; j < 16; ++j) { const unsigned c = xb_ld(&bar[XB_XCNT(j)]); sum += c; cnt += (c > 0u) ? 1u : 0u; mine = (j == x) ? c : mine; }
        if (sum == G) break;
        __builtin_amdgcn_s_sleep(1);
        if ((++sp & 255u) == 0u) { if (xb_ld(&bar[XB_TMO])) break; if (sp > XB_SPIN_CAP) { atomicAdd(&bar[XB_TMO], 1u); break; } }
    }
    nloc = mine > 0u ? mine : 1u; nx = cnt > 0u ? cnt : 1u;
}
__device__ __forceinline__ void xcd_barrier(const XcdBarrier& b) {
    asm volatile("s_waitcnt vmcnt(0)" ::: "memory");
    __syncthreads();
    if (threadIdx.x == 0) {
        unsigned* bar = b.bar;
        __builtin_amdgcn_s_waitcnt(0);
        unsigned nloc = b.st[0], nx = b.st[1];
        if (nloc == 0u) { xcd_barrier_complete(bar, b.x, nloc, nx); b.st[0] = nloc; b.st[1] = nx; }
        const unsigned old = xb_add(&bar[XB_XSUB(b.x)], 1u);
        const unsigned gen = old / nloc;
        if (old + 1u == (gen + 1u) * nloc) {
            __builtin_amdgcn_fence(__ATOMIC_RELEASE, "agent");
            asm volatile("s_waitcnt vmcnt(0)" ::: "memory");
            const unsigned og = xb_add(&bar[XB_TOP], 1u);
            const unsigned tg = og / nx;
            if (og + 1u == (tg + 1u) * nx) xb_add(&bar[XB_TOPGEN], 1u);
            else XB_SPIN(xb_ld(&bar[XB_TOPGEN]) == tg, bar);
            __builtin_amdgcn_fence(__ATOMIC_ACQUIRE, "agent");
            xb_add(&bar[XB_XGEN(b.x)], 1u);
            asm volatile("s_waitcnt vmcnt(0)" ::: "memory");
        } else {
            XB_SPIN(xb_ld(&bar[XB_XGEN(b.x)]) == gen, bar);
            __builtin_amdgcn_fence(__ATOMIC_ACQUIRE, "agent");
            asm volatile("s_waitcnt vmcnt(0)" ::: "memory");
        }
    }
    __syncthreads();
}

struct Args { const float* in[35]; float* out; unsigned char* ws; int ph_lo, ph_hi, li, pad; };
typedef const Args __attribute__((address_space(4)))* KArgs;

struct Frame {
    LAS unsigned char* lds; int tid, lane, wave, G, bx;
};

__device__ __forceinline__ void tr_item(const float* W, int ldw, int k0, int src_col0, const float* kscale, h16* WT, int ldwt, int dst_row0, int dst_k0, LAS float* scr, int lane) {
    float vv[32];
#pragma unroll
    for (int i = 0; i < 32; ++i) { const int kk = 2 * i + (lane >> 5); vv[i] = W[(size_t)(k0 + kk) * ldw + src_col0 + (lane & 31)]; }
    if (kscale) {
#pragma unroll
        for (int i = 0; i < 32; ++i) vv[i] *= kscale[k0 + 2 * i + (lane >> 5)];
    }
#pragma unroll
    for (int i = 0; i < 32; ++i) { const int kk = 2 * i + (lane >> 5); scr[kk * 33 + (lane & 31)] = vv[i]; }
    LDS_WAIT(); asm volatile("" ::: "memory");
    const int c = lane & 7;
#pragma unroll
    for (int j = 0; j < 4; ++j) { const int n = (lane >> 3) + 8 * j; const LAS float* s = scr + (8 * c) * 33 + n;
        u32x4 o; o.x = pkh(s[0 * 33], s[1 * 33]); o.y = pkh(s[2 * 33], s[3 * 33]); o.z = pkh(s[4 * 33], s[5 * 33]); o.w = pkh(s[6 * 33], s[7 * 33]);
        *(u32x4*)(WT + (size_t)(dst_row0 + n) * ldwt + dst_k0 + 8 * c) = o; }
    LDS_WAIT(); asm volatile("" ::: "memory");
}
__device__ __forceinline__ void tr_up_item(const float* Wg, const float* Wu, const float* nrm, h16* WT, int item, LAS float* scr, int lane) {
    const int nblk = 5632 / 32, kb = item / nblk, nb = item % nblk, d0 = nb * 32, pn = d0 >> 8, j0 = d0 & 255;
    const float* src = (j0 < 128) ? Wg : Wu; const int col = 128 * pn + (j0 & 127);
    tr_item(src, FF, 64 * kb, col, nrm, WT, D, d0, 64 * kb, scr, lane);
}
__device__ __forceinline__ void p0_prologue(KArgs a, Frame& F) {
    unsigned char* ws = a->ws; unsigned char* dob = (unsigned char*)a->out;
    LAS float* scr = (LAS float*)(F.lds + F.wave * 16384);
    const int gw = F.bx * NWAVES + F.wave, NGW = F.G * NWAVES;
    constexpr int I_UP = 16 * 176, I_DN = 44 * 32, I_IN = 16 * 184;
    constexpr int NITEMS = I_UP + I_DN + I_IN;
    for (int it = gw; it < NITEMS; it += NGW) {
        int r = it;
        if (r < I_UP) { tr_up_item(a->in[7], a->in[8], a->in[6], (h16*)(dob + DO_W1UP), r, scr, F.lane); continue; } r -= I_UP;
        if (r < I_DN) { const int kb = r / 32, nb = r % 32; tr_item(a->in[9], D, 64 * kb, 32 * nb, nullptr, (h16*)(dob + DO_W1DN), FF, 32 * nb, 64 * kb, scr, F.lane); continue; } r -= I_DN;
        { const int kb = r / 184, nb = r % 184, d0 = 32 * nb; tr_item(a->in[11], 5896, 64 * kb, d0 + (d0 >= PAQ_W ? 8 : 0), a->in[10], (h16*)(dob + DO_WIN), D, d0, 64 * kb, scr, F.lane); }
    }
    {
        const int gt = F.bx * NTHREADS + F.tid, NGT = F.G * NTHREADS;
        h16* wab = (h16*)(ws + WS_WAB); h16* w2t = (h16*)(ws + WS_W2T); h16* a2t = (h16*)(ws + WS_A2T); h16* g2t = (h16*)(ws + WS_G2T);
        for (int i = gt; i < 16 * 1024; i += NGT) { const int j = i >> 10, k = i & 1023; const float v = (j < 8) ? a->in[11][(size_t)k * 5896 + PAQ_W + j] * a->in[10][k] : 0.f; wab[i] = __builtin_bit_cast(h16, (_Float16)v); }
        for (int i = gt; i < 512 * 64; i += NGT) { const int n = i >> 6, k = i & 63; w2t[i] = __builtin_bit_cast(h16, (_Float16)a->in[14][k * 512 + n]); a2t[i] = __builtin_bit_cast(h16, (_Float16)a->in[16][k * 512 + n]); }
        for (int i = gt; i < 512 * 128; i += NGT) { const int n = i >> 7, k = i & 127; g2t[i] = __builtin_bit_cast(h16, (_Float16)a->in[17][k * 512 + n]); }
    }
    h16* xh = (h16*)(ws + WS_A); float* ssq0 = (float*)(ws + WS_SSQ0);
    for (int m0 = gw; m0 < M; m0 += 4 * NGW) {
        f32x4 v[4][4];
#pragma unroll
        for (int r = 0; r < 4; ++r) { const int m = m0 + r * NGW; if (m < M) { const float* xrow = (m < MP) ? a->in[0] + (size_t)m * D : a->in[1] + (size_t)(m - MP) * D; const f32x4* xr = (const f32x4*)xrow + F.lane;
#pragma unroll
            for (int j = 0; j < 4; ++j) v[r][j] = xr[64 * j]; } }
#pragma unroll
        for (int r = 0; r < 4; ++r) { const int m = m0 + r * NGW; if (m < M) { u32x2* o8 = (u32x2*)(xh + (size_t)m * D) + F.lane; float s = 0.f;
#pragma unroll
            for (int j = 0; j < 4; ++j) { const f32x4 t = v[r][j]; s += (t.x * t.x + t.y * t.y) + (t.z * t.z + t.w * t.w); u32x2 w; w.x = pkh(t.x, t.y); w.y = pkh(t.z, t.w); o8[64 * j] = w; }
            s = wave_sum(s);
            if (F.lane == 0) ssq0[(size_t)m * 16] = s; } }
    }
}

__device__ __forceinline__ void ab_gemv(KArgs a, Frame& F) {
    const h16* hh = (const h16*)(a->ws + WS_A); const h16* wab = (const h16*)(a->ws + WS_WAB); float* ab = (float*)(a->ws + WS_AB);
    pg8::RowScale rs{(const float*)(a->ws + WS_SSQ1), 16};
    const int gw = F.bx * NWAVES + F.wave, NGW = F.G * NWAVES, n = F.lane & 15, q = F.lane >> 4;
    for (int tile = gw; tile < M / 16; tile += NGW) {
        const h16* ap = hh + (size_t)(tile * 16 + n) * D + 8 * q; const h16* bp = wab + (size_t)n * D + 8 * q;
        f32x4 acc0 = (f32x4){0.f, 0.f, 0.f, 0.f}, acc1 = acc0;
#pragma unroll 8
        for (int st = 0; st < 32; st += 2) {
            const f16x8 a0 = *(const f16x8*)(ap + 32 * st), b0 = *(const f16x8*)(bp + 32 * st), a1 = *(const f16x8*)(ap + 32 * st + 32), b1 = *(const f16x8*)(bp + 32 * st + 32);
            acc0 = __builtin_amdgcn_mfma_f32_16x16x32_f16(a0, b0, acc0, 0, 0, 0); acc1 = __builtin_amdgcn_mfma_f32_16x16x32_f16(a1, b1, acc1, 0, 0, 0);
        }
        if (n < 8) {
#pragma unroll
            for (int i = 0; i < 4; ++i) { const int row = tile * 16 + 4 * q + i; ab[(size_t)row * 8 + n] = (acc0[i] + acc1[i]) * rs(row); }
        }
    }
}

__device__ __forceinline__ void gdn_prep(KArgs a, Frame& F) {
    const h16* PAQ = (const h16*)(a->ws + WS_PAQ); h16* QK = (h16*)(a->ws + WS_A);
    const float* cwp = a->in[23];
    const int lane = F.lane, arr = lane >> 5, c4 = (lane & 31) * 4;
    const int gw = F.bx * NWAVES + F.wave, NGW = F.G * NWAVES;
    for (int item = gw; item < (M / 4) * 4; item += NGW) {
        const int hh = item & 3, run = item >> 2, row0 = 4 * run;
        const int qcol = (arr ? C_GK : C_Q) + hh * 128 + c4, qch = qcol - C_Q;
        f32x4 cwq[4];
#pragma unroll
        for (int i = 0; i < 4; ++i) cwq[i] = *(const f32x4*)(cwp + i * CONVCH + qch);
        const float qscale = arr ? 1.0f : 0.08838834764831845f;
        const h16* pq = PAQ + (size_t)row0 * PAQ_W + qcol;
        f32x4 w0, w1, w2;
        if (row0 >= MP) { const float* sc = a->in[5] + (size_t)((row0 - MP) >> 2) * 3 * CONVCH + qch; w0 = *(const f32x4*)sc; w1 = *(const f32x4*)(sc + CONVCH); w2 = *(const f32x4*)(sc + 2 * CONVCH); }
        else if ((row0 & (SEQ - 1)) == 0) { w0 = w1 = w2 = (f32x4){0.f, 0.f, 0.f, 0.f}; }
        else { w0 = unpk4(*(const u32x2*)(pq - 3 * PAQ_W)); w1 = unpk4(*(const u32x2*)(pq - 2 * PAQ_W)); w2 = unpk4(*(const u32x2*)(pq - PAQ_W)); }
        f32x4 xs[4];
#pragma unroll
        for (int i = 0; i < 4; ++i) xs[i] = unpk4(*(const u32x2*)(pq + (size_t)i * PAQ_W));
#pragma unroll
        for (int i = 0; i < 4; ++i) {
            f32x4 cv = w0 * cwq[0] + w1 * cwq[1] + w2 * cwq[2] + xs[i] * cwq[3];
            cv.x = fsilu(cv.x); cv.y = fsilu(cv.y); cv.z = fsilu(cv.z); cv.w = fsilu(cv.w);
            float ss = (cv.x * cv.x + cv.y * cv.y) + (cv.z * cv.z + cv.w * cv.w);
            ss = row_sum16(ss); ss += __shfl_xor(ss, 16);
            const float sc = __builtin_amdgcn_rsqf(ss + 1e-6f) * qscale;
            cv = cv * sc;
            u32x2 o; o.x = pkh(cv.x, cv.y); o.y = pkh(cv.z, cv.w);
            *(u32x2*)(QK + (size_t)(row0 + i) * D + arr * 512 + hh * 128 + c4) = o;
            w0 = w1; w1 = w2; w2 = xs[i];
        }
    }
    const int gt = F.bx * NTHREADS + F.tid, NGT = F.G * NTHREADS;
    for (int i = gt; i < NB_P * APROJ; i += NGT) { const int bb = i / APROJ, cc = i % APROJ; a->out[O_SHIFT_P + i] = h2f(PAQ[(size_t)(bb * SEQ + SEQ - 1) * PAQ_W + cc]); }
    for (int i = gt; i < NB_S * APROJ; i += NGT) { const int bb = i / APROJ, cc = i % APROJ; a->out[O_SHIFT_S + i] = h2f(PAQ[(size_t)(MP + bb * TS + TS - 1) * PAQ_W + cc]); }
    for (int i = gt; i < NB_P * 3 * CONVCH; i += NGT) { const int bb = i / (3 * CONVCH), r = (i / CONVCH) % 3, cc = i % CONVCH; a->out[O_CONV_P + i] = h2f(PAQ[(size_t)(bb * SEQ + SEQ - 3 + r) * PAQ_W + C_Q + cc]); }
    for (int i = gt; i < NB_S * 3 * CONVCH; i += NGT) { const int bb = i / (3 * CONVCH), r = (i / CONVCH) % 3, cc = i % CONVCH; a->out[O_CONV_S + i] = h2f(PAQ[(size_t)(MP + bb * TS + 1 + r) * PAQ_W + C_Q + cc]); }
}

constexpr int NBLK_P = SEQ / 16, NBLK = NBLK_P + 4;
constexpr int RX_BYTES = 8192, RY_BYTES = 17408, GY_BYTES = 10752;
constexpr int ROPS_BYTES = 17664, RG_BYTES = 3584;
constexpr int R_X = 0, R_Y = R_X + 2 * RX_BYTES, R_OPS = R_Y + 3 * RY_BYTES, R_G = R_OPS + 3 * ROPS_BYTES, G_Y = 0;
static_assert(R_G + 2 * RG_BYTES <= RING_BYTES && G_Y + 2 * GY_BYTES <= RING_BYTES, "scan LDS");

__device__ __forceinline__ int blk_row0(int j, int b, int sgrp) { return (j < NBLK_P) ? b * SEQ + 16 * j : MP + 16 * (4 * sgrp + (j - NBLK_P)); }
#define WG_BAR() do { asm volatile("s_waitcnt lgkmcnt(0)" ::: "memory"); __builtin_amdgcn_s_barrier(); asm volatile("" ::: "memory"); } while (0)

struct RwkvPre { u32x2 cr, cw, ck, ca, pr, pw, pk, pa; };
struct RwkvOps { u32x2 r, d, k, q, b; unsigned v; };
__device__ __forceinline__ RwkvOps rwkv_ld(const LAS unsigned char* Y, int s, int kq, int vi) {
    RwkvOps o; const LAS unsigned char* p = Y + s * 128 + kq * 8;
    o.r = *(const LAS u32x2*)(p); o.d = *(const LAS u32x2*)(p + 2048); o.k = *(const LAS u32x2*)(p + 4096); o.q = *(const LAS u32x2*)(p + 6144); o.b = *(const LAS u32x2*)(p + 8192);
    o.v = *(const LAS unsigned*)(Y + 10240 + s * 128 + vi * 4);
    return o;
}
__device__ __forceinline__ float rwkv_step(h2& S0, h2& S1, const RwkvOps& p) {
    float sa = __builtin_amdgcn_fdot2(S0, u2h(p.q.x), 0.f, false); sa = __builtin_amdgcn_fdot2(S1, u2h(p.q.y), sa, false);
    sa = -row_sum16(sa);
    const h2 sah = bc2(sa), vv = u2h(p.v);
    S0 = __builtin_elementwise_fma(S0, u2h(p.d.x), __builtin_elementwise_fma(vv, u2h(p.k.x), sah * u2h(p.b.x)));
    S1 = __builtin_elementwise_fma(S1, u2h(p.d.y), __builtin_elementwise_fma(vv, u2h(p.k.y), sah * u2h(p.b.y)));
    float o = __builtin_amdgcn_fdot2(S0, u2h(p.r.x), 0.f, false); o = __builtin_amdgcn_fdot2(S1, u2h(p.r.y), o, false);
    return row_sum16(o);
}

__device__ __forceinline__ void rwkv_role(KArgs a, Frame& F, int c, int mode) {
    const bool do_stage = (mode != 6), do_scan = (mode != 5), do_write = (mode < 3);
    const bool do_c1 = (mode != 8), do_c2 = (mode != 8 && mode != 9), do_cons = (mode != 8 && mode != 9 && mode != 10);
    const int w = F.wave, lane = F.lane;
    const int b = c >> 4, h = (c >> 1) & 7, half = c & 1;
    const h16* PAQ = (const h16*)(a->ws + WS_PAQ); h16* OB = (h16*)(a->ws + WS_PAQ) + C_Q; float* bon = (float*)(a->ws + WS_BON);
    const float* mu = a->in[12];
    LAS unsigned char* lds = F.lds;
    const int tsl = lane >> 4, kq = lane & 15;
    const int rwA = w & 3;
    const f32x4 mu_r = *(const f32x4*)(mu + C_R + h * 64 + 4 * kq), mu_w = *(const f32x4*)(mu + C_WD + 4 * kq), mu_k = *(const f32x4*)(mu + C_K + h * 64 + 4 * kq), mu_a = *(const f32x4*)(mu + C_AD + 4 * kq);
    const f32x4 kkw = *(const f32x4*)(a->in[18] + h * 64 + 4 * kq);
    const int o_r = C_R + h * 64 + 4 * kq, o_w = C_WD + 4 * kq, o_k = C_K + h * 64 + 4 * kq, o_a = C_AD + 4 * kq;
    const int sA = 4 * rwA + tsl;
    const int sVv = 2 * w + (lane >> 5), vloc = lane & 31, vcolp = C_V + h * 64 + 32 * half + vloc; const float mu_v = mu[vcolp];
    const int kb = 16 * rwA + kq;
    const float w0b = a->in[13][h * 64 + kb], a0b = a->in[15][h * 64 + kb], kab = a->in[19][h * 64 + kb], rkb = a->in[20][h * 64 + kb];
    f16x8 w2f[2], a2f[2];
    { const h16* w2t = (const h16*)(a->ws + WS_W2T) + (size_t)(h * 64 + kb) * 64 + 8 * tsl; const h16* a2t = (const h16*)(a->ws + WS_A2T) + (size_t)(h * 64 + kb) * 64 + 8 * tsl;
      w2f[0] = *(const f16x8*)w2t; w2f[1] = *(const f16x8*)(w2t + 32); a2f[0] = *(const f16x8*)a2t; a2f[1] = *(const f16x8*)(a2t + 32); }
    const int vi = 4 * w + tsl, vrow = 32 * half + vi;
    h2 S0 = (h2){0, 0}, S1 = (h2){0, 0};
    const int sgrp = b;

#define RW_PREFETCH(j) do { const int row_ = b * SEQ + 16 * (j) + sA; const h16* pc_ = PAQ + (size_t)row_ * PAQ_W; const h16* pp_ = pc_ - (((j) == 0 && sA == 0) ? 0 : PAQ_W); \
        pre.cr = *(const u32x2*)(pc_ + o_r); pre.cw = *(const u32x2*)(pc_ + o_w); pre.ck = *(const u32x2*)(pc_ + o_k); pre.ca = *(const u32x2*)(pc_ + o_a); \
        pre.pr = *(const u32x2*)(pp_ + o_r); pre.pw = *(const u32x2*)(pp_ + o_w); pre.pk = *(const u32x2*)(pp_ + o_k); pre.pa = *(const u32x2*)(pp_ + o_a); } while (0)
#define RW_STAGE_A(j, cr, cw, ck, ca, pr, pw, pk, pa) do { \
        LAS unsigned char* X_ = lds + R_X + ((j) & 1) * RX_BYTES; LAS unsigned char* Y_ = lds + R_Y + ((j) % 3) * RY_BYTES; \
        const f32x4 r_ = cr + (pr - cr) * mu_r, w_ = cw + (pw - cw) * mu_w, k_ = ck + (pk - ck) * mu_k, a_ = ca + (pa - ca) * mu_a; \
        { u32x2 t_; t_.x = pkh(r_.x, r_.y); t_.y = pkh(r_.z, r_.w); *(LAS u32x2*)(Y_ + 0 + sA * 128 + kq * 8) = t_; } \
        { u32x2 t_; t_.x = pkh(ftanh(w_.x), ftanh(w_.y)); t_.y = pkh(ftanh(w_.z), ftanh(w_.w)); *(LAS u32x2*)(X_ + 0 + sA * 128 + kq * 8) = t_; } \
        { u32x2 t_; t_.x = pkh(a_.x, a_.y); t_.y = pkh(a_.z, a_.w); *(LAS u32x2*)(X_ + 2048 + sA * 128 + kq * 8) = t_; } \
        *(LAS f32x4*)(X_ + 4096 + sA * 256 + kq * 16) = k_; \
        const f32x4 kkr_ = k_ * kkw; \
        float ss_ = (kkr_.x * kkr_.x + kkr_.y * kkr_.y) + (kkr_.z * kkr_.z + kkr_.w * kkr_.w); \
        ss_ = row_sum16(ss_); \
        const float inv_ = frcp(fmaxf(__builtin_amdgcn_sqrtf(ss_), 1e-12f)); \
        { const f32x4 kn_ = kkr_ * inv_; u32x2 t_; t_.x = pkh(kn_.x, kn_.y); t_.y = pkh(kn_.z, kn_.w); *(LAS u32x2*)(Y_ + 6144 + sA * 128 + kq * 8) = t_; } } while (0)
#define RW_STAGE_V(j, cv, pv) do { LAS unsigned char* Y_ = lds + R_Y + ((j) % 3) * RY_BYTES; \
        const float vl_ = (cv) + ((pv) - (cv)) * mu_v; *(LAS unsigned*)(Y_ + 10240 + sVv * 128 + vloc * 4) = pkh(vl_, vl_); \
        *(LAS h16*)(Y_ + 16384 + vloc * 32 + sVv * 2) = __builtin_bit_cast(h16, (_Float16)vl_); } while (0)
#define RW_STAGE_B(j) do { \
        LAS unsigned char* X_ = lds + R_X + ((j) & 1) * RX_BYTES; LAS unsigned char* Y_ = lds + R_Y + ((j) % 3) * RY_BYTES; \
        f32x4 wacc_ = (f32x4){0.f, 0.f, 0.f, 0.f}, aacc_ = (f32x4){0.f, 0.f, 0.f, 0.f}; \
        _Pragma("unroll") for (int st_ = 0; st_ < 2; ++st_) { \
            const f16x8 ta_ = *(const LAS f16x8*)(X_ + 0 + kq * 128 + tsl * 16 + st_ * 64); \
            const f16x8 aa_ = *(const LAS f16x8*)(X_ + 2048 + kq * 128 + tsl * 16 + st_ * 64); \
            wacc_ = __builtin_amdgcn_mfma_f32_16x16x32_f16(ta_, w2f[st_], wacc_, 0, 0, 0); \
            aacc_ = __builtin_amdgcn_mfma_f32_16x16x32_f16(aa_, a2f[st_], aacc_, 0, 0, 0); } \
        const int row0_ = blk_row0((j), b, sgrp); \
        _Pragma("unroll") for (int i_ = 0; i_ < 4; ++i_) { \
            const int s_ = 4 * tsl + i_; \
            const float ld_ = -0.60653065971f * fsigmoid(w0b + wacc_[i_]); const float dd_ = fexp(ld_); \
            *(LAS float*)(Y_ + 12288 + s_ * 256 + kb * 4) = ld_; \
            const float av_ = fsigmoid(a0b + aacc_[i_]); \
            const float kr_ = *(const LAS float*)(X_ + 4096 + s_ * 256 + kb * 4); \
            const float kkv_ = h2f(*(const LAS h16*)(Y_ + 6144 + s_ * 128 + kb * 2)); \
            const float rv_ = h2f(*(const LAS h16*)(Y_ + 0 + s_ * 128 + kb * 2)); \
            const float kp_ = kr_ * (1.0f + (av_ - 1.0f) * kab); \
            *(LAS h16*)(Y_ + 2048 + s_ * 128 + kb * 2) = __builtin_bit_cast(h16, (_Float16)dd_); \
            *(LAS h16*)(Y_ + 4096 + s_ * 128 + kb * 2) = __builtin_bit_cast(h16, (_Float16)kp_); \
            *(LAS h16*)(Y_ + 8192 + s_ * 128 + kb * 2) = __builtin_bit_cast(h16, (_Float16)(kkv_ * av_)); \
            const float bp_ = row_sum16(rv_ * kp_ * rkb); \
            if (do_write && half == 0 && kq == 0) bon[(size_t)(row0_ + s_) * 32 + h * 4 + rwA] = bp_; } } while (0)

    {
        constexpr int RAWR = 0, RAWW = 8192, RAWK = 16384, RAWA = 24576, RAWV = 32768, RAW_END = 36864;
        constexpr int TWP = 144, CP = 136;
        constexpr int AO0 = RAW_END, AO_TW = 0, AO_AD = 16 * TWP, AO_R = 32 * TWP, AO_KK = AO_R + 16 * CP, AO_KR = AO_KK + 16 * CP, AO_SLOT = ((AO_KR + 16 * CP + 63) / 64) * 64;
        constexpr int VR0 = AO0 + 2 * AO_SLOT;
        constexpr int TLP = 40;
        constexpr int TL0 = VR0 + 4096, T_AR = 0, T_RR = 64 * TLP, T_BR = 2 * 64 * TLP, T_KR = 3 * 64 * TLP, T_BH = 4 * 64 * TLP, T_KH = 5 * 64 * TLP, T_PM = 6 * 64 * TLP, T_PC = T_PM + 256, TL_SLOT = T_PC + 256;
        constexpr int TFP = 68;
        constexpr int GG0 = TL0 + 3 * TL_SLOT, GG_TF = 0, GG_NK = 16 * TFP, GG_MB = GG_NK + 512, GG_MK = GG_MB + 512, GG_SLOT = ((GG_MK + 512 + 63) / 64) * 64, AM0 = GG0 + 2 * GG_SLOT, RC_END = AM0 + 1024;
        static_assert(RC_END <= RING_BYTES, "rwkv chunk LDS");
        const int n = kq, q = tsl;
        const int wu = __builtin_amdgcn_readfirstlane(w);
        constexpr int NIT = NBLK_P + 3;
        if (wu < 4) {
            float tri[4], mid[4];
#pragma unroll
            for (int s_ = 0; s_ < 4; ++s_) { tri[s_] = (4 * q + s_ <= n) ? 1.0f : 0.0f; mid[s_] = (4 * q + s_ <= 7) ? 1.0f : 0.0f; }
            const int trp = (4 * q + (n >> 2)) * CP + (16 * wu + 4 * (n & 3)) * 2;
            WG_BAR();
            for (int it = 0; it < NIT; ++it) {
                if (it >= 1 && it - 1 < NBLK_P) {
                    const int jc = it - 1; const LAS unsigned char* AO = lds + AO0 + (jc & 1) * AO_SLOT; LAS unsigned char* P = lds + TL0 + (jc % 3) * TL_SLOT;
                    f32x4 wacc = (f32x4){0.f, 0.f, 0.f, 0.f}, aacc = wacc;
#pragma unroll
                    for (int st = 0; st < 2; ++st) {
                        const f16x8 ta = *(const LAS f16x8*)(AO + AO_TW + n * TWP + q * 16 + st * 64);
                        const f16x8 aa = *(const LAS f16x8*)(AO + AO_AD + n * TWP + q * 16 + st * 64);
                        wacc = __builtin_amdgcn_mfma_f32_16x16x32_f16(ta, w2f[st], wacc, 0, 0, 0);
                        aacc = __builtin_amdgcn_mfma_f32_16x16x32_f16(aa, a2f[st], aacc, 0, 0, 0);
                    }
                    const f32x4 rv = unpk4(__builtin_bit_cast(u32x2, __builtin_amdgcn_ds_read_tr16_b64_v4i16((LAS v4i16_t*)(AO + AO_R + trp))));
                    const f32x4 kkv = unpk4(__builtin_bit_cast(u32x2, __builtin_amdgcn_ds_read_tr16_b64_v4i16((LAS v4i16_t*)(AO + AO_KK + trp))));
                    const f32x4 krv = unpk4(__builtin_bit_cast(u32x2, __builtin_amdgcn_ds_read_tr16_b64_v4i16((LAS v4i16_t*)(AO + AO_KR + trp))));
                    f32x4 ld, av;
#pragma unroll
                    for (int e = 0; e < 4; ++e) { ld[e] = -0.60653065971f * fsigmoid(w0b + wacc[e]); av[e] = fsigmoid(a0b + aacc[e]); }
                    f32x4 L = (f32x4){0.f, 0.f, 0.f, 0.f}, Lm = L, Lf = L;
#pragma unroll
                    for (int s_ = 0; s_ < 4; ++s_) {
                        L = __builtin_amdgcn_mfma_f32_16x16x4f32(tri[s_], ld[s_], L, 0, 0, 0);
                        Lm = __builtin_amdgcn_mfma_f32_16x16x4f32(mid[s_], ld[s_], Lm, 0, 0, 0);
                        Lf = __builtin_amdgcn_mfma_f32_16x16x4f32(1.0f, ld[s_], Lf, 0, 0, 0);
                    }
                    const float lmid = Lm[0], PM = fexp(lmid), c15 = fexp(Lf[0] - lmid);
                    f32x4 E, Em1, Ei;
#pragma unroll
                    for (int e = 0; e < 4; ++e) { E[e] = fexp(L[e] - lmid); Em1[e] = fexp(L[e] - ld[e] - lmid); Ei[e] = frcp(E[e]); }
                    const f32x4 E15 = Ei * c15;
                    const f32x4 kpv = krv * (1.0f + (av - 1.0f) * kab), kav = kkv * av;
                    LAS unsigned char* tw = P + kb * TLP + q * 8;
                    *(LAS f16x4*)(tw + T_AR) = cvt4(-kkv * Em1); *(LAS f16x4*)(tw + T_RR) = cvt4(rv * E);
                    *(LAS f16x4*)(tw + T_BR) = cvt4(kav * Ei); *(LAS f16x4*)(tw + T_KR) = cvt4(kpv * Ei);
                    *(LAS f16x4*)(tw + T_BH) = cvt4(kav * E15); *(LAS f16x4*)(tw + T_KH) = cvt4(kpv * E15);
                    if (q == 0) { *(LAS float*)(P + T_PM + kb * 4) = PM; *(LAS float*)(P + T_PC + kb * 4) = PM * c15; }
                    const int row0 = b * SEQ + 16 * jc;
#pragma unroll
                    for (int e = 0; e < 4; ++e) { const float bp = row_sum16(rv[e] * kpv[e] * rkb);
                        if (do_write && half == 0 && n == 0) bon[(size_t)(row0 + 4 * q + e) * 32 + h * 4 + wu] = bp; }
                }
                WG_BAR();
            }
        } else if (wu < 6) {
            const int wa = wu - 4;
            const h16* gbase = PAQ + (size_t)(b * SEQ) * PAQ_W;
            const unsigned gt0 = (unsigned)(((lane >> 3) * PAQ_W + (wa == 0 ? C_R + h * 64 : C_K + h * 64) + 8 * (lane & 7)) * 2);
            const unsigned gt1 = (unsigned)(((lane >> 3) * PAQ_W + (wa == 0 ? C_WD : C_AD) + 8 * (lane & 7)) * 2);
            const unsigned gtv = (unsigned)(((lane >> 2) * PAQ_W + C_V + h * 64 + 32 * half + 8 * (lane & 3)) * 2);
            const int d0 = (wa == 0) ? RAWR : RAWK, d1 = (wa == 0) ? RAWW : RAWA;
#define RC_DMA(j) do { const unsigned char* gb_ = (const unsigned char*)(gbase + (size_t)(16 * (j)) * PAQ_W); const int ro_ = ((16 * (j)) & 63) * 128; \
                __builtin_amdgcn_global_load_lds((const unsigned*)(gb_ + gt0), (LAS unsigned*)(lds + d0 + ro_), 16, 0, 0); \
                __builtin_amdgcn_global_load_lds((const unsigned*)(gb_ + gt0 + 8 * PAQ_W * 2), (LAS unsigned*)(lds + d0 + ro_ + 1024), 16, 0, 0); \
                __builtin_amdgcn_global_load_lds((const unsigned*)(gb_ + gt1), (LAS unsigned*)(lds + d1 + ro_), 16, 0, 0); \
                __builtin_amdgcn_global_load_lds((const unsigned*)(gb_ + gt1 + 8 * PAQ_W * 2), (LAS unsigned*)(lds + d1 + ro_ + 1024), 16, 0, 0); \
                __builtin_amdgcn_global_load_lds((const unsigned*)(gb_ + gtv), (LAS unsigned*)(lds + RAWV + (ro_ >> 1)), 16, 0, 0); } while (0)
            RC_DMA(0); RC_DMA(1);
            asm volatile("s_waitcnt vmcnt(0)" ::: "memory");
            const float mu_v0 = mu[C_V + h * 64 + 32 * half + 2 * kq], mu_v1 = mu[C_V + h * 64 + 32 * half + 2 * kq + 1];
            WG_BAR();
            for (int it = 0; it < NIT; ++it) {
                if (it + 2 < NBLK_P) RC_DMA(it + 2);
                if (it < NBLK_P) {
                    LAS unsigned char* AO = lds + AO0 + (it & 1) * AO_SLOT;
#pragma unroll
                    for (int p = 0; p < 2; ++p) {
                        const int i = 8 * wa + 4 * p + tsl, rowc = (16 * it + i) & 63, rowp = (rowc - 1) & 63;
                        const f32x4 cr = unpk4(*(const LAS u32x2*)(lds + RAWR + rowc * 128 + kq * 8)), cw_ = unpk4(*(const LAS u32x2*)(lds + RAWW + rowc * 128 + kq * 8)),
                                    ck = unpk4(*(const LAS u32x2*)(lds + RAWK + rowc * 128 + kq * 8)), ca = unpk4(*(const LAS u32x2*)(lds + RAWA + rowc * 128 + kq * 8));
                        f32x4 pr = unpk4(*(const LAS u32x2*)(lds + RAWR + rowp * 128 + kq * 8)), pw = unpk4(*(const LAS u32x2*)(lds + RAWW + rowp * 128 + kq * 8)),
                              pk = unpk4(*(const LAS u32x2*)(lds + RAWK + rowp * 128 + kq * 8)), pa = unpk4(*(const LAS u32x2*)(lds + RAWA + rowp * 128 + kq * 8));
                        const unsigned cvu = *(const LAS unsigned*)(lds + RAWV + rowc * 64 + kq * 4); unsigned pvu = *(const LAS unsigned*)(lds + RAWV + rowp * 64 + kq * 4);
                        if (it == 0 && i == 0) { pr = pw = pk = pa = (f32x4){0.f, 0.f, 0.f, 0.f}; pvu = 0u; }
                        const f32x4 r_ = cr + (pr - cr) * mu_r, w_ = cw_ + (pw - cw_) * mu_w, k_ = ck + (pk - ck) * mu_k, a_ = ca + (pa - ca) * mu_a;
                        { u32x2 t_; t_.x = pkh(r_.x, r_.y); t_.y = pkh(r_.z, r_.w); *(LAS u32x2*)(AO + AO_R + i * CP + kq * 8) = t_; }
                        { u32x2 t_; t_.x = pkh(ftanh(w_.x), ftanh(w_.y)); t_.y = pkh(ftanh(w_.z), ftanh(w_.w)); *(LAS u32x2*)(AO + AO_TW + i * TWP + kq * 8) = t_; }
                        { u32x2 t_; t_.x = pkh(a_.x, a_.y); t_.y = pkh(a_.z, a_.w); *(LAS u32x2*)(AO + AO_AD + i * TWP + kq * 8) = t_; }
                        { u32x2 t_; t_.x = pkh(k_.x, k_.y); t_.y = pkh(k_.z, k_.w); *(LAS u32x2*)(AO + AO_KR + i * CP + kq * 8) = t_; }
                        const f32x4 kkr = k_ * kkw;
                        float ss = (kkr.x * kkr.x + kkr.y * kkr.y) + (kkr.z * kkr.z + kkr.w * kkr.w);
                        ss = row_sum16(ss);
                        const float inv = frcp(fmaxf(__builtin_amdgcn_sqrtf(ss), 1e-12f));
                        { const f32x4 kn = kkr * inv; u32x2 t_; t_.x = pkh(kn.x, kn.y); t_.y = pkh(kn.z, kn.w); *(LAS u32x2*)(AO + AO_KK + i * CP + kq * 8) = t_; }
                        { const h2 cv2 = u2h(cvu), pv2 = u2h(pvu); const float c0 = (float)cv2.x, c1 = (float)cv2.y;
                          *(LAS unsigned*)(lds + VR0 + (it & 3) * 1024 + i * 64 + kq * 4) = pkh(c0 + ((float)pv2.x - c0) * mu_v0, c1 + ((float)pv2.y - c1) * mu_v1); }
                    }
                }
                if (it + 2 < NBLK_P) asm volatile("s_waitcnt vmcnt(5)" ::: "memory"); else asm volatile("s_waitcnt vmcnt(0)" ::: "memory");
                WG_BAR();
            }
#undef RC_DMA
        } else if (wu == 6) {
            const int tra = (4 * q + (n >> 2)) * TLP + (n & 3) * 8;
            WG_BAR();
            for (int it = 0; it < NIT; ++it) {
                if (it >= 2 && it - 2 < NBLK_P) {
                    const int jc = it - 2; const LAS unsigned char* P = lds + TL0 + (jc % 3) * TL_SLOT; LAS unsigned char* Gs = lds + GG0 + (jc & 1) * GG_SLOT; LAS unsigned char* AM = lds + AM0;
                    f32x4 nb = (f32x4){0.f, 0.f, 0.f, 0.f}, nk = nb, mb = nb, mk = nb;
#pragma unroll
                    for (int s_ = 0; s_ < 4; ++s_) {
                        const f16x4 ar = __builtin_bit_cast(f16x4, __builtin_amdgcn_ds_read_tr16_b64_v4i16((LAS v4i16_t*)(P + T_AR + 16 * s_ * TLP + tra)));
                        const f16x4 rr = __builtin_bit_cast(f16x4, __builtin_amdgcn_ds_read_tr16_b64_v4i16((LAS v4i16_t*)(P + T_RR + 16 * s_ * TLP + tra)));
                        const f16x4 br = __builtin_bit_cast(f16x4, __builtin_amdgcn_ds_read_tr16_b64_v4i16((LAS v4i16_t*)(P + T_BR + 16 * s_ * TLP + tra)));
                        const f16x4 kr = __builtin_bit_cast(f16x4, __builtin_amdgcn_ds_read_tr16_b64_v4i16((LAS v4i16_t*)(P + T_KR + 16 * s_ * TLP + tra)));
                        nb = MFMA16(ar, br, nb); nk = MFMA16(ar, kr, nk); mb = MFMA16(rr, br, mb); mk = MFMA16(rr, kr, mk);
                    }
#pragma unroll
                    for (int r = 0; r < 4; ++r) { const int i = 4 * q + r;
                        *(LAS float*)(AM + (i * 16 + n) * 4) = (i > n) ? nb[r] : 0.f;
                        *(LAS h16*)(Gs + GG_NK + i * 32 + n * 2) = __builtin_bit_cast(h16, (_Float16)((i > n) ? nk[r] : 0.f));
                        *(LAS h16*)(Gs + GG_MB + i * 32 + n * 2) = __builtin_bit_cast(h16, (_Float16)((i >= n) ? mb[r] : 0.f));
                        *(LAS h16*)(Gs + GG_MK + i * 32 + n * 2) = __builtin_bit_cast(h16, (_Float16)((i >= n) ? mk[r] : 0.f)); }
                    LDS_WAIT();
                    float tc[16];
#pragma unroll
                    for (int r = 0; r < 16; ++r) {
                        float arow[16];
#pragma unroll
                        for (int m4 = 0; 4 * m4 < r; ++m4) { const f32x4 av = *(const LAS f32x4*)(AM + (r * 16 + 4 * m4) * 4); arow[4 * m4] = av.x; arow[4 * m4 + 1] = av.y; arow[4 * m4 + 2] = av.z; arow[4 * m4 + 3] = av.w; }
                        float a0 = (r == n) ? 1.0f : 0.0f, a1 = 0.f;
#pragma unroll
                        for (int m = 0; m + 1 < r; m += 2) { a0 += arow[m] * tc[m]; a1 += arow[m + 1] * tc[m + 1]; }
                        if (r & 1) a0 += arow[r - 1] * tc[r - 1];
                        tc[r] = a0 + a1;
                    }
                    if (q == 0) {
#pragma unroll
                        for (int r = 0; r < 16; ++r) *(LAS float*)(Gs + GG_TF + r * TFP + n * 4) = tc[r];
                    }
                }
                WG_BAR();
            }
        } else {
            f32x4 Xs[2][4];
#pragma unroll
            for (int cw = 0; cw < 2; ++cw)
#pragma unroll
                for (int t = 0; t < 4; ++t) Xs[cw][t] = (f32x4){0.f, 0.f, 0.f, 0.f};
            const int tra = (4 * q + (n >> 2)) * TLP + (n & 3) * 8;
            WG_BAR();
            for (int it = 0; it < NIT; ++it) {
                if (it >= 3) {
                    const int jc = it - 3; const LAS unsigned char* P = lds + TL0 + (jc % 3) * TL_SLOT; const LAS unsigned char* Gs = lds + GG0 + (jc & 1) * GG_SLOT;
                    const LAS unsigned char* VR = lds + VR0 + (jc & 3) * 1024;
                    f16x4 art[4], rrt[4], bht[4], kht[4]; f32x4 pm4[4], pc4[4];
#pragma unroll
                    for (int t = 0; t < 4; ++t) {
                        art[t] = __builtin_bit_cast(f16x4, __builtin_amdgcn_ds_read_tr16_b64_v4i16((LAS v4i16_t*)(P + T_AR + 16 * t * TLP + tra)));
                        rrt[t] = __builtin_bit_cast(f16x4, __builtin_amdgcn_ds_read_tr16_b64_v4i16((LAS v4i16_t*)(P + T_RR + 16 * t * TLP + tra)));
                        bht[t] = *(const LAS f16x4*)(P + T_BH + (16 * t + n) * TLP + q * 8); kht[t] = *(const LAS f16x4*)(P + T_KH + (16 * t + n) * TLP + q * 8);
                        pm4[t] = *(const LAS f32x4*)(P + T_PM + (16 * t + 4 * q) * 4); pc4[t] = *(const LAS f32x4*)(P + T_PC + (16 * t + 4 * q) * 4);
                    }
                    const f16x4 nkf = *(const LAS f16x4*)(Gs + GG_NK + n * 32 + 8 * q), mbf = *(const LAS f16x4*)(Gs + GG_MB + n * 32 + 8 * q), mkf = *(const LAS f16x4*)(Gs + GG_MK + n * 32 + 8 * q);
                    float tf[4];
#pragma unroll
                    for (int s_ = 0; s_ < 4; ++s_) tf[s_] = *(const LAS float*)(Gs + GG_TF + n * TFP + (4 * q + s_) * 4);
#pragma unroll
                    for (int cw = 0; cw < 2; ++cw) {
                        const f16x4 Vf = __builtin_bit_cast(f16x4, __builtin_amdgcn_ds_read_tr16_b64_v4i16((LAS v4i16_t*)(VR + (4 * q + (n >> 2)) * 64 + (16 * cw + 4 * (n & 3)) * 2)));
                        f16x4 Xp[4];
#pragma unroll
                        for (int t = 0; t < 4; ++t) Xp[t] = cvt4(Xs[cw][t] * pm4[t]);
                        f32x4 Wa = (f32x4){0.f, 0.f, 0.f, 0.f}, Oa = Wa;
#pragma unroll
                        for (int t = 0; t < 4; ++t) { Wa = MFMA16(art[t], Xp[t], Wa); Oa = MFMA16(rrt[t], Xp[t], Oa); }
                        Wa = MFMA16(nkf, Vf, Wa);
                        f32x4 U = (f32x4){0.f, 0.f, 0.f, 0.f};
#pragma unroll
                        for (int s_ = 0; s_ < 4; ++s_) U = __builtin_amdgcn_mfma_f32_16x16x4f32(tf[s_], Wa[s_], U, 0, 0, 0);
                        const f16x4 Ub = cvt4(U);
                        Oa = MFMA16(mbf, Ub, Oa);
                        Oa = MFMA16(mkf, Vf, Oa);
#pragma unroll
                        for (int t = 0; t < 4; ++t) Xs[cw][t] = MFMA16(bht[t], Ub, MFMA16(kht[t], Vf, Xs[cw][t] * pc4[t]));
                        if (do_write) {
#pragma unroll
                            for (int r = 0; r < 4; ++r) OB[(size_t)(b * SEQ + 16 * jc + 4 * q + r) * PAQ_W + h * 64 + 32 * half + 16 * cw + n] = __builtin_bit_cast(h16, (_Float16)Oa[r]);
                        }
                    }
                }
                WG_BAR();
            }
            if (do_write) {
#pragma unroll
                for (int cw = 0; cw < 2; ++cw)
#pragma unroll
                    for (int t = 0; t < 4; ++t) *(f32x4*)(a->out + O_RWKV_P + ((size_t)(b * 8 + h)) * 4096 + (size_t)(32 * half + 16 * cw + n) * 64 + 16 * t + 4 * q) = Xs[cw][t];
            }
        }
    }
    if (!do_write) return;
    for (int it = 0; it < 6; ++it) {
        if (it < 4) {
            const int j = NBLK_P + it, row0 = blk_row0(j, b, sgrp);
            if (w < 4) {
                const int row = row0 + sA; const h16* pc = PAQ + (size_t)row * PAQ_W;
                const f32x4 cr = unpk4(*(const u32x2*)(pc + o_r)), cw = unpk4(*(const u32x2*)(pc + o_w)), ck = unpk4(*(const u32x2*)(pc + o_k)), ca = unpk4(*(const u32x2*)(pc + o_a));
                f32x4 pr, pw, pk, pa;
                if ((sA & 3) == 0) {
                    const float* sp = a->in[3] + (size_t)((row - MP) >> 2) * APROJ;
                    pr = *(const f32x4*)(sp + o_r); pw = *(const f32x4*)(sp + o_w); pk = *(const f32x4*)(sp + o_k); pa = *(const f32x4*)(sp + o_a);
                } else {
                    const h16* pp = pc - PAQ_W;
                    pr = unpk4(*(const u32x2*)(pp + o_r)); pw = unpk4(*(const u32x2*)(pp + o_w)); pk = unpk4(*(const u32x2*)(pp + o_k)); pa = unpk4(*(const u32x2*)(pp + o_a));
                }
                RW_STAGE_A(j, cr, cw, ck, ca, pr, pw, pk, pa);
            }
            { const int row = row0 + sVv; const float cv = h2f(PAQ[(size_t)row * PAQ_W + vcolp]);
              const float pv = ((sVv & 3) == 0) ? a->in[3][(size_t)((row - MP) >> 2) * APROJ + vcolp] : h2f(PAQ[(size_t)(row - 1) * PAQ_W + vcolp]);
              RW_STAGE_V(j, cv, pv); }
        }
        if (w >= 4 && it >= 1 && it - 1 < 4) RW_STAGE_B(NBLK_P + it - 1);
        if (it >= 2) {
            const int j = NBLK_P + it - 2; const int row0 = blk_row0(j, b, sgrp);
            const LAS unsigned char* Y = lds + R_Y + (j % 3) * RY_BYTES;
            const size_t sbase = ((size_t)((row0 - MP) >> 2) * 8 + h) * 4096 + vrow * 64 + 4 * kq;
            f32x4 st[4];
#pragma unroll
            for (int q = 0; q < 4; ++q) st[q] = *(const f32x4*)(a->in[2] + sbase + (size_t)q * 8 * 4096);
            float osave = 0.f;
#pragma unroll
            for (int q = 0; q < 4; ++q) {
                S0 = (h2){(_Float16)st[q].x, (_Float16)st[q].y}; S1 = (h2){(_Float16)st[q].z, (_Float16)st[q].w};
#pragma unroll
                for (int s = 4 * q; s < 4 * q + 4; ++s) { const RwkvOps p = rwkv_ld(Y, s, kq, vi); const float o = rwkv_step(S0, S1, p); osave = (kq == s) ? o : osave; }
                *(f32x4*)(a->out + O_RWKV_S + sbase + (size_t)q * 8 * 4096) = (f32x4){(float)S0.x, (float)S0.y, (float)S1.x, (float)S1.y};
            }
            OB[(size_t)(row0 + kq) * PAQ_W + h * 64 + vrow] = __builtin_bit_cast(h16, (_Float16)osave);
        }
        WG_BAR();
    }
#undef RW_PREFETCH
#undef RW_PREFETCH_V
#undef RW_STAGE_A
#undef RW_STAGE_V
#undef RW_STAGE_B
}

struct GdnPre { u32x4 qk; h16 v[4]; float ain, bin, vb; };
struct GdnOps { u32x4 q, k; unsigned v; float eg, beta; unsigned meh; };
__device__ __forceinline__ GdnOps gdn_ld(const LAS unsigned char* Y, int s, int kq, int vi) {
    GdnOps o;
    o.q = *(const LAS u32x4*)(Y + 0 + s * 256 + kq * 16); o.k = *(const LAS u32x4*)(Y + 4096 + s * 256 + kq * 16);
    o.v = *(const LAS unsigned*)(Y + 8192 + s * 128 + vi * 4); o.eg = *(const LAS float*)(Y + 10240 + s * 16); o.beta = *(const LAS float*)(Y + 10240 + s * 16 + 4); o.meh = *(const LAS unsigned*)(Y + 10240 + s * 16 + 8);
    return o;
}
__device__ __forceinline__ float gdn_step(h2 (&S)[4], const GdnOps& p) {
    float ks = __builtin_amdgcn_fdot2(S[1], u2h(p.k.y), __builtin_amdgcn_fdot2(S[0], u2h(p.k.x), 0.f, false), false) + __builtin_amdgcn_fdot2(S[3], u2h(p.k.w), __builtin_amdgcn_fdot2(S[2], u2h(p.k.z), 0.f, false), false);
    ks = row_sum16(ks);
    const float vv = (float)u2h(p.v).x;
    const float dl = vv - p.eg * ks;
    const h2 dlh = bc2(dl), meh = u2h(p.meh);
    S[0] = __builtin_elementwise_fma(u2h(p.k.x), dlh, __builtin_elementwise_fma(S[0], meh, S[0])); S[1] = __builtin_elementwise_fma(u2h(p.k.y), dlh, __builtin_elementwise_fma(S[1], meh, S[1]));
    S[2] = __builtin_elementwise_fma(u2h(p.k.z), dlh, __builtin_elementwise_fma(S[2], meh, S[2])); S[3] = __builtin_elementwise_fma(u2h(p.k.w), dlh, __builtin_elementwise_fma(S[3], meh, S[3]));
    float o = __builtin_amdgcn_fdot2(S[0], u2h(p.q.x), 0.f, false); o = __builtin_amdgcn_fdot2(S[1], u2h(p.q.y), o, false);
    o = __builtin_amdgcn_fdot2(S[2], u2h(p.q.z), o, false); o = __builtin_amdgcn_fdot2(S[3], u2h(p.q.w), o, false);
    return row_sum16(o);
}

__device__ __forceinline__ void gdn_role(KArgs a, Frame& F, int cc, int mode) {
    const bool do_stage = (mode != 4), do_scan = (mode != 3), do_write = (mode < 3);
    const int w = F.wave, lane = F.lane;
    const int b = cc >> 4, hh = (cc >> 2) & 3, qt = cc & 3;
    const h16* PAQ = (const h16*)(a->ws + WS_PAQ); h16* OB = (h16*)(a->ws + WS_PAQ) + C_Q; const float* ab = (const float*)(a->ws + WS_AB);
    const float* cwp = a->in[23];
    LAS unsigned char* lds = F.lds;
    const h16* QK = (const h16*)(a->ws + WS_A);
    const int qarr = w >> 2, qslot = ((w & 3) << 2) + (lane >> 4), qj = lane & 15;
    const int qkoff = qarr * 512 + hh * 128 + 8 * qj;
    const int tsl = lane >> 4, kq = lane & 15;
    const int sV = 2 * w + (lane >> 5), vloc = lane & 31, vcolp = C_GV + hh * 128 + 32 * qt + vloc, vch = vcolp - C_Q;
    float cwv[4];
#pragma unroll
    for (int i = 0; i < 4; ++i) cwv[i] = cwp[i * CONVCH + vch];
    const float negA = -fexp(a->in[24][hh]), dtb = a->in[25][hh];
    const int vi = 4 * w + tsl, vcol = 32 * qt + vi;
    const int sgrp = b;

#define GD_QK(Y_, v_) do { *(LAS u32x4*)((Y_) + qarr * 4096 + qslot * 256 + qj * 16) = (v_); } while (0)
#define GD_GB(Y_, ain_, bin_) do { if (w == 0 && lane < 16) { const float xx_ = (ain_) + dtb; const float sp_ = (xx_ > 20.f) ? xx_ : __logf(1.0f + fexp(xx_)); \
        const float eg_ = fexp(negA * sp_), me_ = eg_ - 1.0f, bt_ = fsigmoid(bin_); *(LAS u32x4*)((Y_) + 10240 + lane * 16) = (u32x4){__builtin_bit_cast(unsigned, bt_ * eg_), __builtin_bit_cast(unsigned, bt_), pkh(me_, me_), 0u}; } } while (0)
#define GD_PREFETCH(j) do { pre.qk = *(const u32x4*)(QK + (size_t)(b * SEQ + 16 * (j) + qslot) * D + qkoff); \
        const int rowv_ = b * SEQ + 16 * (j) + sV; \
        _Pragma("unroll") for (int i_ = 0; i_ < 4; ++i_) { int rr_ = rowv_ - 3 + i_; rr_ = rr_ < b * SEQ ? b * SEQ : rr_; pre.v[i_] = PAQ[(size_t)rr_ * PAQ_W + vcolp]; } \
        pre.vb = ab[(size_t)rowv_ * 8 + 4 + hh]; \
        if (w == 0 && lane < 16) { const int rg_ = b * SEQ + 16 * (j) + lane; pre.ain = ab[(size_t)rg_ * 8 + hh]; pre.bin = ab[(size_t)rg_ * 8 + 4 + hh]; } } while (0)

    {
        constexpr int KP = 272, VP = 80, TP = 68;
        constexpr int GC_KBE = 0, GC_QD = 16 * KP, GC_KD = 32 * KP, GC_QKM = 48 * KP, GC_VB = GC_QKM + 512, GC_EG = GC_VB + 32 * VP, GC_TF = GC_EG + 16, GC_SLOT = ((GC_TF + 16 * TP + 63) / 64) * 64;
        constexpr int RD = 6, TA0 = 2 * GC_SLOT, KQ0 = TA0 + 2048, AB0 = KQ0 + RD * 8192, VR0 = AB0 + RD * 1024, GC_END = VR0 + 8 * 1024;
        static_assert(GC_END <= RING_BYTES, "chunk LDS");
        const int n = lane & 15, q = lane >> 4;
        const int wu = __builtin_amdgcn_readfirstlane(w);
        const int only = (mode >= 11) ? mode - 11 : -1;
#define ROLE_ON(r_) (only < 0 || only == (r_))
#define GC_GATES(a_cur_, b_cur_) \
                const float xx = (a_cur_) + dtb; const float sp = (xx > 20.f) ? xx : __logf(1.0f + fexp(xx)); \
                const float bet = fsigmoid(b_cur_); float gc = negA * sp; \
                gc += dppf<0x111>(gc); gc += dppf<0x112>(gc); gc += dppf<0x114>(gc); gc += dppf<0x118>(gc); \
                const float egi = fexp(gc);
        const int rko = n * 256 + ((q & 1) << 3), rkx = (q >> 1) ^ n;
#define GC_RAWK(j, t_) (*(const LAS u32x2*)(lds + KQ0 + ((j) % RD) * 8192 + rko + (((2 * (t_)) ^ rkx) << 4)))
#define GC_RAWQ(j, t_) (*(const LAS u32x2*)(lds + KQ0 + ((j) % RD) * 8192 + 4096 + rko + (((2 * (t_)) ^ rkx) << 4)))
#define GC_LD_AB(j) do { const LAS unsigned char* abp_ = lds + AB0 + ((j) % RD) * 1024 + n * 32 + hh * 4; pa_in = *(const LAS float*)abp_; pb_in = *(const LAS float*)(abp_ + 16); } while (0)
        if (wu < 2) {
            f32x4 Sc[8];
#pragma unroll
            for (int t = 0; t < 8; ++t) Sc[t] = (f32x4){0.f, 0.f, 0.f, 0.f};
            WG_BAR();
            for (int it = -1; it <= NBLK_P; ++it) {
                if (it >= 1 && ROLE_ON(4)) {
                    const int jc = it - 1; const LAS unsigned char* L = lds + (jc & 1) * GC_SLOT;
                    f16x4 Sb[8];
#pragma unroll
                    for (int t = 0; t < 8; ++t) Sb[t] = cvt4(Sc[t]);
                    f32x4 X = *(const LAS f32x4*)(L + GC_VB + (16 * w + n) * VP + 16 * q);
                    f32x4 Oa = (f32x4){0.f, 0.f, 0.f, 0.f};
#pragma unroll
                    for (int t = 0; t < 8; ++t) {
                        X = MFMA16(*(const LAS f16x4*)(L + GC_KBE + n * KP + (16 * t + 4 * q) * 2), Sb[t], X);
                        Oa = MFMA16(*(const LAS f16x4*)(L + GC_QD + n * KP + (16 * t + 4 * q) * 2), Sb[t], Oa);
                    }
                    f32x4 VN = (f32x4){0.f, 0.f, 0.f, 0.f};
#pragma unroll
                    for (int s_ = 0; s_ < 4; ++s_) VN = __builtin_amdgcn_mfma_f32_16x16x4f32(*(const LAS float*)(L + GC_TF + n * TP + (4 * q + s_) * 4), X[s_], VN, 0, 0, 0);
                    const f16x4 VNb = cvt4(VN);
                    Oa = MFMA16(*(const LAS f16x4*)(L + GC_QKM + n * 32 + 8 * q), VNb, Oa);
                    const float eg15 = *(const LAS float*)(L + GC_EG);
                    const LAS unsigned char* kdp = L + GC_KD + (4 * q + (n >> 2)) * KP + (4 * (n & 3)) * 2;
#pragma unroll
                    for (int t = 0; t < 8; ++t) {
                        const f16x4 kdt = __builtin_bit_cast(f16x4, __builtin_amdgcn_ds_read_tr16_b64_v4i16((LAS v4i16_t*)(kdp + 32 * t)));
                        Sc[t] = MFMA16(kdt, VNb, Sc[t] * eg15);
                    }
                    if (do_write) {
#pragma unroll
                        for (int r = 0; r < 4; ++r) OB[(size_t)(b * SEQ + 16 * jc + 4 * q + r) * PAQ_W + 512 + hh * 128 + 32 * qt + 16 * w + n] = __builtin_bit_cast(h16, (_Float16)Oa[r]);
                    }
                }
                WG_BAR();
            }
            if (do_write) {
#pragma unroll
                for (int t = 0; t < 8; ++t)
#pragma unroll
                    for (int r = 0; r < 4; ++r) a->out[O_DELTA_P + ((size_t)(b * 4 + hh)) * 16384 + (size_t)(16 * t + 4 * q + r) * 128 + 32 * qt + 16 * w + n] = Sc[t][r];
            }
        } else if (wu < 4) {
            const int tp = wu - 2;
            LAS unsigned char* TA = lds + 2 * GC_SLOT + tp * 1024;
            float pa_in = 0.f, pb_in = 0.f;
            float tc[16];
#pragma unroll
            for (int r = 0; r < 16; ++r) tc[r] = 0.f;
            WG_BAR();
            for (int it = -1; it <= NBLK_P; ++it) {
                const int c1 = it + 1;
                if (!ROLE_ON(0)) {} else if ((c1 & 1) == tp && c1 < NBLK_P) {
                    GC_LD_AB(c1);
                    u32x2 kfr[8];
#pragma unroll
                    for (int t = 0; t < 8; ++t) kfr[t] = GC_RAWK(c1, t);
                    GC_GATES(pa_in, pb_in) (void)egi;
                    f32x4 kk = (f32x4){0.f, 0.f, 0.f, 0.f};
#pragma unroll
                    for (int t = 0; t < 8; ++t) kk = MFMA16(u2q(kfr[t]), u2q(kfr[t]), kk);
#pragma unroll
                    for (int r = 0; r < 4; ++r) { const int i = 4 * q + r; const float gci = __shfl(gc, i + (lane & 48)), bi = __shfl(bet, i + (lane & 48));
                        *(LAS float*)(TA + (i * 16 + n) * 4) = (i > n) ? bi * kk[r] * fexp(fminf(gci - gc, 0.f)) : 0.f; }
                    LDS_WAIT();
#pragma unroll
                    for (int r = 0; r < 8; ++r) {
                        float arow[8];
#pragma unroll
                        for (int m4 = 0; 4 * m4 < r; ++m4) { const f32x4 av = *(const LAS f32x4*)(TA + (r * 16 + 4 * m4) * 4); arow[4 * m4] = av.x; arow[4 * m4 + 1] = av.y; arow[4 * m4 + 2] = av.z; arow[4 * m4 + 3] = av.w; }
                        float a0 = (r == n) ? 1.0f : 0.0f, a1 = 0.f;
#pragma unroll
                        for (int m = 0; m + 1 < r; m += 2) { a0 -= arow[m] * tc[m]; a1 -= arow[m + 1] * tc[m + 1]; }
                        if (r & 1) a0 -= arow[r - 1] * tc[r - 1];
                        tc[r] = a0 + a1;
                    }
                } else if ((it & 1) == tp && it >= 0 && it < NBLK_P) {
                    LAS unsigned char* L = lds + (it & 1) * GC_SLOT;
#pragma unroll
                    for (int r = 8; r < 16; ++r) {
                        float arow[16];
#pragma unroll
                        for (int m4 = 0; 4 * m4 < r; ++m4) { const f32x4 av = *(const LAS f32x4*)(TA + (r * 16 + 4 * m4) * 4); arow[4 * m4] = av.x; arow[4 * m4 + 1] = av.y; arow[4 * m4 + 2] = av.z; arow[4 * m4 + 3] = av.w; }
                        float a0 = (r == n) ? 1.0f : 0.0f, a1 = 0.f;
#pragma unroll
                        for (int m = 0; m + 1 < r; m += 2) { a0 -= arow[m] * tc[m]; a1 -= arow[m + 1] * tc[m + 1]; }
                        if (r & 1) a0 -= arow[r - 1] * tc[r - 1];
                        tc[r] = a0 + a1;
                    }
                    if (q == 0) {
#pragma unroll
                        for (int r = 0; r < 16; ++r) *(LAS float*)(L + GC_TF + r * TP + n * 4) = tc[r];
                    }
                }
                WG_BAR();
            }
        } else if (wu == 4) {
            float pa_in = 0.f, pb_in = 0.f;
            WG_BAR();
            for (int it = -1; it <= NBLK_P; ++it) {
                if (it >= 0 && it < NBLK_P && ROLE_ON(1)) {
                    LAS unsigned char* L = lds + (it & 1) * GC_SLOT;
                    GC_LD_AB(it);
                    u32x2 kfr[8], qfr[8];
#pragma unroll
                    for (int t = 0; t < 8; ++t) { kfr[t] = GC_RAWK(it, t); qfr[t] = GC_RAWQ(it, t); }
                    GC_GATES(pa_in, pb_in)
                    const _Float16 s1 = (_Float16)(-bet * egi), s2 = (_Float16)egi, s3 = (_Float16)fexp(__shfl(gc, 15 + (lane & 48)) - gc);
#pragma unroll
                    for (int t = 0; t < 8; ++t) {
                        *(LAS f16x4*)(L + GC_KBE + n * KP + (16 * t + 4 * q) * 2) = u2q(kfr[t]) * s1;
                        *(LAS f16x4*)(L + GC_QD + n * KP + (16 * t + 4 * q) * 2) = u2q(qfr[t]) * s2;
                        *(LAS f16x4*)(L + GC_KD + n * KP + (16 * t + 4 * q) * 2) = u2q(kfr[t]) * s3;
                    }
                    if (lane == 15) *(LAS float*)(L + GC_EG) = egi;
                }
                WG_BAR();
            }
        } else if (wu < 7) {
            float pa_in = 0.f, pb_in = 0.f;
            const int cv_ = C_GV + hh * 128 + 32 * qt + 16 * (wu - 5) + 4 * q;
            f32x4 cw4[4];
#pragma unroll
            for (int i = 0; i < 4; ++i) cw4[i] = *(const f32x4*)(cwp + i * CONVCH + (cv_ - C_Q));
            unsigned go[4];
#pragma unroll
            for (int j = 0; j < 4; ++j) { const int tk = 4 * j + q; go[j] = (unsigned)((tk * D + (wu == 5 ? 512 : 0) + hh * 128 + 8 * (n ^ tk)) * 2); }
            const unsigned go4 = (wu == 5) ? (unsigned)(lane * 16) : (unsigned)((((lane >> 2) * PAQ_W) + C_GV + hh * 128 + 32 * qt + 8 * (lane & 3)) * 2);
            const unsigned char* g4 = (wu == 5) ? (const unsigned char*)(ab + (size_t)(b * SEQ) * 8) : (const unsigned char*)(PAQ + (size_t)(b * SEQ) * PAQ_W);
            const size_t g4s = (wu == 5) ? 16 * 8 * 4 : (size_t)16 * PAQ_W * 2;
            const unsigned char* gkq = (const unsigned char*)(QK + (size_t)(b * SEQ) * D);
#define GC_DMA(j) do { const unsigned char* gb_ = gkq + (size_t)(j) * (16 * D * 2); LAS unsigned char* ld_ = lds + KQ0 + ((j) % RD) * 8192 + (wu == 5 ? 0 : 4096); \
                _Pragma("unroll") for (int j_ = 0; j_ < 4; ++j_) __builtin_amdgcn_global_load_lds((const unsigned*)(gb_ + go[j_]), (LAS unsigned*)(ld_ + j_ * 1024), 16, 0, 0); \
                __builtin_amdgcn_global_load_lds((const unsigned*)(g4 + (size_t)(j) * g4s + go4), (LAS unsigned*)(lds + (wu == 5 ? AB0 + ((j) % RD) * 1024 : VR0 + ((j) & 7) * 1024)), 16, 0, 0); } while (0)
#pragma unroll
            for (int j = 0; j < RD - 2; ++j) GC_DMA(j);
            asm volatile("s_waitcnt vmcnt(0)" ::: "memory");
            WG_BAR();
            for (int it = -1; it <= NBLK_P; ++it) {
                if (it + RD - 1 < NBLK_P) GC_DMA(it + RD - 1);
                if (it >= 0 && it < NBLK_P && ROLE_ON(2)) {
                    LAS unsigned char* L = lds + (it & 1) * GC_SLOT;
                    GC_LD_AB(it);
                    const float bet = fsigmoid(pb_in);
                    const int tt = 16 * it + n;
                    f32x4 acc = (f32x4){0.f, 0.f, 0.f, 0.f};
#pragma unroll
                    for (int i = 0; i < 4; ++i) { const f32x4 x = unpk4(*(const LAS u32x2*)(lds + VR0 + ((tt - 3 + i) & 127) * 64 + (wu - 5) * 32 + q * 8)); if (tt - 3 + i >= 0) acc += x * cw4[i]; }
#pragma unroll
                    for (int e = 0; e < 4; ++e) *(LAS float*)(L + GC_VB + (16 * (wu - 5) + 4 * q + e) * VP + n * 4) = bet * fsilu(acc[e]);
                }
                if (it + RD - 1 < NBLK_P) asm volatile("s_waitcnt vmcnt(%0)" :: "n"(5 * (RD - 3)) : "memory"); else asm volatile("s_waitcnt vmcnt(0)" ::: "memory");
                WG_BAR();
            }
#undef GC_DMA
        } else {
            float pa_in = 0.f, pb_in = 0.f;
            WG_BAR();
            for (int it = -1; it <= NBLK_P; ++it) {
                if (it >= 0 && it < NBLK_P && ROLE_ON(3)) {
                    LAS unsigned char* L = lds + (it & 1) * GC_SLOT;
                    GC_LD_AB(it);
                    u32x2 kfr[8], qfr[8];
#pragma unroll
                    for (int t = 0; t < 8; ++t) { kfr[t] = GC_RAWK(it, t); qfr[t] = GC_RAWQ(it, t); }
                    GC_GATES(pa_in, pb_in) (void)egi; (void)bet;
                    f32x4 qk = (f32x4){0.f, 0.f, 0.f, 0.f};
#pragma unroll
                    for (int t = 0; t < 8; ++t) qk = MFMA16(u2q(qfr[t]), u2q(kfr[t]), qk);
#pragma unroll
                    for (int r = 0; r < 4; ++r) { const int i = 4 * q + r; const float gci = __shfl(gc, i + (lane & 48));
                        const float vq = (i >= n) ? qk[r] * fexp(fminf(gci - gc, 0.f)) : 0.f;
                        *(LAS h16*)(L + GC_QKM + i * 32 + n * 2) = __builtin_bit_cast(h16, (_Float16)vq); }
                }
                WG_BAR();
            }
        }
#undef GC_GATES
#undef GC_LD_AB
#undef GC_RAWK
#undef GC_RAWQ
        if (!do_write && mode != 16 && mode != 17) return;
    }
    static_assert(G_Y + 4 * GY_BYTES <= RING_BYTES, "sample LDS");
    float Sn[32];
#define GD_LDS_STATE(jb_) do { const int row0_ = blk_row0(NBLK_P + (jb_), b, sgrp); \
        const float* sp_ = a->in[4] + ((size_t)((row0_ - MP) >> 2) * 4 + hh) * 16384 + (size_t)(8 * kq) * 128 + vcol; \
        _Pragma("unroll") for (int q_ = 0; q_ < 4; ++q_) _Pragma("unroll") for (int i_ = 0; i_ < 8; ++i_) Sn[q_ * 8 + i_] = (mode == 17) ? 0.f : sp_[(size_t)q_ * 4 * 16384 + i_ * 128]; } while (0)
    GD_LDS_STATE(0);
#pragma unroll
    for (int jb = 0; jb < 4; ++jb) {
        LAS unsigned char* Y = lds + G_Y + jb * GY_BYTES;
        const int row0 = blk_row0(NBLK_P + jb, b, sgrp);
        { const u32x4 qv = *(const u32x4*)(QK + (size_t)(row0 + qslot) * D + qkoff); GD_QK(Y, qv); }
        { const int row = row0 + sV, t = sV & 3; float accv = 0.f;
#pragma unroll
          for (int i = 0; i < 4; ++i) { const int tt = t - 3 + i;
              const float xp = h2f(PAQ[(size_t)(row - 3 + i) * PAQ_W + vcolp]);
              const float xs = a->in[5][((size_t)((row - MP) >> 2) * 3 + (tt < 0 ? 3 + tt : 0)) * CONVCH + vch];
              accv += ((tt >= 0) ? xp : xs) * cwv[i]; }
          const float sv = fsilu(accv) * fsigmoid(ab[(size_t)row * 8 + 4 + hh]); *(LAS unsigned*)(Y + 8192 + sV * 128 + vloc * 4) = pkh(sv, sv); }
        { float ain = 0.f, bin = 0.f; if (w == 0 && lane < 16) { ain = ab[(size_t)(row0 + lane) * 8 + hh]; bin = ab[(size_t)(row0 + lane) * 8 + 4 + hh]; } GD_GB(Y, ain, bin); }
    }
    WG_BAR();
#pragma unroll
    for (int jb = 0; jb < 4; ++jb) {
        const int row0 = blk_row0(NBLK_P + jb, b, sgrp);
        const LAS unsigned char* Y = lds + G_Y + jb * GY_BYTES;
        const size_t sbase = ((size_t)((row0 - MP) >> 2) * 4 + hh) * 16384 + (size_t)(8 * kq) * 128 + vcol;
        h2 Sq[4][4];
#pragma unroll
        for (int q = 0; q < 4; ++q)
#pragma unroll
            for (int i = 0; i < 4; ++i) Sq[q][i] = (h2){(_Float16)Sn[q * 8 + 2 * i], (_Float16)Sn[q * 8 + 2 * i + 1]};
        if (jb + 1 < 4) GD_LDS_STATE(jb + 1);
        float osave = 0.f;
#pragma unroll
        for (int q = 0; q < 4; ++q) {
#pragma unroll
            for (int s = 4 * q; s < 4 * q + 4; ++s) { const GdnOps p = gdn_ld(Y, s, kq, vi); const float o = gdn_step(Sq[q], p); osave = (kq == s) ? o : osave; }
            float* so = a->out + O_DELTA_S + sbase + (size_t)q * 4 * 16384;
            if (do_write) {
#pragma unroll
            for (int i = 0; i < 4; ++i) { so[(2 * i) * 128] = (float)Sq[q][i].x; so[(2 * i + 1) * 128] = (float)Sq[q][i].y; } }
        }
        if (do_write || osave == 123.456f) OB[(size_t)(row0 + kq) * PAQ_W + 512 + hh * 128 + vcol] = __builtin_bit_cast(h16, (_Float16)osave);
    }
    WG_BAR();
#undef GD_LDS_STATE
#undef GD_QK
#undef GD_GB
#undef GD_PREFETCH
}

__device__ __forceinline__ void post_phase(KArgs a, Frame& F) {
    const h16* PAQ = (const h16*)(a->ws + WS_PAQ); const h16* Z = (const h16*)(a->ws + WS_Z); const h16* OI = (const h16*)(a->ws + WS_PAQ) + C_Q; h16* OB = (h16*)(a->ws + WS_A); const float* bon = (const float*)(a->ws + WS_BON);
    const float* mu = a->in[12];
    LAS unsigned char* lds = F.lds;
    const int lane = F.lane, w = F.wave, tsl = lane >> 4, n = lane & 15;
    const h16* g2t = (const h16*)(a->ws + WS_G2T);
    for (int blk = F.bx; blk < M / 16; blk += F.G) {
        const int row0 = blk * 16;
        {
            const int tok = F.tid >> 5, c4 = (F.tid & 31) * 4, row = row0 + tok;
            const bool smp = row >= MP; const int t = smp ? ((row - MP) & 3) : (row & (SEQ - 1));
            const f32x4 cg = unpk4(*(const u32x2*)(PAQ + (size_t)row * PAQ_W + C_GD + c4));
            f32x4 pg;
            if (t > 0) pg = unpk4(*(const u32x2*)(PAQ + (size_t)(row - 1) * PAQ_W + C_GD + c4));
            else if (smp) pg = *(const f32x4*)(a->in[3] + (size_t)((row - MP) >> 2) * APROJ + C_GD + c4);
            else pg = (f32x4){0.f, 0.f, 0.f, 0.f};
            const f32x4 m4 = *(const f32x4*)(mu + C_GD + c4);
            const f32x4 g = cg + (pg - cg) * m4;
            u32x2 o; o.x = pkh(fsigmoid(g.x), fsigmoid(g.y)); o.y = pkh(fsigmoid(g.z), fsigmoid(g.w));
            *(LAS u32x2*)(lds + tok * 256 + c4 * 2) = o;
        }
        __syncthreads();
        {
            f32x4 gacc[4];
#pragma unroll
            for (int nt = 0; nt < 4; ++nt) gacc[nt] = (f32x4){0.f, 0.f, 0.f, 0.f};
#pragma unroll
            for (int st = 0; st < 4; ++st) {
                const f16x8 av = *(const LAS f16x8*)(lds + n * 256 + tsl * 16 + st * 64);
#pragma unroll
                for (int nt = 0; nt < 4; ++nt) {
                    const f16x8 bv = *(const f16x8*)(g2t + (size_t)(w * 64 + nt * 16 + n) * 128 + 8 * tsl + 32 * st);
                    gacc[nt] = __builtin_amdgcn_mfma_f32_16x16x32_f16(av, bv, gacc[nt], 0, 0, 0);
                }
            }
#pragma unroll
            for (int i = 0; i < 4; ++i) {
                const int row = row0 + 4 * tsl + i;
                const bool smp = row >= MP; const int t = smp ? ((row - MP) & 3) : (row & (SEQ - 1));
                float o[4], sum = 0.f;
#pragma unroll
                for (int nt = 0; nt < 4; ++nt) { o[nt] = h2f(OI[(size_t)row * PAQ_W + w * 64 + nt * 16 + n]); sum += o[nt]; }
                const float mean = row_sum16(sum) * (1.0f / 64.0f);
                float var = 0.f;
#pragma unroll
                for (int nt = 0; nt < 4; ++nt) { o[nt] -= mean; var += o[nt] * o[nt]; }
                const float rstd = __builtin_amdgcn_rsqf(row_sum16(var) * (1.0f / 64.0f) + LNX_EPS);
                const f32x4 bp = *(const f32x4*)(bon + (size_t)row * 32 + w * 4);
                const float bonus = (bp.x + bp.y) + (bp.z + bp.w);
#pragma unroll
                for (int nt = 0; nt < 4; ++nt) {
                    const int col = w * 64 + nt * 16 + n;
                    const float cv = h2f(PAQ[(size_t)row * PAQ_W + C_V + col]); float pv;
                    if (t > 0) pv = h2f(PAQ[(size_t)(row - 1) * PAQ_W + C_V + col]); else if (smp) pv = a->in[3][(size_t)((row - MP) >> 2) * APROJ + C_V + col]; else pv = 0.f;
                    const float vl = cv + (pv - cv) * mu[C_V + col];
                    const float val = (o[nt] * rstd * a->in[21][col] + a->in[22][col] + bonus * vl) * gacc[nt][i];
                    o[nt] = val;
                }
                asm volatile("" ::: "memory");
#pragma unroll
                for (int nt = 0; nt < 4; ++nt) OB[(size_t)row * D + w * 64 + nt * 16 + n] = __builtin_bit_cast(h16, (_Float16)o[nt]);
            }
        }
#pragma unroll
        for (int i = 0; i < 2; ++i) {
            const int row = row0 + 2 * w + i, col = tsl * 128 + n * 8;
            const u32x4 ov = *(const u32x4*)(OI + (size_t)row * PAQ_W + 512 + col); const u32x4 zv = *(const u32x4*)(Z + (size_t)row * Z_W + col);
            const f32x4 o0 = unpk4((u32x2){ov.x, ov.y}), o1 = unpk4((u32x2){ov.z, ov.w}), z0 = unpk4((u32x2){zv.x, zv.y}), z1 = unpk4((u32x2){zv.z, zv.w});
            float ss = ((o0.x * o0.x + o0.y * o0.y) + (o0.z * o0.z + o0.w * o0.w)) + ((o1.x * o1.x + o1.y * o1.y) + (o1.z * o1.z + o1.w * o1.w));
            const float rstd = __builtin_amdgcn_rsqf(row_sum16(ss) * (1.0f / 128.0f) + RMS_EPS);
            const f32x4 n0 = *(const f32x4*)(a->in[26] + n * 8), n1 = *(const f32x4*)(a->in[26] + n * 8 + 4);
            f32x4 r0 = o0 * rstd * n0, r1 = o1 * rstd * n1;
            r0.x *= fsilu(z0.x); r0.y *= fsilu(z0.y); r0.z *= fsilu(z0.z); r0.w *= fsilu(z0.w);
            r1.x *= fsilu(z1.x); r1.y *= fsilu(z1.y); r1.z *= fsilu(z1.z); r1.w *= fsilu(z1.w);
            u32x4 wv; wv.x = pkh(r0.x, r0.y); wv.y = pkh(r0.z, r0.w); wv.z = pkh(r1.x, r1.y); wv.w = pkh(r1.z, r1.w);
            *(u32x4*)(OB + (size_t)row * D + 512 + col) = wv;
        }
        __syncthreads();
    }
}

__device__ __forceinline__ void final_norm(KArgs a, Frame& F) {
    pg8::RowScale rs{(const float*)(a->ws + WS_SSQ3), 16};
    const int gw = F.bx * NWAVES + F.wave, NGW = F.G * NWAVES;
    const f32x4* fw = (const f32x4*)a->in[34] + F.lane; f32x4 wv[4];
#pragma unroll
    for (int j = 0; j < 4; ++j) wv[j] = fw[64 * j];
    for (int m = gw; m < M; m += NGW) {
        f32x4* xr = (f32x4*)(a->out + (size_t)m * D) + F.lane; const float s = rs(m);
#pragma unroll
        for (int j = 0; j < 4; ++j) { const f32x4 v = xr[64 * j]; xr[64 * j] = v * s * wv[j]; }
    }
}

__device__ __forceinline__ void late_convert(KArgs a, Frame& F, int part, int nparts) {
    unsigned char* ws = a->ws;
    LAS float* scr = (LAS float*)(F.lds + F.wave * 16384);
    const int gw = part * NWAVES + F.wave, NGW = nparts * NWAVES;
    constexpr int I_UP = 16 * 176, I_DN = 44 * 32, I_PJ = 8 * 32, I_WO = 16 * 32;
    constexpr int NITEMS = I_UP + I_DN + 2 * I_PJ + I_WO;
    for (int it = gw; it < NITEMS; it += NGW) {
        int r = it;
        if (r < I_UP) { tr_up_item(a->in[31], a->in[32], a->in[30], (h16*)(ws + WS_W2UP), r, scr, F.lane); continue; } r -= I_UP;
        if (r < I_DN) { const int kb = r / 32, nb = r % 32; tr_item(a->in[33], D, 64 * kb, 32 * nb, nullptr, (h16*)(ws + WS_W2DN), FF, 32 * nb, 64 * kb, scr, F.lane); continue; } r -= I_DN;
        if (r < I_PJ) { const int kb = r / 32, nb = r % 32; tr_item(a->in[27], D, 64 * kb, 32 * nb, nullptr, (h16*)(ws + WS_WPT), D, 32 * nb, 64 * kb, scr, F.lane); continue; } r -= I_PJ;
        if (r < I_PJ) { const int kb = r / 32, nb = r % 32; tr_item(a->in[28], D, 64 * kb, 32 * nb, nullptr, (h16*)(ws + WS_WPT), D, 32 * nb, 512 + 64 * kb, scr, F.lane); continue; } r -= I_PJ;
        { const int kb = r / 32, nb = r % 32; tr_item(a->in[29], D, 64 * kb, 32 * nb, nullptr, (h16*)(ws + WS_WOUTT), D, 32 * nb, 64 * kb, scr, F.lane); }
    }
}

constexpr int N_PHASES = 12;
__global__ void __launch_bounds__(NTHREADS, 2) mk_fwd(Args args) {
    extern __shared__ __attribute__((aligned(16))) unsigned char lds_raw[];
    Frame F;
    F.lds = (LAS unsigned char*)lds_raw;
    F.tid = threadIdx.x; F.lane = F.tid & 63; F.wave = __builtin_amdgcn_readfirstlane(F.tid >> 6);
    F.G = gridDim.x; F.bx = blockIdx.x;
    volatile LAS unsigned* MISC = (volatile LAS unsigned*)(F.lds + MISC_OFF);
    for (int u = F.tid; u < (LDS_BYTES - LDSCTL_OFF) / 4; u += NTHREADS) ((LAS unsigned*)(F.lds + LDSCTL_OFF))[u] = 0u;
    __syncthreads();
    KArgs ka0 = (KArgs)__builtin_amdgcn_kernarg_segment_ptr();
    unsigned char* ws = ka0->ws;
    XcdBarrier bar; bar.bar = (unsigned*)(ws + WS_CTL) + 1024; bar.x = 0; bar.st = nullptr;
    if (MK_N_LAUNCHES == 1) bar = xcd_barrier_post((unsigned*)(ws + WS_CTL) + 1024, MISC + 8);
    const int lo = ka0->ph_lo, hi = ka0->ph_hi;
#ifndef PH_MASK
#define PH_MASK 0xfff
#endif
#define IN(k) (((PH_MASK >> (k)) & 1) && lo <= (k) && (k) < hi)
#define SEAM(k) do { if (IN(k) && IN((k) + 1)) xcd_barrier(bar); } while (0)
    const int c = F.bx;

#define NREP(k) ((PROBE_REP == (k)) ? 2 : 1)
    if (IN(0)) for (int rep_ = 0; rep_ < NREP(0); ++rep_) { KArgs args = ka0; asm volatile("" : "+s"(args)); unsigned char* ws = args->ws; unsigned char* dob = (unsigned char*)args->out; (void)ws; (void)dob; p0_prologue(args, F); } SEAM(0);
    if (IN(1)) for (int rep_ = 0; rep_ < NREP(1); ++rep_) { KArgs args = ka0; asm volatile("" : "+s"(args)); unsigned char* ws = args->ws; unsigned char* dob = (unsigned char*)args->out; (void)ws; (void)dob;
        pg8::Gemm g{(const h16*)(ws + WS_A), (const h16*)(dob + DO_W1UP), D, D}; pg8::StaticOrder S; S.init(M, 5632, F.G, c);
        pg8::EpiSwiglu E{(h16*)(ws + WS_HID), pg8::RowScale{(const float*)(ws + WS_SSQ0), 1}};
        pg8::gemm_phase(F.lds, g, S, E);
    } SEAM(1);
    if (IN(2)) for (int rep_ = 0; rep_ < NREP(2); ++rep_) { KArgs args = ka0; asm volatile("" : "+s"(args)); unsigned char* ws = args->ws; unsigned char* dob = (unsigned char*)args->out; (void)ws; (void)dob;
        pg8::Gemm g{(const h16*)(ws + WS_HID), (const h16*)(dob + DO_W1DN), FF, FF}; pg8::StaticOrder S; S.init(MP, D, F.G, c);
        pg8::EpiResid E{args->in[0], args->in[1], MP, args->out, (h16*)(ws + WS_A), (float*)(ws + WS_SSQ1), 0.5f};
        pg8::gemm_phase(F.lds, g, S, E);
        SResid SE{args->in[1] - (size_t)MP * D, args->out, (h16*)(ws + WS_A), (float*)(ws + WS_SSQ1), 0.5f};
        if (c < 256) sample_gemm(F.lds, g.A, FF, g.Bt, FF, SE, c, F.tid);
    } SEAM(2);
    if (IN(3)) for (int rep_ = 0; rep_ < NREP(3); ++rep_) { KArgs args = ka0; asm volatile("" : "+s"(args)); unsigned char* ws = args->ws; unsigned char* dob = (unsigned char*)args->out; (void)ws; (void)dob;
        pg8::Gemm g{(const h16*)(ws + WS_A), (const h16*)(dob + DO_WIN), D, D}; pg8::StaticOrder S; S.init(M, NIN, F.G, c);
        pg8::EpiP E{(h16*)(ws + WS_PAQ), (h16*)(ws + WS_Z), (h16*)(ws + WS_GT), pg8::RowScale{(const float*)(ws + WS_SSQ1), 16}};
        pg8::gemm_phase(F.lds, g, S, E);
        ab_gemv(args, F);
    } SEAM(3);
    if (IN(4)) for (int rep_ = 0; rep_ < NREP(4); ++rep_) { KArgs args = ka0; asm volatile("" : "+s"(args)); gdn_prep(args, F); } SEAM(4);
    if (IN(5)) for (int rep_ = 0; rep_ < NREP(5); ++rep_) { KArgs args = ka0; asm volatile("" : "+s"(args)); unsigned char* ws = args->ws; unsigned char* dob = (unsigned char*)args->out; (void)ws; (void)dob;
        const int mode = (MK_N_LAUNCHES == 1) ? 0 : args->pad;
        if (F.G == 256) { if (c < 128) { if (mode == 0 || mode == 1 || mode == 5 || mode == 6 || mode == 8 || mode == 9 || mode == 10) rwkv_role(args, F, c, mode); } else { if (mode == 0 || mode == 2 || mode == 3 || mode == 4 || mode >= 11) gdn_role(args, F, c - 128, mode); if (mode == 0) late_convert(args, F, c - 128, 128); } }
    } SEAM(5);
    if (IN(6)) for (int rep_ = 0; rep_ < NREP(6); ++rep_) { KArgs args = ka0; asm volatile("" : "+s"(args)); unsigned char* ws = args->ws; unsigned char* dob = (unsigned char*)args->out; (void)ws; (void)dob; post_phase(args, F); } SEAM(6);
    if (IN(7)) for (int rep_ = 0; rep_ < NREP(7); ++rep_) { KArgs args = ka0; asm volatile("" : "+s"(args)); unsigned char* ws = args->ws; unsigned char* dob = (unsigned char*)args->out; (void)ws; (void)dob;
        pg8::Gemm g{(const h16*)(ws + WS_A), (const h16*)(ws + WS_WPT), D, D}; pg8::StaticOrder S; S.init(MP, D, F.G, c);
        pg8::EpiMerge E{(const h16*)(ws + WS_GT), (h16*)(ws + WS_MRG), 8};
        pg8::gemm_phase(F.lds, g, S, E);
        SMerge SE{(const h16*)(ws + WS_GT), (h16*)(ws + WS_MRG)};
        if (c < 256) sample_gemm(F.lds, g.A, D, g.Bt, D, SE, c, F.tid);
    } SEAM(7);
    if (IN(8)) for (int rep_ = 0; rep_ < NREP(8); ++rep_) { KArgs args = ka0; asm volatile("" : "+s"(args)); unsigned char* ws = args->ws; unsigned char* dob = (unsigned char*)args->out; (void)ws; (void)dob;
        pg8::Gemm g{(const h16*)(ws + WS_MRG), (const h16*)(ws + WS_WOUTT), D, D}; pg8::StaticOrder S; S.init(MP, D, F.G, c);
        pg8::EpiResid E{args->out, args->out, M, args->out, (h16*)(ws + WS_A), (float*)(ws + WS_SSQ2), 1.0f};
        pg8::gemm_phase(F.lds, g, S, E);
        SResid SE{args->out, args->out, (h16*)(ws + WS_A), (float*)(ws + WS_SSQ2), 1.0f};
        if (c < 256) sample_gemm(F.lds, g.A, D, g.Bt, D, SE, c, F.tid);
    } SEAM(8);
    if (IN(9)) for (int rep_ = 0; rep_ < NREP(9); ++rep_) { KArgs args = ka0; asm volatile("" : "+s"(args)); unsigned char* ws = args->ws; unsigned char* dob = (unsigned char*)args->out; (void)ws; (void)dob;
        pg8::Gemm g{(const h16*)(ws + WS_A), (const h16*)(ws + WS_W2UP), D, D}; pg8::StaticOrder S; S.init(M, 5632, F.G, c);
        pg8::EpiSwiglu E{(h16*)(ws + WS_HID), pg8::RowScale{(const float*)(ws + WS_SSQ2), 16}};
        pg8::gemm_phase(F.lds, g, S, E);
    } SEAM(9);
    if (IN(10)) for (int rep_ = 0; rep_ < NREP(10); ++rep_) { KArgs args = ka0; asm volatile("" : "+s"(args)); unsigned char* ws = args->ws; unsigned char* dob = (unsigned char*)args->out; (void)ws; (void)dob;
        pg8::Gemm g{(const h16*)(ws + WS_HID), (const h16*)(ws + WS_W2DN), FF, FF}; pg8::StaticOrder S; S.init(MP, D, F.G, c);
        pg8::EpiResid E{args->out, args->out, M, args->out, nullptr, (float*)(ws + WS_SSQ3), 0.5f};
        pg8::gemm_phase(F.lds, g, S, E);
        SResid SE{args->out, args->out, nullptr, (float*)(ws + WS_SSQ3), 0.5f};
        if (c < 256) sample_gemm(F.lds, g.A, FF, g.Bt, FF, SE, c, F.tid);
    } SEAM(10);
    if (IN(11)) for (int rep_ = 0; rep_ < NREP(11); ++rep_) { KArgs args = ka0; asm volatile("" : "+s"(args)); unsigned char* ws = args->ws; unsigned char* dob = (unsigned char*)args->out; (void)ws; (void)dob; final_norm(args, F); }
#undef IN
#undef SEAM
}

extern "C" void kernel_launch(void* const* d_in, const int* in_sizes, int n_in, void* d_out, int out_size, void* d_ws, size_t ws_size, hipStream_t stream) {
    static int grid = 0;
    if (grid == 0) {
        if (n_in != 35 || in_sizes[0] != MP * D || in_sizes[1] != MS * D || (size_t)out_size != O_END || ws_size < WS_END) {
            fprintf(stderr, "kernel_launch: unexpected shapes: n_in %d in0 %d out %d ws %zu (need %zu)\n", n_in, n_in > 0 ? in_sizes[0] : -1, out_size, ws_size, (size_t)WS_END); grid = -1; return; }
        int dev = 0, cus = 0, per_cu = 0;
        if (hipGetDevice(&dev) != hipSuccess || hipDeviceGetAttribute(&cus, hipDeviceAttributeMultiprocessorCount, dev) != hipSuccess) { fprintf(stderr, "kernel_launch: device query failed\n"); grid = -1; return; }
        if (hipFuncSetAttribute((const void*)mk_fwd, hipFuncAttributeMaxDynamicSharedMemorySize, LDS_BYTES) != hipSuccess) { fprintf(stderr, "kernel_launch: hipFuncSetAttribute failed\n"); grid = -1; return; }
        if (hipOccupancyMaxActiveBlocksPerMultiprocessor(&per_cu, (const void*)mk_fwd, NTHREADS, LDS_BYTES) != hipSuccess || per_cu < 1) { fprintf(stderr, "kernel_launch: occupancy query says %d blocks per CU\n", per_cu); grid = -1; (void)hipGetLastError(); return; }
        (void)hipGetLastError();
        grid = cus;
        if (grid != 256) fprintf(stderr, "kernel_launch: %d CUs; the scan phase needs exactly 256 workgroups\n", grid);
    }
    if (grid < 0) return;
    (void)hipMemsetAsync((char*)d_ws + WS_CTL, 0, CTL_ZERO_BYTES, stream);
    Args a{};
    for (int i = 0; i < 35; ++i) a.in[i] = (const float*)d_in[i];
    a.out = (float*)d_out; a.ws = (unsigned char*)d_ws;
    if (MK_N_LAUNCHES == 1) {
        a.ph_lo = 0; a.ph_hi = N_PHASES; a.li = 0;
        hipLaunchKernelGGL(mk_fwd, dim3(grid), dim3(NTHREADS), LDS_BYTES, stream, a);
    } else {
        for (int li = 0; li < N_PHASES; ++li) { a.ph_lo = li; a.ph_hi = li + 1; a.li = li; hipLaunchKernelGGL(mk_fwd, dim3(grid), dim3(NTHREADS), LDS_BYTES, stream, a);
            if (li == PROBE_LREP) { a.pad = PROBE_MODE; for (int x_ = 0; x_ < PROBE_NX; ++x_) hipLaunchKernelGGL(mk_fwd, dim3(grid), dim3(NTHREADS), LDS_BYTES, stream, a); a.pad = 0; } }
    }
}
```

```cpp
#include <hip/hip_runtime.h>
#include <cstdio>
#include <cstdint>

#ifndef MK_N_LAUNCHES
#define MK_N_LAUNCHES 1
#endif

#ifndef PROBE_SCAN2
#define PROBE_SCAN2 0
#endif
#ifndef PROBE_MODE
#define PROBE_MODE 0
#endif
#ifndef PROBE_LREP
#define PROBE_LREP -1
#endif
#ifndef PROBE_NX
#define PROBE_NX 4
#endif
#ifndef PROBE_REP
#define PROBE_REP -1
#endif
#define LAS __attribute__((address_space(3)))
#define GAS __attribute__((address_space(1)))
typedef unsigned short h16;
typedef _Float16 f16x8 __attribute__((ext_vector_type(8)));
typedef _Float16 f16x4 __attribute__((ext_vector_type(4)));
typedef _Float16 f16x2 __attribute__((ext_vector_type(2)));
typedef _Float16 h2 __attribute__((ext_vector_type(2)));
typedef _Float16 f16x4 __attribute__((ext_vector_type(4)));
typedef float f32x4 __attribute__((ext_vector_type(4)));
typedef float f32x2 __attribute__((ext_vector_type(2)));
typedef unsigned u32x4 __attribute__((ext_vector_type(4)));
typedef unsigned u32x2 __attribute__((ext_vector_type(2)));
typedef short v4i16_t __attribute__((ext_vector_type(4)));
typedef GAS unsigned gu32;

constexpr int D = 1024, MP = 16384, MS = 512, M = MP + MS, SEQ = 2048, NB_P = 8, NB_S = 128, TS = 4;
constexpr int FF = 2816, APROJ = 1792, CONVCH = 1536;
constexpr int PAQ_W = 3328, Z_W = 512, GT_W = 2048, NIN = PAQ_W + Z_W + GT_W;
constexpr int GT_P = 2112;
constexpr float RMS_EPS = 1e-6f, LNX_EPS = 64e-5f;
constexpr int C_R = 0, C_WD = 512, C_K = 576, C_V = 1088, C_AD = 1600, C_GD = 1664, C_Q = 1792, C_GK = 2304, C_GV = 2816;
constexpr size_t O_Y = 0, O_RWKV_P = 17301504, O_SHIFT_P = 17563648, O_DELTA_P = 17577984, O_CONV_P = 18102272,
                 O_RWKV_S = 18139136, O_SHIFT_S = 22333440, O_DELTA_S = 22562816, O_CONV_S = 30951424, O_END = 31541248;

constexpr size_t MiB = 1u << 20;
constexpr size_t WS_CTL = 0, CTL_ZERO_BYTES = 64 * 1024;
constexpr size_t WS_SSQ0 = 1 * MiB, WS_SSQ1 = WS_SSQ0 + (size_t)M * 64, WS_SSQ2 = WS_SSQ1 + (size_t)M * 64, WS_SSQ3 = WS_SSQ2 + (size_t)M * 64;
constexpr size_t WS_AB = WS_SSQ3 + (size_t)M * 64;
constexpr size_t WS_BON = WS_AB + (size_t)M * 32;
constexpr size_t WS_WAB = WS_BON + (size_t)M * 128;
constexpr size_t WS_W2T = WS_WAB + 32768;
constexpr size_t WS_A2T = WS_W2T + 65536;
constexpr size_t WS_G2T = WS_A2T + 65536;
static_assert(WS_G2T + 131072 <= 8 * MiB, "small arrays");
constexpr size_t WS_A = 8 * MiB;
constexpr size_t WS_WPT = 41 * MiB, WS_WOUTT = 43 * MiB;
constexpr size_t WS_W2UP = 45 * MiB;
constexpr size_t WS_W2DN = 56 * MiB;
constexpr size_t WS_B = 62 * MiB;
constexpr size_t WS_HID = WS_B;
constexpr size_t WS_PAQ = WS_B;
constexpr size_t WS_Z = WS_PAQ + (size_t)M * PAQ_W * 2;
constexpr size_t WS_GT = WS_Z + (size_t)M * Z_W * 2;
constexpr size_t WS_MRG = WS_B;
constexpr size_t WS_H3H = 160 * MiB;
constexpr size_t WS_END = WS_GT + (size_t)M * GT_P * 2;
static_assert(WS_END <= 256 * MiB, "workspace map");
static_assert(WS_A + (size_t)M * D * 2 <= WS_WPT, "region A");
constexpr size_t DO_W1UP = O_DELTA_S * 4;
constexpr size_t DO_W1DN = DO_W1UP + (size_t)5632 * 1024 * 2;
constexpr size_t DO_H1H = (size_t)MP * D * 2;
constexpr size_t DO_WIN = O_RWKV_S * 4;
static_assert(DO_W1DN + (size_t)1024 * 2816 * 2 <= O_CONV_S * 4 && DO_WIN + (size_t)NIN * 1024 * 2 <= O_SHIFT_S * 4, "d_out scratch");

constexpr int NWAVES = 8, NTHREADS = 512;
constexpr int RING_BYTES = 131072, LDSCTL_OFF = RING_BYTES, MISC_OFF = LDSCTL_OFF + 320, LDS_BYTES = 147456;

__device__ __forceinline__ unsigned pkh(float lo, float hi) { f16x2 v; v.x = (_Float16)lo; v.y = (_Float16)hi; return __builtin_bit_cast(unsigned, v); }
__device__ __forceinline__ f32x2 unpk(unsigned u) { f16x2 v = __builtin_bit_cast(f16x2, u); f32x2 r; r.x = (float)v.x; r.y = (float)v.y; return r; }
__device__ __forceinline__ f32x4 unpk4(u32x2 u) { f32x2 a = unpk(u.x), b = unpk(u.y); return (f32x4){a.x, a.y, b.x, b.y}; }
__device__ __forceinline__ float h2f(h16 v) { return (float)__builtin_bit_cast(_Float16, v); }
__device__ __forceinline__ h2 bc2(float x) { const _Float16 h = (_Float16)x; return (h2){h, h}; }
__device__ __forceinline__ h2 u2h(unsigned u) { return __builtin_bit_cast(h2, u); }
__device__ __forceinline__ float fexp(float x) { return __builtin_amdgcn_exp2f(x * 1.44269504089f); }
__device__ __forceinline__ float frcp(float x) { return __builtin_amdgcn_rcpf(x); }
__device__ __forceinline__ float fsigmoid(float x) { return frcp(1.0f + fexp(-x)); }
__device__ __forceinline__ float fsilu(float x) { return x * frcp(1.0f + fexp(-x)); }
__device__ __forceinline__ float ftanh(float x) { return 1.0f - 2.0f * frcp(1.0f + fexp(2.0f * x)); }
template <int CTRL> __device__ __forceinline__ float dppf(float x) { return __builtin_bit_cast(float, __builtin_amdgcn_update_dpp(0, __builtin_bit_cast(int, x), CTRL, 0xF, 0xF, false)); }
__device__ __forceinline__ float row_sum16(float x) { x += dppf<0x128>(x); x += dppf<0x124>(x); x += dppf<0x122>(x); x += dppf<0x121>(x); return x; }
__device__ __forceinline__ float wave_sum(float v) {
#pragma unroll
    for (int o = 1; o < 64; o <<= 1) v += __shfl_xor(v, o);
    return v;
}
#define MFMA16(a_, b_, c_) __builtin_amdgcn_mfma_f32_16x16x16f16(a_, b_, c_, 0, 0, 0)
__device__ __forceinline__ f16x4 cvt4(f32x4 v) { return (f16x4){(_Float16)v.x, (_Float16)v.y, (_Float16)v.z, (_Float16)v.w}; }
__device__ __forceinline__ f16x4 u2q(u32x2 u) { return __builtin_bit_cast(f16x4, u); }
#define LDS_WAIT() asm volatile("s_waitcnt lgkmcnt(0)" ::: "memory")
#define VM_WAIT() asm volatile("s_waitcnt vmcnt(0)" ::: "memory")
#define RLX_AGENT __ATOMIC_RELAXED, __HIP_MEMORY_SCOPE_AGENT

namespace pg8 {
constexpr int BM = 256, BK = 64, HALF = 128, HTB = HALF * BK * 2, STAGE_BYTES = 8 * HTB, NXCD = 8, WGM = 8;
__host__ __device__ __forceinline__ int lds_byte(int r, int c) { const int st = (r >> 4) * 2 + (c >> 5), rr = r & 15, cc = c & 31, ob = rr * 64 + cc * 2; return st * 1024 + (ob ^ (((ob >> 9) & 1) << 5)); }
__host__ __device__ __forceinline__ void stage_rc(int b, int& R, int& C) { const int st = b / 1024, sb = b % 1024, swz = sb ^ (((sb >> 9) & 1) << 5); R = (st >> 1) * 16 + swz / 64; C = (st & 1) * 32 + (swz % 64) / 2; }
__host__ __device__ __forceinline__ int perm32(int rho) { const int n = rho >> 4, i = rho & 15; return 8 * (i >> 2) + 4 * n + (i & 3); }

struct Unit { int pm, pn; };
struct Gemm { const h16* A; const h16* Bt; int lda, K; };

struct StaticOrder {
    int nM, nN, nwg, G, c;
    __device__ void init(int Mr, int N, int G_, int c_) { nM = Mr / BM; nN = N / BM; nwg = nM * nN; G = G_; c = c_; }
    __device__ bool next(int i, Unit& u) const {
        const long L = (long)i * G + c; if (L >= nwg) return false;
        int wgid = (int)L; { const int q = nwg / NXCD, r = nwg % NXCD, xcd = wgid % NXCD, off = wgid / NXCD; wgid = (xcd < r ? xcd * (q + 1) : r * (q + 1) + (xcd - r) * q) + off; }
        const int nig = WGM * nN, gid = wgid / nig, fm = gid * WGM, gsz = (nM - fm) < WGM ? (nM - fm) : WGM;
        u.pm = fm + ((wgid % nig) % gsz); u.pn = (wgid % nig) / gsz; return true;
    }
};

struct RowScale {
    const float* ssq; int np;
    __device__ __forceinline__ float operator()(int row) const {
        const f32x4* p = (const f32x4*)(ssq + (size_t)row * 16); float s;
        if (np == 1) s = ssq[(size_t)row * 16];
        else { f32x4 a = p[0], b = p[1], c = p[2], d = p[3]; s = ((a.x + a.y) + (a.z + a.w)) + ((b.x + b.y) + (b.z + b.w)) + ((c.x + c.y) + (c.z + c.w)) + ((d.x + d.y) + (d.z + d.w)); }
        return __builtin_amdgcn_rsqf(s * (1.0f / 1024.0f) + RMS_EPS);
    }
};

struct EpiSwiglu {
    static constexpr bool PERM = true, MID = false;
    h16* O; RowScale rs;
    __device__ __forceinline__ void operator()(const f32x4 (&acc)[2][2][4][2], const Unit& u, int wr, int wc, int fr, int fq) const {
        const int row0 = u.pm * BM + wr * 64 + fr, col0 = u.pn * 128 + wc * 32 + 8 * fq;
#pragma unroll
        for (int ai = 0; ai < 2; ++ai)
#pragma unroll
            for (int m = 0; m < 4; ++m) {
                const int row = row0 + ai * HALF + m * 16; const float s = rs(row);
                float o[8];
#pragma unroll
                for (int n = 0; n < 2; ++n)
#pragma unroll
                    for (int i = 0; i < 4; ++i) { const float g = acc[ai][0][m][n][i] * s, v = acc[ai][1][m][n][i] * s; o[4 * n + i] = fsilu(g) * v; }
                u32x4 w; w.x = pkh(o[0], o[1]); w.y = pkh(o[2], o[3]); w.z = pkh(o[4], o[5]); w.w = pkh(o[6], o[7]);
                *(u32x4*)(O + (size_t)row * FF + col0) = w;
            }
    }
};
struct EpiP {
    static constexpr bool PERM = true, MID = false;
    h16 *paq, *z, *gt; RowScale rs;
    __device__ __forceinline__ void operator()(const f32x4 (&acc)[2][2][4][2], const Unit& u, int wr, int wc, int fr, int fq) const {
        h16* base; int ld, colt;
        if (u.pn < 13) { base = paq; ld = PAQ_W; colt = u.pn * BM; } else if (u.pn < 15) { base = z; ld = Z_W; colt = (u.pn - 13) * BM; } else { base = gt; ld = GT_P; colt = (u.pn - 15) * BM; }
        const int row0 = u.pm * BM + wr * 64 + fr, col0 = colt + wc * 32 + 8 * fq;
#pragma unroll
        for (int ai = 0; ai < 2; ++ai)
#pragma unroll
            for (int m = 0; m < 4; ++m) {
                const int row = row0 + ai * HALF + m * 16; const float s = rs(row);
#pragma unroll
                for (int bj = 0; bj < 2; ++bj) {
                    f32x4 a = acc[ai][bj][m][0] * s, b = acc[ai][bj][m][1] * s;
                    if (u.pn >= 15) {
#pragma unroll
                        for (int i = 0; i < 4; ++i) { a[i] = fmaxf(fsigmoid(a[i]), 1e-7f); b[i] = fmaxf(fsigmoid(b[i]), 1e-7f); }
                    }
                    u32x4 w; w.x = pkh(a.x, a.y); w.y = pkh(a.z, a.w); w.z = pkh(b.x, b.y); w.w = pkh(b.z, b.w);
                    *(u32x4*)(base + (size_t)row * ld + col0 + bj * HALF) = w;
                }
            }
    }
};
template <bool RH, bool WF, bool WH>
struct EpiResid {
    static constexpr bool PERM = false, MID = false;
    const float* base0; const float* base1; int split_row;
    const h16* resh; float* out; h16* outh; float* ssq; float alpha;
    __device__ __forceinline__ void operator()(const f32x4 (&acc)[2][2][4][2], const Unit& u, int wr, int wc, int fr, int fq) const {
        const int row0 = u.pm * BM + wr * 64 + fr, col0 = u.pn * BM + wc * 32 + 4 * fq;
#pragma unroll
        for (int ai = 0; ai < 2; ++ai)
#pragma unroll
            for (int m = 0; m < 4; ++m) {
                const int row = row0 + ai * HALF + m * 16;
                const float* bp = (row < split_row) ? base0 + (size_t)row * D : base1 + (size_t)(row - split_row) * D;
                float s = 0.f;
#pragma unroll
                for (int bj = 0; bj < 2; ++bj)
#pragma unroll
                    for (int n = 0; n < 2; ++n) {
                        const int col = col0 + bj * HALF + n * 16;
                        const f32x4 bv = RH ? unpk4(*(const u32x2*)(resh + (size_t)row * D + col)) : *(const f32x4*)(bp + col); const f32x4 o = bv + acc[ai][bj][m][n] * alpha;
                        if (WF) *(f32x4*)(out + (size_t)row * D + col) = o;
                        if (WH) { u32x2 w; w.x = pkh(o.x, o.y); w.y = pkh(o.z, o.w); *(u32x2*)(outh + (size_t)row * D + col) = w; }
                        s += (o.x * o.x + o.y * o.y) + (o.z * o.z + o.w * o.w);
                    }
                s += __shfl_xor(s, 16); s += __shfl_xor(s, 32);
                if (fq == 0) ssq[(size_t)row * 16 + u.pn * 4 + wc] = s;
            }
    }
};
struct EpiMerge {
    static constexpr bool PERM = true, MID = true;
    const h16* gt; h16* O; int mid_t;
    __device__ __forceinline__ void mid(f32x4 (&acc)[2][2][4][2], const Unit& u, int wr, int wc, int fr, int fq) const {
        asm volatile("" : "+v"(fr), "+v"(fq));
        const int row0 = u.pm * BM + wr * 64 + fr, col0 = u.pn * BM + wc * 32 + 8 * fq;
#pragma unroll
        for (int ai = 0; ai < 2; ++ai)
#pragma unroll
            for (int m = 0; m < 4; ++m) {
                const h16* gp = gt + (size_t)(row0 + ai * HALF + m * 16) * GT_P + col0;
#pragma unroll
                for (int bj = 0; bj < 2; ++bj) {
                    const u32x4 ga = *(const u32x4*)(gp + bj * HALF), gb = *(const u32x4*)(gp + 1024 + bj * HALF);
                    const f32x4 a0 = unpk4((u32x2){ga.x, ga.y}), a1 = unpk4((u32x2){ga.z, ga.w}), b0 = unpk4((u32x2){gb.x, gb.y}), b1 = unpk4((u32x2){gb.z, gb.w});
                    f32x4 r0, r1;
#pragma unroll
                    for (int i = 0; i < 4; ++i) { r0[i] = a0[i] * frcp(b0[i]); r1[i] = a1[i] * frcp(b1[i]); }
                    acc[ai][bj][m][0] *= r0; acc[ai][bj][m][1] *= r1;
                    asm volatile("" ::: "memory");
                }
            }
    }
    __device__ __forceinline__ void operator()(const f32x4 (&acc)[2][2][4][2], const Unit& u, int wr, int wc, int fr, int fq) const {
        const int row0 = u.pm * BM + wr * 64 + fr, col0 = u.pn * BM + wc * 32 + 8 * fq;
#pragma unroll
        for (int ai = 0; ai < 2; ++ai)
#pragma unroll
            for (int m = 0; m < 4; ++m) {
                const int row = row0 + ai * HALF + m * 16;
                const h16* gp = gt + (size_t)row * GT_P + 1024 + col0;
#pragma unroll
                for (int bj = 0; bj < 2; ++bj) {
                    const u32x4 gb = *(const u32x4*)(gp + bj * HALF);
                    const f32x4 b0 = unpk4((u32x2){gb.x, gb.y}), b1 = unpk4((u32x2){gb.z, gb.w});
                    f32x4 a = acc[ai][bj][m][0], b = acc[ai][bj][m][1];
#pragma unroll
                    for (int i = 0; i < 4; ++i) { a[i] *= b0[i]; b[i] *= b1[i]; }
                    u32x4 w; w.x = pkh(a.x, a.y); w.y = pkh(a.z, a.w); w.z = pkh(b.x, b.y); w.w = pkh(b.z, b.w);
                    *(u32x4*)(O + (size_t)row * D + col0 + bj * HALF) = w;
                }
            }
    }
};

template <class Epi, class Sched>
__device__ __forceinline__ void gemm_phase(LAS unsigned char* lds, const Gemm g, const Sched& S, const Epi& E) {
    const int tid = threadIdx.x, wid = __builtin_amdgcn_readfirstlane(tid >> 6), lane = tid & 63, wr = wid >> 2, wc = wid & 3, fr = lane & 15, fq = lane >> 4;
    const int K = g.K, nt = K / BK, lda = g.lda;
    unsigned voffA[2], voffB[2];
#pragma unroll
    for (int i = 0; i < 2; ++i) { int R, C; stage_rc(tid * 16 + i * 8192, R, C); const int Rb = Epi::PERM ? ((R & ~31) + perm32(R & 31)) : R;
        voffA[i] = (unsigned)(R * lda + C) * 2u; voffB[i] = (unsigned)(Rb * K + C) * 2u; }
    const size_t kstep = (size_t)(BK * 2);
    const size_t hstepA = (size_t)HALF * lda * 2, hstepB = (size_t)HALF * K * 2;
    const size_t tstepA = 2 * hstepA, tstepB = 2 * hstepB;
    const unsigned ldsw = (unsigned)wid * 1024u;
    const int aoff = lds_byte(wr * 64 + fr, fq * 8), boff = lds_byte(wc * 32 + fr, fq * 8);
#define PG8_SA(b, h) (((b) * 2 + (h)) * HTB)
#define PG8_SB(b, h) ((4 + (b) * 2 + (h)) * HTB)
#define PG8_STAGE(bufoff, gbase, voff) do { _Pragma("unroll") for (int _i = 0; _i < 2; ++_i) \
        __builtin_amdgcn_global_load_lds((const unsigned*)((const char*)(gbase) + (voff)[_i]), (LAS unsigned*)(lds + (bufoff) + ldsw + _i * 8192), 16, 0, 0); } while (0)
#define PG8_LDA(dst, b, h) do { _Pragma("unroll") for (int m = 0; m < 4; ++m) _Pragma("unroll") for (int k = 0; k < 2; ++k) dst[m][k] = *(const LAS f16x8*)(lds + PG8_SA(b, h) + aoff + m * 2048 + k * 1024); } while (0)
#define PG8_LDB(dst, b, h) do { _Pragma("unroll") for (int n = 0; n < 2; ++n) _Pragma("unroll") for (int k = 0; k < 2; ++k) dst[n][k] = *(const LAS f16x8*)(lds + PG8_SB(b, h) + boff + n * 2048 + k * 1024); } while (0)
#define PG8_MMA(ai, bj, At, Bt) do { __builtin_amdgcn_s_setprio(1); _Pragma("unroll") for (int m = 0; m < 4; ++m) _Pragma("unroll") for (int n = 0; n < 2; ++n) _Pragma("unroll") for (int k = 0; k < 2; ++k) \
        acc[ai][bj][m][n] = __builtin_amdgcn_mfma_f32_16x16x32_f16(Bt[n][k], At[m][k], acc[ai][bj][m][n], 0, 0, 0); __builtin_amdgcn_s_setprio(0); } while (0)
#define PG8_WAIT_V(n) asm volatile("s_waitcnt vmcnt(" #n ")" ::: "memory")
#define PG8_WAIT_L(n) asm volatile("s_waitcnt lgkmcnt(" #n ")" ::: "memory")
#define PG8_BAR __builtin_amdgcn_s_barrier()
#define PG8_SCHED __builtin_amdgcn_sched_barrier(0)
#define PG8_KBODY \
            const bool last = (t == nt - 2); \
            const char* a1 = cA + (size_t)(t + 1) * kstep; \
            const char* a2 = last ? nA : cA + (size_t)(t + 2) * kstep; const char* b2 = last ? nB : cB + (size_t)(t + 2) * kstep; \
            const char* a3 = a2 + kstep; const char* b3 = b2 + kstep; \
            PG8_LDB(B0, 0, 0); PG8_LDB(B1, 0, 1); PG8_SCHED; PG8_LDA(At, 0, 0); PG8_STAGE(PG8_SA(1, 1), a1 + hstepA, voffA); \
            PG8_WAIT_V(8); PG8_WAIT_L(0); PG8_BAR; PG8_MMA(0, 0, At, B0); PG8_MMA(0, 1, At, B1); PG8_BAR; PG8_SCHED; \
            PG8_LDA(At, 0, 1); PG8_STAGE(PG8_SB(0, 0), b2, voffB); PG8_STAGE(PG8_SB(0, 1), b2 + hstepB, voffB); PG8_STAGE(PG8_SA(0, 0), a2, voffA); \
            PG8_WAIT_V(8); PG8_WAIT_L(0); PG8_BAR; PG8_MMA(1, 0, At, B0); PG8_MMA(1, 1, At, B1); PG8_BAR; PG8_SCHED; \
            PG8_LDB(B0, 1, 0); PG8_LDB(B1, 1, 1); PG8_SCHED; PG8_LDA(At, 1, 0); PG8_STAGE(PG8_SA(0, 1), a2 + hstepA, voffA); \
            PG8_WAIT_V(8); PG8_WAIT_L(0); PG8_BAR; PG8_MMA(0, 0, At, B0); PG8_MMA(0, 1, At, B1); PG8_BAR; PG8_SCHED; \
            PG8_LDA(At, 1, 1); PG8_STAGE(PG8_SB(1, 0), b3, voffB); PG8_STAGE(PG8_SB(1, 1), b3 + hstepB, voffB); PG8_STAGE(PG8_SA(1, 0), a3, voffA); \
            PG8_WAIT_V(8); PG8_WAIT_L(0); PG8_BAR; PG8_MMA(1, 0, At, B0); PG8_MMA(1, 1, At, B1); PG8_BAR; PG8_SCHED;
    Unit cur, nxt; int ui = 0;
    if (!S.next(0, cur)) return;
    f32x4 acc[2][2][4][2];
#pragma unroll
    for (int a = 0; a < 2; ++a)
#pragma unroll
        for (int b = 0; b < 2; ++b)
#pragma unroll
            for (int m = 0; m < 4; ++m)
#pragma unroll
                for (int n = 0; n < 2; ++n) acc[a][b][m][n] = (f32x4){0.f, 0.f, 0.f, 0.f};
    f16x8 At[4][2], B0[2][2], B1[2][2];
    const char* cA = (const char*)g.A + (size_t)cur.pm * tstepA; const char* cB = (const char*)g.Bt + (size_t)cur.pn * tstepB;
    PG8_STAGE(PG8_SB(0, 0), cB, voffB); PG8_STAGE(PG8_SB(0, 1), cB + hstepB, voffB); PG8_STAGE(PG8_SA(0, 0), cA, voffA); PG8_STAGE(PG8_SA(0, 1), cA + hstepA, voffA);
    if (wr == 1) PG8_BAR;
    PG8_WAIT_V(2); PG8_BAR;
    PG8_STAGE(PG8_SB(1, 0), cB + kstep, voffB); PG8_STAGE(PG8_SA(1, 0), cA + kstep, voffA); PG8_STAGE(PG8_SB(1, 1), cB + hstepB + kstep, voffB);
    PG8_WAIT_V(6); PG8_BAR;
    for (;;) {
        const bool has_next = S.next(ui + 1, nxt);
        const char* nA = has_next ? (const char*)g.A + (size_t)nxt.pm * tstepA : cA; const char* nB = has_next ? (const char*)g.Bt + (size_t)nxt.pn * tstepB : cB;
        if constexpr (Epi::MID) {
            for (int t = 0; t < E.mid_t; t += 2) { PG8_KBODY }
            E.mid(acc, cur, wr, wc, fr, fq); PG8_SCHED;
            for (int t = E.mid_t; t < nt; t += 2) { PG8_KBODY }
        } else {
            for (int t = 0; t < nt; t += 2) { PG8_KBODY }
        }
        if (wr == 0) PG8_BAR;
        E(acc, cur, wr, wc, fr, fq);
        if (!has_next) break;
#pragma unroll
        for (int a = 0; a < 2; ++a)
#pragma unroll
            for (int b = 0; b < 2; ++b)
#pragma unroll
                for (int m = 0; m < 4; ++m)
#pragma unroll
                    for (int n = 0; n < 2; ++n) acc[a][b][m][n] = (f32x4){0.f, 0.f, 0.f, 0.f};
        cur = nxt; cA = nA; cB = nB; ++ui;
        if (wr == 1) PG8_BAR;
    }
    PG8_WAIT_V(0);
    PG8_BAR;
#undef PG8_KBODY
#undef PG8_SA
#undef PG8_SB
#undef PG8_STAGE
#undef PG8_LDA
#undef PG8_LDB
#undef PG8_MMA
#undef PG8_WAIT_V
#undef PG8_WAIT_L
#undef PG8_BAR
#undef PG8_SCHED
}
}

struct SResid {
    const float* base; const h16* resh; float* out; h16* outh; float* ssq; float alpha;
    __device__ __forceinline__ void operator()(f32x4 sa, f32x4 sb, int row, int col, int pc, int t) const {
        const f32x4 bv = resh ? unpk4(*(const u32x2*)(resh + (size_t)row * D + col)) : *(const f32x4*)(base + (size_t)row * D + col); const f32x4 o = bv + (sa + sb) * alpha;
        if (out) *(f32x4*)(out + (size_t)row * D + col) = o;
        if (outh) { u32x2 w; w.x = pkh(o.x, o.y); w.y = pkh(o.z, o.w); *(u32x2*)(outh + (size_t)row * D + col) = w; }
        float s = (o.x * o.x + o.y * o.y) + (o.z * o.z + o.w * o.w);
        s = row_sum16(s);
        if ((t & 15) == 0) ssq[(size_t)row * 16 + pc] = s;
    }
};
struct SMerge {
    const h16* gt; h16* O;
    __device__ __forceinline__ void operator()(f32x4 sa, f32x4 sb, int row, int col, int pc, int t) const {
        const f32x4 ga = unpk4(*(const u32x2*)(gt + (size_t)row * GT_P + col)), gb = unpk4(*(const u32x2*)(gt + (size_t)row * GT_P + 1024 + col));
        const f32x4 o = ga * sa + gb * sb;
        u32x2 w; w.x = pkh(o.x, o.y); w.y = pkh(o.z, o.w); *(u32x2*)(O + (size_t)row * D + col) = w;
    }
};
template <class SE>
__device__ __forceinline__ void sample_gemm(LAS unsigned char* lds, const h16* A, int lda, const h16* Bt, int K, const SE& E, int piece, int tid) {
    const int w = __builtin_amdgcn_readfirstlane(tid >> 6), lane = tid & 63, n = lane & 15, q = lane >> 4;
    const int pr = piece >> 4, pc = piece & 15, kw = K >> 3, kbeg = w * kw;
    f32x4 acc[2][4];
#pragma unroll
    for (int m = 0; m < 2; ++m)
#pragma unroll
        for (int nn = 0; nn < 4; ++nn) acc[m][nn] = (f32x4){0.f, 0.f, 0.f, 0.f};
    const h16* ap = A + (size_t)(MP + 32 * pr + n) * lda + kbeg + 8 * q;
    const h16* bp = Bt + (size_t)(64 * pc + n) * K + kbeg + 8 * q;
#pragma unroll 4
    for (int k0 = 0; k0 < kw; k0 += 32) {
        f16x8 av[2], bv[4];
#pragma unroll
        for (int m = 0; m < 2; ++m) av[m] = *(const f16x8*)(ap + (size_t)(16 * m) * lda + k0);
#pragma unroll
        for (int nn = 0; nn < 4; ++nn) bv[nn] = *(const f16x8*)(bp + (size_t)(16 * nn) * K + k0);
#pragma unroll
        for (int m = 0; m < 2; ++m)
#pragma unroll
            for (int nn = 0; nn < 4; ++nn) acc[m][nn] = __builtin_amdgcn_mfma_f32_16x16x32_f16(av[m], bv[nn], acc[m][nn], 0, 0, 0);
    }
    LAS float* P = (LAS float*)lds + w * 2048;
#pragma unroll
    for (int m = 0; m < 2; ++m)
#pragma unroll
        for (int nn = 0; nn < 4; ++nn)
#pragma unroll
            for (int i = 0; i < 4; ++i) P[(16 * m + 4 * q + i) * 64 + 16 * nn + n] = acc[m][nn][i];
    LDS_WAIT(); __builtin_amdgcn_s_barrier(); asm volatile("" ::: "memory");
    const int r = tid >> 4, c4 = (tid & 15) * 4;
    const LAS float* Q = (const LAS float*)lds + r * 64 + c4;
    f32x4 sa = *(const LAS f32x4*)(Q), sb = *(const LAS f32x4*)(Q + 4 * 2048);
#pragma unroll
    for (int ww = 1; ww < 4; ++ww) { sa += *(const LAS f32x4*)(Q + ww * 2048); sb += *(const LAS f32x4*)(Q + (4 + ww) * 2048); }
    E(sa, sb, MP + 32 * pr + r, 64 * pc + c4, pc, tid);
    LDS_WAIT(); __builtin_amdgcn_s_barrier(); asm volatile("" ::: "memory");
}

#define XB_TMO      128
#define XB_XCNT(j)  (256  + 64 * (j))
#define XB_XSUB(j)  (1280 + 64 * (j))
#define XB_XGEN(j)  (2304 + 64 * (j))
#define XB_TOP      3328
#define XB_TOPGEN   3392
#define XCD_BAR_WORDS 3456
#define XB_SPIN_CAP (1u << 18)
__device__ __forceinline__ unsigned xb_ld(unsigned* p)              { return __hip_atomic_load(p, __ATOMIC_RELAXED, __HIP_MEMORY_SCOPE_AGENT); }
__device__ __forceinline__ unsigned xb_add(unsigned* p, unsigned v) { return __hip_atomic_fetch_add(p, v, __ATOMIC_RELAXED, __HIP_MEMORY_SCOPE_AGENT); }
__device__ __forceinline__ unsigned xb_xcc_id() { return (unsigned)__builtin_amdgcn_s_getreg((3 << 11) | 20) & 0xFu; }
#define XB_SPIN(cond, bar) do { unsigned _sp = 0; while (cond) { __builtin_amdgcn_s_sleep(1); \
    if ((++_sp & 255u) == 0u) { if (xb_ld(&(bar)[XB_TMO])) break; if (_sp > XB_SPIN_CAP) { atomicAdd(&(bar)[XB_TMO], 1u); break; } } } } while (0)
struct XcdBarrier { unsigned* bar; unsigned x; volatile LAS unsigned* st; };
__device__ __forceinline__ XcdBarrier xcd_barrier_post(unsigned* bar, volatile LAS unsigned* st) {
    XcdBarrier b; b.bar = bar; b.x = xb_xcc_id(); b.st = st;
    if (threadIdx.x == 0) (void)xb_add(&bar[XB_XCNT(b.x)], 1u);
    return b;
}
__device__ __forceinline__ void xcd_barrier_complete(unsigned* bar, unsigned x, unsigned& nloc, unsigned& nx) {
    const unsigned G = gridDim.x * gridDim.y * gridDim.z;
    unsigned sum, cnt, mine, sp = 0u;
    for (;;) {
        sum = 0u; cnt = 0u; mine = 0u;
#pragma unroll
        for (unsigned j = 0; j < 16; ++j) { const unsigned c = xb_ld(&bar[XB_XCNT(j)]); sum += c; cnt += (c > 0u) ? 1u : 0u; mine = (j == x) ? c : mine; }
        if (sum == G) break;
        __builtin_amdgcn_s_sleep(1);
        if ((++sp & 255u) == 0u) { if (xb_ld(&bar[XB_TMO])) break; if (sp > XB_SPIN_CAP) { atomicAdd(&bar[XB_TMO], 1u); break; } }
    }
    nloc = mine > 0u ? mine : 1u; nx = cnt > 0u ? cnt : 1u;
}
__device__ __forceinline__ void xcd_barrier(const XcdBarrier& b) {
    asm volatile("s_waitcnt vmcnt(0)" ::: "memory");
    __syncthreads();
    if (threadIdx.x == 0) {
        unsigned* bar = b.bar;
        __builtin_amdgcn_s_waitcnt(0);
        unsigned nloc = b.st[0], nx = b.st[1];
        if (nloc == 0u) { xcd_barrier_complete(bar, b.x, nloc, nx); b.st[0] = nloc; b.st[1] = nx; }
        const unsigned old = xb_add(&bar[XB_XSUB(b.x)], 1u);
        const unsigned gen = old / nloc;
        if (old + 1u == (gen + 1u) * nloc) {
            __builtin_amdgcn_fence(__ATOMIC_RELEASE, "agent");
            asm volatile("s_waitcnt vmcnt(0)" ::: "memory");
            const unsigned og = xb_add(&bar[XB_TOP], 1u);
            const unsigned tg = og / nx;
            if (og + 1u == (tg + 1u) * nx) xb_add(&bar[XB_TOPGEN], 1u);
            else XB_SPIN(xb_ld(&bar[XB_TOPGEN]) == tg, bar);
            __builtin_amdgcn_fence(__ATOMIC_ACQUIRE, "agent");
            xb_add(&bar[XB_XGEN(b.x)], 1u);
            asm volatile("s_waitcnt vmcnt(0)" ::: "memory");
        } else {
            XB_SPIN(xb_ld(&bar[XB_XGEN(b.x)]) == gen, bar);
            __builtin_amdgcn_fence(__ATOMIC_ACQUIRE, "agent");
            asm volatile("s_waitcnt vmcnt(0)" ::: "memory");
        }
    }
    __syncthreads();
}

struct Args { const float* in[35]; float* out; unsigned char* ws; int ph_lo, ph_hi, li, pad; };
typedef const Args __attribute__((address_space(4)))* KArgs;

struct Frame {
    LAS unsigned char* lds; int tid, lane, wave, G, bx;
};

__device__ __forceinline__ void tr_item(const float* W, int ldw, int k0, int src_col0, const float* kscale, h16* WT, int ldwt, int dst_row0, int dst_k0, LAS float* scr, int lane) {
    float vv[32];
#pragma unroll
    for (int i = 0; i < 32; ++i) { const int kk = 2 * i + (lane >> 5); vv[i] = W[(size_t)(k0 + kk) * ldw + src_col0 + (lane & 31)]; }
    if (kscale) {
#pragma unroll
        for (int i = 0; i < 32; ++i) vv[i] *= kscale[k0 + 2 * i + (lane >> 5)];
    }
#pragma unroll
    for (int i = 0; i < 32; ++i) { const int kk = 2 * i + (lane >> 5); scr[kk * 33 + (lane & 31)] = vv[i]; }
    LDS_WAIT(); asm volatile("" ::: "memory");
    const int c = lane & 7;
#pragma unroll
    for (int j = 0; j < 4; ++j) { const int n = (lane >> 3) + 8 * j; const LAS float* s = scr + (8 * c) * 33 + n;
        u32x4 o; o.x = pkh(s[0 * 33], s[1 * 33]); o.y = pkh(s[2 * 33], s[3 * 33]); o.z = pkh(s[4 * 33], s[5 * 33]); o.w = pkh(s[6 * 33], s[7 * 33]);
        *(u32x4*)(WT + (size_t)(dst_row0 + n) * ldwt + dst_k0 + 8 * c) = o; }
    LDS_WAIT(); asm volatile("" ::: "memory");
}
__device__ __forceinline__ void tr_up_item(const float* Wg, const float* Wu, const float* nrm, h16* WT, int item, LAS float* scr, int lane) {
    const int nblk = 5632 / 32, kb = item / nblk, nb = item % nblk, d0 = nb * 32, pn = d0 >> 8, j0 = d0 & 255;
    const float* src = (j0 < 128) ? Wg : Wu; const int col = 128 * pn + (j0 & 127);
    tr_item(src, FF, 64 * kb, col, nrm, WT, D, d0, 64 * kb, scr, lane);
}
__device__ __forceinline__ void p0_prologue(KArgs a, Frame& F) {
    unsigned char* ws = a->ws; unsigned char* dob = (unsigned char*)a->out;
    LAS float* scr = (LAS float*)(F.lds + F.wave * 16384);
    const int gw = F.bx * NWAVES + F.wave, NGW = F.G * NWAVES;
    constexpr int I_UP = 16 * 176, I_DN = 44 * 32, I_IN = 16 * 184;
    constexpr int NITEMS = I_UP + I_DN + I_IN;
    for (int it = gw; it < NITEMS; it += NGW) {
        int r = it;
        if (r < I_UP) { tr_up_item(a->in[7], a->in[8], a->in[6], (h16*)(dob + DO_W1UP), r, scr, F.lane); continue; } r -= I_UP;
        if (r < I_DN) { const int kb = r / 32, nb = r % 32; tr_item(a->in[9], D, 64 * kb, 32 * nb, nullptr, (h16*)(dob + DO_W1DN), FF, 32 * nb, 64 * kb, scr, F.lane); continue; } r -= I_DN;
        { const int kb = r / 184, nb = r % 184, d0 = 32 * nb; tr_item(a->in[11], 5896, 64 * kb, d0 + (d0 >= PAQ_W ? 8 : 0), a->in[10], (h16*)(dob + DO_WIN), D, d0, 64 * kb, scr, F.lane); }
    }
    {
        const int gt = F.bx * NTHREADS + F.tid, NGT = F.G * NTHREADS;
        h16* wab = (h16*)(ws + WS_WAB); h16* w2t = (h16*)(ws + WS_W2T); h16* a2t = (h16*)(ws + WS_A2T); h16* g2t = (h16*)(ws + WS_G2T);
        for (int i = gt; i < 16 * 1024; i += NGT) { const int j = i >> 10, k = i & 1023; const float v = (j < 8) ? a->in[11][(size_t)k * 5896 + PAQ_W + j] * a->in[10][k] : 0.f; wab[i] = __builtin_bit_cast(h16, (_Float16)v); }
        for (int i = gt; i < 512 * 64; i += NGT) { const int n = i >> 6, k = i & 63; w2t[i] = __builtin_bit_cast(h16, (_Float16)a->in[14][k * 512 + n]); a2t[i] = __builtin_bit_cast(h16, (_Float16)a->in[16][k * 512 + n]); }
        for (int i = gt; i < 512 * 128; i += NGT) { const int n = i >> 7, k = i & 127; g2t[i] = __builtin_bit_cast(h16, (_Float16)a->in[17][k * 512 + n]); }
    }
    h16* xh = (h16*)(ws + WS_A); float* ssq0 = (float*)(ws + WS_SSQ0);
    for (int m0 = gw; m0 < M; m0 += 4 * NGW) {
        f32x4 v[4][4];
#pragma unroll
        for (int r = 0; r < 4; ++r) { const int m = m0 + r * NGW; if (m < M) { const float* xrow = (m < MP) ? a->in[0] + (size_t)m * D : a->in[1] + (size_t)(m - MP) * D; const f32x4* xr = (const f32x4*)xrow + F.lane;
#pragma unroll
            for (int j = 0; j < 4; ++j) v[r][j] = xr[64 * j]; } }
#pragma unroll
        for (int r = 0; r < 4; ++r) { const int m = m0 + r * NGW; if (m < M) { u32x2* o8 = (u32x2*)(xh + (size_t)m * D) + F.lane; float s = 0.f;
#pragma unroll
            for (int j = 0; j < 4; ++j) { const f32x4 t = v[r][j]; s += (t.x * t.x + t.y * t.y) + (t.z * t.z + t.w * t.w); u32x2 w; w.x = pkh(t.x, t.y); w.y = pkh(t.z, t.w); o8[64 * j] = w; }
            s = wave_sum(s);
            if (F.lane == 0) ssq0[(size_t)m * 16] = s; } }
    }
}

__device__ __forceinline__ void ab_gemv(KArgs a, Frame& F) {
    const h16* hh = (const h16*)((const unsigned char*)a->out + DO_H1H); const h16* wab = (const h16*)(a->ws + WS_WAB); float* ab = (float*)(a->ws + WS_AB);
    pg8::RowScale rs{(const float*)(a->ws + WS_SSQ1), 16};
    const int gw = F.bx * NWAVES + F.wave, NGW = F.G * NWAVES, n = F.lane & 15, q = F.lane >> 4;
    for (int tile = gw; tile < M / 16; tile += NGW) {
        const h16* ap = hh + (size_t)(tile * 16 + n) * D + 8 * q; const h16* bp = wab + (size_t)n * D + 8 * q;
        f32x4 acc0 = (f32x4){0.f, 0.f, 0.f, 0.f}, acc1 = acc0;
#pragma unroll 8
        for (int st = 0; st < 32; st += 2) {
            const f16x8 a0 = *(const f16x8*)(ap + 32 * st), b0 = *(const f16x8*)(bp + 32 * st), a1 = *(const f16x8*)(ap + 32 * st + 32), b1 = *(const f16x8*)(bp + 32 * st + 32);
            acc0 = __builtin_amdgcn_mfma_f32_16x16x32_f16(a0, b0, acc0, 0, 0, 0); acc1 = __builtin_amdgcn_mfma_f32_16x16x32_f16(a1, b1, acc1, 0, 0, 0);
        }
        if (n < 8) {
#pragma unroll
            for (int i = 0; i < 4; ++i) { const int row = tile * 16 + 4 * q + i; ab[(size_t)row * 8 + n] = (acc0[i] + acc1[i]) * rs(row); }
        }
    }
}

__device__ __forceinline__ void gdn_prep(KArgs a, Frame& F) {
    const h16* PAQ = (const h16*)(a->ws + WS_PAQ); h16* QK = (h16*)(a->ws + WS_A);
    const float* cwp = a->in[23];
    const int lane = F.lane, arr = lane >> 5, c4 = (lane & 31) * 4;
    const int gw = F.bx * NWAVES + F.wave, NGW = F.G * NWAVES;
    for (int item = gw; item < (M / 4) * 4; item += NGW) {
        const int hh = item & 3, run = item >> 2, row0 = 4 * run;
        const int qcol = (arr ? C_GK : C_Q) + hh * 128 + c4, qch = qcol - C_Q;
        f32x4 cwq[4];
#pragma unroll
        for (int i = 0; i < 4; ++i) cwq[i] = *(const f32x4*)(cwp + i * CONVCH + qch);
        const float qscale = arr ? 1.0f : 0.08838834764831845f;
        const h16* pq = PAQ + (size_t)row0 * PAQ_W + qcol;
        f32x4 w0, w1, w2;
        if (row0 >= MP) { const float* sc = a->in[5] + (size_t)((row0 - MP) >> 2) * 3 * CONVCH + qch; w0 = *(const f32x4*)sc; w1 = *(const f32x4*)(sc + CONVCH); w2 = *(const f32x4*)(sc + 2 * CONVCH); }
        else if ((row0 & (SEQ - 1)) == 0) { w0 = w1 = w2 = (f32x4){0.f, 0.f, 0.f, 0.f}; }
        else { w0 = unpk4(*(const u32x2*)(pq - 3 * PAQ_W)); w1 = unpk4(*(const u32x2*)(pq - 2 * PAQ_W)); w2 = unpk4(*(const u32x2*)(pq - PAQ_W)); }
        f32x4 xs[4];
#pragma unroll
        for (int i = 0; i < 4; ++i) xs[i] = unpk4(*(const u32x2*)(pq + (size_t)i * PAQ_W));
#pragma unroll
        for (int i = 0; i < 4; ++i) {
            f32x4 cv = w0 * cwq[0] + w1 * cwq[1] + w2 * cwq[2] + xs[i] * cwq[3];
            cv.x = fsilu(cv.x); cv.y = fsilu(cv.y); cv.z = fsilu(cv.z); cv.w = fsilu(cv.w);
            float ss = (cv.x * cv.x + cv.y * cv.y) + (cv.z * cv.z + cv.w * cv.w);
            ss = row_sum16(ss); ss += __shfl_xor(ss, 16);
            const float sc = __builtin_amdgcn_rsqf(ss + 1e-6f) * qscale;
            cv = cv * sc;
            u32x2 o; o.x = pkh(cv.x, cv.y); o.y = pkh(cv.z, cv.w);
            *(u32x2*)(QK + (size_t)(row0 + i) * D + arr * 512 + hh * 128 + c4) = o;
            w0 = w1; w1 = w2; w2 = xs[i];
        }
    }
    const int gt = F.bx * NTHREADS + F.tid, NGT = F.G * NTHREADS;
    for (int i = gt; i < NB_P * APROJ; i += NGT) { const int bb = i / APROJ, cc = i % APROJ; a->out[O_SHIFT_P + i] = h2f(PAQ[(size_t)(bb * SEQ + SEQ - 1) * PAQ_W + cc]); }
    for (int i = gt; i < NB_S * APROJ; i += NGT) { const int bb = i / APROJ, cc = i % APROJ; a->out[O_SHIFT_S + i] = h2f(PAQ[(size_t)(MP + bb * TS + TS - 1) * PAQ_W + cc]); }
    for (int i = gt; i < NB_P * 3 * CONVCH; i += NGT) { const int bb = i / (3 * CONVCH), r = (i / CONVCH) % 3, cc = i % CONVCH; a->out[O_CONV_P + i] = h2f(PAQ[(size_t)(bb * SEQ + SEQ - 3 + r) * PAQ_W + C_Q + cc]); }
    for (int i = gt; i < NB_S * 3 * CONVCH; i += NGT) { const int bb = i / (3 * CONVCH), r = (i / CONVCH) % 3, cc = i % CONVCH; a->out[O_CONV_S + i] = h2f(PAQ[(size_t)(MP + bb * TS + 1 + r) * PAQ_W + C_Q + cc]); }
}

constexpr int NBLK_P = SEQ / 16, NBLK = NBLK_P + 4;
constexpr int RX_BYTES = 8192, RY_BYTES = 17408, GY_BYTES = 10752;
constexpr int ROPS_BYTES = 17664, RG_BYTES = 3584;
constexpr int R_X = 0, R_Y = R_X + 2 * RX_BYTES, R_OPS = R_Y + 3 * RY_BYTES, R_G = R_OPS + 3 * ROPS_BYTES, G_Y = 0;
static_assert(R_G + 2 * RG_BYTES <= RING_BYTES && G_Y + 2 * GY_BYTES <= RING_BYTES, "scan LDS");

__device__ __forceinline__ int blk_row0(int j, int b, int sgrp) { return (j < NBLK_P) ? b * SEQ + 16 * j : MP + 16 * (4 * sgrp + (j - NBLK_P)); }
#define WG_BAR() do { asm volatile("s_waitcnt lgkmcnt(0)" ::: "memory"); __builtin_amdgcn_s_barrier(); asm volatile("" ::: "memory"); } while (0)

struct RwkvPre { u32x2 cr, cw, ck, ca, pr, pw, pk, pa; };
struct RwkvOps { u32x2 r, d, k, q, b; unsigned v; };
__device__ __forceinline__ RwkvOps rwkv_ld(const LAS unsigned char* Y, int s, int kq, int vi) {
    RwkvOps o; const LAS unsigned char* p = Y + s * 128 + kq * 8;
    o.r = *(const LAS u32x2*)(p); o.d = *(const LAS u32x2*)(p + 2048); o.k = *(const LAS u32x2*)(p + 4096); o.q = *(const LAS u32x2*)(p + 6144); o.b = *(const LAS u32x2*)(p + 8192);
    o.v = *(const LAS unsigned*)(Y + 10240 + s * 128 + vi * 4);
    return o;
}
__device__ __forceinline__ float rwkv_step(h2& S0, h2& S1, const RwkvOps& p) {
    float sa = __builtin_amdgcn_fdot2(S0, u2h(p.q.x), 0.f, false); sa = __builtin_amdgcn_fdot2(S1, u2h(p.q.y), sa, false);
    sa = -row_sum16(sa);
    const h2 sah = bc2(sa), vv = u2h(p.v);
    S0 = __builtin_elementwise_fma(S0, u2h(p.d.x), __builtin_elementwise_fma(vv, u2h(p.k.x), sah * u2h(p.b.x)));
    S1 = __builtin_elementwise_fma(S1, u2h(p.d.y), __builtin_elementwise_fma(vv, u2h(p.k.y), sah * u2h(p.b.y)));
    float o = __builtin_amdgcn_fdot2(S0, u2h(p.r.x), 0.f, false); o = __builtin_amdgcn_fdot2(S1, u2h(p.r.y), o, false);
    return row_sum16(o);
}

__device__ __forceinline__ void rwkv_role(KArgs a, Frame& F, int c, int mode) {
    const bool do_stage = (mode != 6), do_scan = (mode != 5), do_write = (mode < 3);
    const bool do_c1 = (mode != 8), do_c2 = (mode != 8 && mode != 9), do_cons = (mode != 8 && mode != 9 && mode != 10);
    const int w = F.wave, lane = F.lane;
    const int b = c >> 4, h = (c >> 1) & 7, half = c & 1;
    const h16* PAQ = (const h16*)(a->ws + WS_PAQ); h16* OB = (h16*)(a->ws + WS_PAQ) + C_Q; float* bon = (float*)(a->ws + WS_BON);
    const float* mu = a->in[12];
    LAS unsigned char* lds = F.lds;
    const int tsl = lane >> 4, kq = lane & 15;
    const int rwA = w & 3;
    const f32x4 mu_r = *(const f32x4*)(mu + C_R + h * 64 + 4 * kq), mu_w = *(const f32x4*)(mu + C_WD + 4 * kq), mu_k = *(const f32x4*)(mu + C_K + h * 64 + 4 * kq), mu_a = *(const f32x4*)(mu + C_AD + 4 * kq);
    const f32x4 kkw = *(const f32x4*)(a->in[18] + h * 64 + 4 * kq);
    const int o_r = C_R + h * 64 + 4 * kq, o_w = C_WD + 4 * kq, o_k = C_K + h * 64 + 4 * kq, o_a = C_AD + 4 * kq;
    const int sA = 4 * rwA + tsl;
    const int sVv = 2 * w + (lane >> 5), vloc = lane & 31, vcolp = C_V + h * 64 + 32 * half + vloc; const float mu_v = mu[vcolp];
    const int kb = 16 * rwA + kq;
    const float w0b = a->in[13][h * 64 + kb], a0b = a->in[15][h * 64 + kb], kab = a->in[19][h * 64 + kb], rkb = a->in[20][h * 64 + kb];
    f16x8 w2f[2], a2f[2];
    { const h16* w2t = (const h16*)(a->ws + WS_W2T) + (size_t)(h * 64 + kb) * 64 + 8 * tsl; const h16* a2t = (const h16*)(a->ws + WS_A2T) + (size_t)(h * 64 + kb) * 64 + 8 * tsl;
      w2f[0] = *(const f16x8*)w2t; w2f[1] = *(const f16x8*)(w2t + 32); a2f[0] = *(const f16x8*)a2t; a2f[1] = *(const f16x8*)(a2t + 32); }
    const int vi = 4 * w + tsl, vrow = 32 * half + vi;
    h2 S0 = (h2){0, 0}, S1 = (h2){0, 0};
    const int sgrp = b;

#define RW_PREFETCH(j) do { const int row_ = b * SEQ + 16 * (j) + sA; const h16* pc_ = PAQ + (size_t)row_ * PAQ_W; const h16* pp_ = pc_ - (((j) == 0 && sA == 0) ? 0 : PAQ_W); \
        pre.cr = *(const u32x2*)(pc_ + o_r); pre.cw = *(const u32x2*)(pc_ + o_w); pre.ck = *(const u32x2*)(pc_ + o_k); pre.ca = *(const u32x2*)(pc_ + o_a); \
        pre.pr = *(const u32x2*)(pp_ + o_r); pre.pw = *(const u32x2*)(pp_ + o_w); pre.pk = *(const u32x2*)(pp_ + o_k); pre.pa = *(const u32x2*)(pp_ + o_a); } while (0)
#define RW_STAGE_A(j, cr, cw, ck, ca, pr, pw, pk, pa) do { \
        LAS unsigned char* X_ = lds + R_X + ((j) & 1) * RX_BYTES; LAS unsigned char* Y_ = lds + R_Y + ((j) % 3) * RY_BYTES; \
        const f32x4 r_ = cr + (pr - cr) * mu_r, w_ = cw + (pw - cw) * mu_w, k_ = ck + (pk - ck) * mu_k, a_ = ca + (pa - ca) * mu_a; \
        { u32x2 t_; t_.x = pkh(r_.x, r_.y); t_.y = pkh(r_.z, r_.w); *(LAS u32x2*)(Y_ + 0 + sA * 128 + kq * 8) = t_; } \
        { u32x2 t_; t_.x = pkh(ftanh(w_.x), ftanh(w_.y)); t_.y = pkh(ftanh(w_.z), ftanh(w_.w)); *(LAS u32x2*)(X_ + 0 + sA * 128 + kq * 8) = t_; } \
        { u32x2 t_; t_.x = pkh(a_.x, a_.y); t_.y = pkh(a_.z, a_.w); *(LAS u32x2*)(X_ + 2048 + sA * 128 + kq * 8) = t_; } \
        *(LAS f32x4*)(X_ + 4096 + sA * 256 + kq * 16) = k_; \
        const f32x4 kkr_ = k_ * kkw; \
        float ss_ = (kkr_.x * kkr_.x + kkr_.y * kkr_.y) + (kkr_.z * kkr_.z + kkr_.w * kkr_.w); \
        ss_ = row_sum16(ss_); \
        const float inv_ = frcp(fmaxf(__builtin_amdgcn_sqrtf(ss_), 1e-12f)); \
        { const f32x4 kn_ = kkr_ * inv_; u32x2 t_; t_.x = pkh(kn_.x, kn_.y); t_.y = pkh(kn_.z, kn_.w); *(LAS u32x2*)(Y_ + 6144 + sA * 128 + kq * 8) = t_; } } while (0)
#define RW_STAGE_V(j, cv, pv) do { LAS unsigned char* Y_ = lds + R_Y + ((j) % 3) * RY_BYTES; \
        const float vl_ = (cv) + ((pv) - (cv)) * mu_v; *(LAS unsigned*)(Y_ + 10240 + sVv * 128 + vloc * 4) = pkh(vl_, vl_); \
        *(LAS h16*)(Y_ + 16384 + vloc * 32 + sVv * 2) = __builtin_bit_cast(h16, (_Float16)vl_); } while (0)
#define RW_STAGE_B(j) do { \
        LAS unsigned char* X_ = lds + R_X + ((j) & 1) * RX_BYTES; LAS unsigned char* Y_ = lds + R_Y + ((j) % 3) * RY_BYTES; \
        f32x4 wacc_ = (f32x4){0.f, 0.f, 0.f, 0.f}, aacc_ = (f32x4){0.f, 0.f, 0.f, 0.f}; \
        _Pragma("unroll") for (int st_ = 0; st_ < 2; ++st_) { \
            const f16x8 ta_ = *(const LAS f16x8*)(X_ + 0 + kq * 128 + tsl * 16 + st_ * 64); \
            const f16x8 aa_ = *(const LAS f16x8*)(X_ + 2048 + kq * 128 + tsl * 16 + st_ * 64); \
            wacc_ = __builtin_amdgcn_mfma_f32_16x16x32_f16(ta_, w2f[st_], wacc_, 0, 0, 0); \
            aacc_ = __builtin_amdgcn_mfma_f32_16x16x32_f16(aa_, a2f[st_], aacc_, 0, 0, 0); } \
        const int row0_ = blk_row0((j), b, sgrp); \
        _Pragma("unroll") for (int i_ = 0; i_ < 4; ++i_) { \
            const int s_ = 4 * tsl + i_; \
            const float ld_ = -0.60653065971f * fsigmoid(w0b + wacc_[i_]); const float dd_ = fexp(ld_); \
            *(LAS float*)(Y_ + 12288 + s_ * 256 + kb * 4) = ld_; \
            const float av_ = fsigmoid(a0b + aacc_[i_]); \
            const float kr_ = *(const LAS float*)(X_ + 4096 + s_ * 256 + kb * 4); \
            const float kkv_ = h2f(*(const LAS h16*)(Y_ + 6144 + s_ * 128 + kb * 2)); \
            const float rv_ = h2f(*(const LAS h16*)(Y_ + 0 + s_ * 128 + kb * 2)); \
            const float kp_ = kr_ * (1.0f + (av_ - 1.0f) * kab); \
            *(LAS h16*)(Y_ + 2048 + s_ * 128 + kb * 2) = __builtin_bit_cast(h16, (_Float16)dd_); \
            *(LAS h16*)(Y_ + 4096 + s_ * 128 + kb * 2) = __builtin_bit_cast(h16, (_Float16)kp_); \
            *(LAS h16*)(Y_ + 8192 + s_ * 128 + kb * 2) = __builtin_bit_cast(h16, (_Float16)(kkv_ * av_)); \
            const float bp_ = row_sum16(rv_ * kp_ * rkb); \
            if (do_write && half == 0 && kq == 0) bon[(size_t)(row0_ + s_) * 32 + h * 4 + rwA] = bp_; } } while (0)

    {
        constexpr int RAWR = 0, RAWW = 8192, RAWK = 16384, RAWA = 24576, RAWV = 32768, RAW_END = 36864;
        constexpr int TWP = 144, CP = 136;
        constexpr int AO0 = RAW_END, AO_TW = 0, AO_AD = 16 * TWP, AO_R = 32 * TWP, AO_KK = AO_R + 16 * CP, AO_KR = AO_KK + 16 * CP, AO_SLOT = ((AO_KR + 16 * CP + 63) / 64) * 64;
        constexpr int VR0 = AO0 + 2 * AO_SLOT;
        constexpr int TLP = 40;
        constexpr int TL0 = VR0 + 4096, T_AR = 0, T_RR = 64 * TLP, T_BR = 2 * 64 * TLP, T_KR = 3 * 64 * TLP, T_BH = 4 * 64 * TLP, T_KH = 5 * 64 * TLP, T_PM = 6 * 64 * TLP, T_PC = T_PM + 256, TL_SLOT = T_PC + 256;
        constexpr int TFP = 68;
        constexpr int GG0 = TL0 + 3 * TL_SLOT, GG_TF = 0, GG_NK = 16 * TFP, GG_MB = GG_NK + 512, GG_MK = GG_MB + 512, GG_SLOT = ((GG_MK + 512 + 63) / 64) * 64, AM0 = GG0 + 2 * GG_SLOT, RC_END = AM0 + 1024;
        static_assert(RC_END <= RING_BYTES, "rwkv chunk LDS");
        const int n = kq, q = tsl;
        const int wu = __builtin_amdgcn_readfirstlane(w);
        const int bcg = (wu == 6) ? 3 : wu;
        constexpr int NIT = NBLK_P + 3;
        if (wu < 3 || wu == 6) {
            float tri[4], mid[4];
#pragma unroll
            for (int s_ = 0; s_ < 4; ++s_) { tri[s_] = (4 * q + s_ <= n) ? 1.0f : 0.0f; mid[s_] = (4 * q + s_ <= 7) ? 1.0f : 0.0f; }
            const int trp = (4 * q + (n >> 2)) * CP + (16 * bcg + 4 * (n & 3)) * 2;
            const int kb = 16 * bcg + n;
            const float w0b = a->in[13][h * 64 + kb], a0b = a->in[15][h * 64 + kb], kab = a->in[19][h * 64 + kb], rkb = a->in[20][h * 64 + kb];
            f16x8 w2f[2], a2f[2];
            { const h16* w2t = (const h16*)(a->ws + WS_W2T) + (size_t)(h * 64 + kb) * 64 + 8 * q; const h16* a2t = (const h16*)(a->ws + WS_A2T) + (size_t)(h * 64 + kb) * 64 + 8 * q;
              w2f[0] = *(const f16x8*)w2t; w2f[1] = *(const f16x8*)(w2t + 32); a2f[0] = *(const f16x8*)a2t; a2f[1] = *(const f16x8*)(a2t + 32); }
            WG_BAR();
            for (int it = 0; it < NIT; ++it) {
                if (it >= 1 && it - 1 < NBLK_P) {
                    const int jc = it - 1; const LAS unsigned char* AO = lds + AO0 + (jc & 1) * AO_SLOT; LAS unsigned char* P = lds + TL0 + (jc % 3) * TL_SLOT;
                    f32x4 wacc = (f32x4){0.f, 0.f, 0.f, 0.f}, aacc = wacc;
#pragma unroll
                    for (int st = 0; st < 2; ++st) {
                        const f16x8 ta = *(const LAS f16x8*)(AO + AO_TW + n * TWP + q * 16 + st * 64);
                        const f16x8 aa = *(const LAS f16x8*)(AO + AO_AD + n * TWP + q * 16 + st * 64);
                        wacc = __builtin_amdgcn_mfma_f32_16x16x32_f16(ta, w2f[st], wacc, 0, 0, 0);
                        aacc = __builtin_amdgcn_mfma_f32_16x16x32_f16(aa, a2f[st], aacc, 0, 0, 0);
                    }
                    const f32x4 rv = unpk4(__builtin_bit_cast(u32x2, __builtin_amdgcn_ds_read_tr16_b64_v4i16((LAS v4i16_t*)(AO + AO_R + trp))));
                    const f32x4 kkv = unpk4(__builtin_bit_cast(u32x2, __builtin_amdgcn_ds_read_tr16_b64_v4i16((LAS v4i16_t*)(AO + AO_KK + trp))));
                    const f32x4 krv = unpk4(__builtin_bit_cast(u32x2, __builtin_amdgcn_ds_read_tr16_b64_v4i16((LAS v4i16_t*)(AO + AO_KR + trp))));
                    f32x4 ld, av;
#pragma unroll
                    for (int e = 0; e < 4; ++e) { ld[e] = -0.60653065971f * fsigmoid(w0b + wacc[e]); av[e] = fsigmoid(a0b + aacc[e]); }
                    f32x4 L = (f32x4){0.f, 0.f, 0.f, 0.f}, Lm = L, Lf = L;
#pragma unroll
                    for (int s_ = 0; s_ < 4; ++s_) {
                        L = __builtin_amdgcn_mfma_f32_16x16x4f32(tri[s_], ld[s_], L, 0, 0, 0);
                        Lm = __builtin_amdgcn_mfma_f32_16x16x4f32(mid[s_], ld[s_], Lm, 0, 0, 0);
                        Lf = __builtin_amdgcn_mfma_f32_16x16x4f32(1.0f, ld[s_], Lf, 0, 0, 0);
                    }
                    const float lmid = Lm[0], PM = fexp(lmid), c15 = fexp(Lf[0] - lmid);
                    f32x4 E, Em1, Ei;
#pragma unroll
                    for (int e = 0; e < 4; ++e) { E[e] = fexp(L[e] - lmid); Em1[e] = fexp(L[e] - ld[e] - lmid); Ei[e] = frcp(E[e]); }
                    const f32x4 E15 = Ei * c15;
                    const f32x4 kpv = krv * (1.0f + (av - 1.0f) * kab), kav = kkv * av;
                    LAS unsigned char* tw = P + kb * TLP + q * 8;
                    *(LAS f16x4*)(tw + T_AR) = cvt4(-kkv * Em1); *(LAS f16x4*)(tw + T_RR) = cvt4(rv * E);
                    *(LAS f16x4*)(tw + T_BR) = cvt4(kav * Ei); *(LAS f16x4*)(tw + T_KR) = cvt4(kpv * Ei);
                    *(LAS f16x4*)(tw + T_BH) = cvt4(kav * E15); *(LAS f16x4*)(tw + T_KH) = cvt4(kpv * E15);
                    if (q == 0) { *(LAS float*)(P + T_PM + kb * 4) = PM; *(LAS float*)(P + T_PC + kb * 4) = PM * c15; }
                    const int row0 = b * SEQ + 16 * jc;
#pragma unroll
                    for (int e = 0; e < 4; ++e) { const float bp = row_sum16(rv[e] * kpv[e] * rkb);
                        if (do_write && half == 0 && n == 0) bon[(size_t)(row0 + 4 * q + e) * 32 + h * 4 + bcg] = bp; }
                }
                WG_BAR();
            }
        } else if (wu == 4 || wu == 5) {
            const int wa = wu - 4;
            const h16* gbase = PAQ + (size_t)(b * SEQ) * PAQ_W;
            const unsigned gt0 = (unsigned)(((lane >> 3) * PAQ_W + (wa == 0 ? C_R + h * 64 : C_K + h * 64) + 8 * (lane & 7)) * 2);
            const unsigned gt1 = (unsigned)(((lane >> 3) * PAQ_W + (wa == 0 ? C_WD : C_AD) + 8 * (lane & 7)) * 2);
            const unsigned gtv = (unsigned)(((lane >> 2) * PAQ_W + C_V + h * 64 + 32 * half + 8 * (lane & 3)) * 2);
            const int d0 = (wa == 0) ? RAWR : RAWK, d1 = (wa == 0) ? RAWW : RAWA;
#define RC_DMA(j) do { const unsigned char* gb_ = (const unsigned char*)(gbase + (size_t)(16 * (j)) * PAQ_W); const int ro_ = ((16 * (j)) & 63) * 128; \
                __builtin_amdgcn_global_load_lds((const unsigned*)(gb_ + gt0), (LAS unsigned*)(lds + d0 + ro_), 16, 0, 0); \
                __builtin_amdgcn_global_load_lds((const unsigned*)(gb_ + gt0 + 8 * PAQ_W * 2), (LAS unsigned*)(lds + d0 + ro_ + 1024), 16, 0, 0); \
                __builtin_amdgcn_global_load_lds((const unsigned*)(gb_ + gt1), (LAS unsigned*)(lds + d1 + ro_), 16, 0, 0); \
                __builtin_amdgcn_global_load_lds((const unsigned*)(gb_ + gt1 + 8 * PAQ_W * 2), (LAS unsigned*)(lds + d1 + ro_ + 1024), 16, 0, 0); \
                __builtin_amdgcn_global_load_lds((const unsigned*)(gb_ + gtv), (LAS unsigned*)(lds + RAWV + (ro_ >> 1)), 16, 0, 0); } while (0)
            RC_DMA(0); RC_DMA(1);
            asm volatile("s_waitcnt vmcnt(0)" ::: "memory");
            const float mu_v0 = mu[C_V + h * 64 + 32 * half + 2 * kq], mu_v1 = mu[C_V + h * 64 + 32 * half + 2 * kq + 1];
            WG_BAR();
            for (int it = 0; it < NIT; ++it) {
                if (it + 2 < NBLK_P) RC_DMA(it + 2);
                if (it < NBLK_P) {
                    LAS unsigned char* AO = lds + AO0 + (it & 1) * AO_SLOT;
#pragma unroll
                    for (int p = 0; p < 2; ++p) {
                        const int i = 8 * wa + 4 * p + tsl, rowc = (16 * it + i) & 63, rowp = (rowc - 1) & 63;
                        const f32x4 cr = unpk4(*(const LAS u32x2*)(lds + RAWR + rowc * 128 + kq * 8)), cw_ = unpk4(*(const LAS u32x2*)(lds + RAWW + rowc * 128 + kq * 8)),
                                    ck = unpk4(*(const LAS u32x2*)(lds + RAWK + rowc * 128 + kq * 8)), ca = unpk4(*(const LAS u32x2*)(lds + RAWA + rowc * 128 + kq * 8));
                        f32x4 pr = unpk4(*(const LAS u32x2*)(lds + RAWR + rowp * 128 + kq * 8)), pw = unpk4(*(const LAS u32x2*)(lds + RAWW + rowp * 128 + kq * 8)),
                              pk = unpk4(*(const LAS u32x2*)(lds + RAWK + rowp * 128 + kq * 8)), pa = unpk4(*(const LAS u32x2*)(lds + RAWA + rowp * 128 + kq * 8));
                        const unsigned cvu = *(const LAS unsigned*)(lds + RAWV + rowc * 64 + kq * 4); unsigned pvu = *(const LAS unsigned*)(lds + RAWV + rowp * 64 + kq * 4);
                        if (it == 0 && i == 0) { pr = pw = pk = pa = (f32x4){0.f, 0.f, 0.f, 0.f}; pvu = 0u; }
                        const f32x4 r_ = cr + (pr - cr) * mu_r, w_ = cw_ + (pw - cw_) * mu_w, k_ = ck + (pk - ck) * mu_k, a_ = ca + (pa - ca) * mu_a;
                        { u32x2 t_; t_.x = pkh(r_.x, r_.y); t_.y = pkh(r_.z, r_.w); *(LAS u32x2*)(AO + AO_R + i * CP + kq * 8) = t_; }
                        { u32x2 t_; t_.x = pkh(ftanh(w_.x), ftanh(w_.y)); t_.y = pkh(ftanh(w_.z), ftanh(w_.w)); *(LAS u32x2*)(AO + AO_TW + i * TWP + kq * 8) = t_; }
                        { u32x2 t_; t_.x = pkh(a_.x, a_.y); t_.y = pkh(a_.z, a_.w); *(LAS u32x2*)(AO + AO_AD + i * TWP + kq * 8) = t_; }
                        { u32x2 t_; t_.x = pkh(k_.x, k_.y); t_.y = pkh(k_.z, k_.w); *(LAS u32x2*)(AO + AO_KR + i * CP + kq * 8) = t_; }
                        const f32x4 kkr = k_ * kkw;
                        float ss = (kkr.x * kkr.x + kkr.y * kkr.y) + (kkr.z * kkr.z + kkr.w * kkr.w);
                        ss = row_sum16(ss);
                        const float inv = frcp(fmaxf(__builtin_amdgcn_sqrtf(ss), 1e-12f));
                        { const f32x4 kn = kkr * inv; u32x2 t_; t_.x = pkh(kn.x, kn.y); t_.y = pkh(kn.z, kn.w); *(LAS u32x2*)(AO + AO_KK + i * CP + kq * 8) = t_; }
                        { const h2 cv2 = u2h(cvu), pv2 = u2h(pvu); const float c0 = (float)cv2.x, c1 = (float)cv2.y;
                          *(LAS unsigned*)(lds + VR0 + (it & 3) * 1024 + i * 64 + kq * 4) = pkh(c0 + ((float)pv2.x - c0) * mu_v0, c1 + ((float)pv2.y - c1) * mu_v1); }
                    }
                }
                if (it + 2 < NBLK_P) asm volatile("s_waitcnt vmcnt(5)" ::: "memory"); else asm volatile("s_waitcnt vmcnt(0)" ::: "memory");
                WG_BAR();
            }
#undef RC_DMA
        } else if (wu == 3) {
            const int tra = (4 * q + (n >> 2)) * TLP + (n & 3) * 8;
            WG_BAR();
            for (int it = 0; it < NIT; ++it) {
                if (it >= 2 && it - 2 < NBLK_P) {
                    const int jc = it - 2; const LAS unsigned char* P = lds + TL0 + (jc % 3) * TL_SLOT; LAS unsigned char* Gs = lds + GG0 + (jc & 1) * GG_SLOT; LAS unsigned char* AM = lds + AM0;
                    f32x4 nb = (f32x4){0.f, 0.f, 0.f, 0.f}, nk = nb, mb = nb, mk = nb;
#pragma unroll
                    for (int s_ = 0; s_ < 4; ++s_) {
                        const f16x4 ar = __builtin_bit_cast(f16x4, __builtin_amdgcn_ds_read_tr16_b64_v4i16((LAS v4i16_t*)(P + T_AR + 16 * s_ * TLP + tra)));
                        const f16x4 rr = __builtin_bit_cast(f16x4, __builtin_amdgcn_ds_read_tr16_b64_v4i16((LAS v4i16_t*)(P + T_RR + 16 * s_ * TLP + tra)));
                        const f16x4 br = __builtin_bit_cast(f16x4, __builtin_amdgcn_ds_read_tr16_b64_v4i16((LAS v4i16_t*)(P + T_BR + 16 * s_ * TLP + tra)));
                        const f16x4 kr = __builtin_bit_cast(f16x4, __builtin_amdgcn_ds_read_tr16_b64_v4i16((LAS v4i16_t*)(P + T_KR + 16 * s_ * TLP + tra)));
                        nb = MFMA16(ar, br, nb); nk = MFMA16(ar, kr, nk); mb = MFMA16(rr, br, mb); mk = MFMA16(rr, kr, mk);
                    }
#pragma unroll
                    for (int r = 0; r < 4; ++r) { const int i = 4 * q + r;
                        *(LAS float*)(AM + (i * 16 + n) * 4) = (i > n) ? nb[r] : 0.f;
                        *(LAS h16*)(Gs + GG_NK + i * 32 + n * 2) = __builtin_bit_cast(h16, (_Float16)((i > n) ? nk[r] : 0.f));
                        *(LAS h16*)(Gs + GG_MB + i * 32 + n * 2) = __builtin_bit_cast(h16, (_Float16)((i >= n) ? mb[r] : 0.f));
                        *(LAS h16*)(Gs + GG_MK + i * 32 + n * 2) = __builtin_bit_cast(h16, (_Float16)((i >= n) ? mk[r] : 0.f)); }
                    LDS_WAIT();
                    float tc[16];
#pragma unroll
                    for (int r = 0; r < 16; ++r) {
                        float arow[16];
#pragma unroll
                        for (int m4 = 0; 4 * m4 < r; ++m4) { const f32x4 av = *(const LAS f32x4*)(AM + (r * 16 + 4 * m4) * 4); arow[4 * m4] = av.x; arow[4 * m4 + 1] = av.y; arow[4 * m4 + 2] = av.z; arow[4 * m4 + 3] = av.w; }
                        float a0 = (r == n) ? 1.0f : 0.0f, a1 = 0.f;
#pragma unroll
                        for (int m = 0; m + 1 < r; m += 2) { a0 += arow[m] * tc[m]; a1 += arow[m + 1] * tc[m + 1]; }
                        if (r & 1) a0 += arow[r - 1] * tc[r - 1];
                        tc[r] = a0 + a1;
                    }
                    if (q == 0) {
#pragma unroll
                        for (int r = 0; r < 16; ++r) *(LAS float*)(Gs + GG_TF + r * TFP + n * 4) = tc[r];
                    }
                }
                WG_BAR();
            }
        } else {
            f32x4 Xs[2][4];
#pragma unroll
            for (int cw = 0; cw < 2; ++cw)
#pragma unroll
                for (int t = 0; t < 4; ++t) Xs[cw][t] = (f32x4){0.f, 0.f, 0.f, 0.f};
            const int tra = (4 * q + (n >> 2)) * TLP + (n & 3) * 8;
            WG_BAR();
            for (int it = 0; it < NIT; ++it) {
                if (it >= 3) {
                    const int jc = it - 3; const LAS unsigned char* P = lds + TL0 + (jc % 3) * TL_SLOT; const LAS unsigned char* Gs = lds + GG0 + (jc & 1) * GG_SLOT;
                    const LAS unsigned char* VR = lds + VR0 + (jc & 3) * 1024;
                    f16x4 art[4], rrt[4], bht[4], kht[4]; f32x4 pm4[4], pc4[4];
#pragma unroll
                    for (int t = 0; t < 4; ++t) {
                        art[t] = __builtin_bit_cast(f16x4, __builtin_amdgcn_ds_read_tr16_b64_v4i16((LAS v4i16_t*)(P + T_AR + 16 * t * TLP + tra)));
                        rrt[t] = __builtin_bit_cast(f16x4, __builtin_amdgcn_ds_read_tr16_b64_v4i16((LAS v4i16_t*)(P + T_RR + 16 * t * TLP + tra)));
                        bht[t] = *(const LAS f16x4*)(P + T_BH + (16 * t + n) * TLP + q * 8); kht[t] = *(const LAS f16x4*)(P + T_KH + (16 * t + n) * TLP + q * 8);
                        pm4[t] = *(const LAS f32x4*)(P + T_PM + (16 * t + 4 * q) * 4); pc4[t] = *(const LAS f32x4*)(P + T_PC + (16 * t + 4 * q) * 4);
                    }
                    const f16x4 nkf = *(const LAS f16x4*)(Gs + GG_NK + n * 32 + 8 * q), mbf = *(const LAS f16x4*)(Gs + GG_MB + n * 32 + 8 * q), mkf = *(const LAS f16x4*)(Gs + GG_MK + n * 32 + 8 * q);
                    float tf[4];
#pragma unroll
                    for (int s_ = 0; s_ < 4; ++s_) tf[s_] = *(const LAS float*)(Gs + GG_TF + n * TFP + (4 * q + s_) * 4);
#pragma unroll
                    for (int cw = 0; cw < 2; ++cw) {
                        const f16x4 Vf = __builtin_bit_cast(f16x4, __builtin_amdgcn_ds_read_tr16_b64_v4i16((LAS v4i16_t*)(VR + (4 * q + (n >> 2)) * 64 + (16 * cw + 4 * (n & 3)) * 2)));
                        f16x4 Xp[4];
#pragma unroll
                        for (int t = 0; t < 4; ++t) Xp[t] = cvt4(Xs[cw][t] * pm4[t]);
                        f32x4 Wa = (f32x4){0.f, 0.f, 0.f, 0.f}, Oa = Wa;
#pragma unroll
                        for (int t = 0; t < 4; ++t) { Wa = MFMA16(art[t], Xp[t], Wa); Oa = MFMA16(rrt[t], Xp[t], Oa); }
                        Wa = MFMA16(nkf, Vf, Wa);
                        f32x4 U = (f32x4){0.f, 0.f, 0.f, 0.f};
#pragma unroll
                        for (int s_ = 0; s_ < 4; ++s_) U = __builtin_amdgcn_mfma_f32_16x16x4f32(tf[s_], Wa[s_], U, 0, 0, 0);
                        const f16x4 Ub = cvt4(U);
                        Oa = MFMA16(mbf, Ub, Oa);
                        Oa = MFMA16(mkf, Vf, Oa);
#pragma unroll
                        for (int t = 0; t < 4; ++t) Xs[cw][t] = MFMA16(bht[t], Ub, MFMA16(kht[t], Vf, Xs[cw][t] * pc4[t]));
                        if (do_write) {
#pragma unroll
                            for (int r = 0; r < 4; ++r) OB[(size_t)(b * SEQ + 16 * jc + 4 * q + r) * PAQ_W + h * 64 + 32 * half + 16 * cw + n] = __builtin_bit_cast(h16, (_Float16)Oa[r]);
                        }
                    }
                }
                WG_BAR();
            }
            if (do_write) {
#pragma unroll
                for (int cw = 0; cw < 2; ++cw)
#pragma unroll
                    for (int t = 0; t < 4; ++t) *(f32x4*)(a->out + O_RWKV_P + ((size_t)(b * 8 + h)) * 4096 + (size_t)(32 * half + 16 * cw + n) * 64 + 16 * t + 4 * q) = Xs[cw][t];
            }
        }
    }
    if (!do_write) return;
    for (int it = 0; it < 6; ++it) {
        if (it < 4) {
            const int j = NBLK_P + it, row0 = blk_row0(j, b, sgrp);
            if (w < 4) {
                const int row = row0 + sA; const h16* pc = PAQ + (size_t)row * PAQ_W;
                const f32x4 cr = unpk4(*(const u32x2*)(pc + o_r)), cw = unpk4(*(const u32x2*)(pc + o_w)), ck = unpk4(*(const u32x2*)(pc + o_k)), ca = unpk4(*(const u32x2*)(pc + o_a));
                f32x4 pr, pw, pk, pa;
                if ((sA & 3) == 0) {
                    const float* sp = a->in[3] + (size_t)((row - MP) >> 2) * APROJ;
                    pr = *(const f32x4*)(sp + o_r); pw = *(const f32x4*)(sp + o_w); pk = *(const f32x4*)(sp + o_k); pa = *(const f32x4*)(sp + o_a);
                } else {
                    const h16* pp = pc - PAQ_W;
                    pr = unpk4(*(const u32x2*)(pp + o_r)); pw = unpk4(*(const u32x2*)(pp + o_w)); pk = unpk4(*(const u32x2*)(pp + o_k)); pa = unpk4(*(const u32x2*)(pp + o_a));
                }
                RW_STAGE_A(j, cr, cw, ck, ca, pr, pw, pk, pa);
            }
            { const int row = row0 + sVv; const float cv = h2f(PAQ[(size_t)row * PAQ_W + vcolp]);
              const float pv = ((sVv & 3) == 0) ? a->in[3][(size_t)((row - MP) >> 2) * APROJ + vcolp] : h2f(PAQ[(size_t)(row - 1) * PAQ_W + vcolp]);
              RW_STAGE_V(j, cv, pv); }
        }
        if (w >= 4 && it >= 1 && it - 1 < 4) RW_STAGE_B(NBLK_P + it - 1);
        if (it >= 2) {
            const int j = NBLK_P + it - 2; const int row0 = blk_row0(j, b, sgrp);
            const LAS unsigned char* Y = lds + R_Y + (j % 3) * RY_BYTES;
            const size_t sbase = ((size_t)((row0 - MP) >> 2) * 8 + h) * 4096 + vrow * 64 + 4 * kq;
            f32x4 st[4];
#pragma unroll
            for (int q = 0; q < 4; ++q) st[q] = *(const f32x4*)(a->in[2] + sbase + (size_t)q * 8 * 4096);
            float osave = 0.f;
#pragma unroll
            for (int q = 0; q < 4; ++q) {
                S0 = (h2){(_Float16)st[q].x, (_Float16)st[q].y}; S1 = (h2){(_Float16)st[q].z, (_Float16)st[q].w};
#pragma unroll
                for (int s = 4 * q; s < 4 * q + 4; ++s) { const RwkvOps p = rwkv_ld(Y, s, kq, vi); const float o = rwkv_step(S0, S1, p); osave = (kq == s) ? o : osave; }
                *(f32x4*)(a->out + O_RWKV_S + sbase + (size_t)q * 8 * 4096) = (f32x4){(float)S0.x, (float)S0.y, (float)S1.x, (float)S1.y};
            }
            OB[(size_t)(row0 + kq) * PAQ_W + h * 64 + vrow] = __builtin_bit_cast(h16, (_Float16)osave);
        }
        WG_BAR();
    }
#undef RW_PREFETCH
#undef RW_PREFETCH_V
#undef RW_STAGE_A
#undef RW_STAGE_V
#undef RW_STAGE_B
}

struct GdnPre { u32x4 qk; h16 v[4]; float ain, bin, vb; };
struct GdnOps { u32x4 q, k; unsigned v; float eg, beta; unsigned meh; };
__device__ __forceinline__ GdnOps gdn_ld(const LAS unsigned char* Y, int s, int kq, int vi) {
    GdnOps o;
    o.q = *(const LAS u32x4*)(Y + 0 + s * 256 + kq * 16); o.k = *(const LAS u32x4*)(Y + 4096 + s * 256 + kq * 16);
    o.v = *(const LAS unsigned*)(Y + 8192 + s * 128 + vi * 4); o.eg = *(const LAS float*)(Y + 10240 + s * 16); o.beta = *(const LAS float*)(Y + 10240 + s * 16 + 4); o.meh = *(const LAS unsigned*)(Y + 10240 + s * 16 + 8);
    return o;
}
__device__ __forceinline__ float gdn_step(h2 (&S)[4], const GdnOps& p) {
    float ks = __builtin_amdgcn_fdot2(S[1], u2h(p.k.y), __builtin_amdgcn_fdot2(S[0], u2h(p.k.x), 0.f, false), false) + __builtin_amdgcn_fdot2(S[3], u2h(p.k.w), __builtin_amdgcn_fdot2(S[2], u2h(p.k.z), 0.f, false), false);
    ks = row_sum16(ks);
    const float vv = (float)u2h(p.v).x;
    const float dl = vv - p.eg * ks;
    const h2 dlh = bc2(dl), meh = u2h(p.meh);
    S[0] = __builtin_elementwise_fma(u2h(p.k.x), dlh, __builtin_elementwise_fma(S[0], meh, S[0])); S[1] = __builtin_elementwise_fma(u2h(p.k.y), dlh, __builtin_elementwise_fma(S[1], meh, S[1]));
    S[2] = __builtin_elementwise_fma(u2h(p.k.z), dlh, __builtin_elementwise_fma(S[2], meh, S[2])); S[3] = __builtin_elementwise_fma(u2h(p.k.w), dlh, __builtin_elementwise_fma(S[3], meh, S[3]));
    float o = __builtin_amdgcn_fdot2(S[0], u2h(p.q.x), 0.f, false); o = __builtin_amdgcn_fdot2(S[1], u2h(p.q.y), o, false);
    o = __builtin_amdgcn_fdot2(S[2], u2h(p.q.z), o, false); o = __builtin_amdgcn_fdot2(S[3], u2h(p.q.w), o, false);
    return row_sum16(o);
}

__device__ __forceinline__ void gdn_role(KArgs a, Frame& F, int cc, int mode) {
    const bool do_stage = (mode != 4), do_scan = (mode != 3), do_write = (mode < 3);
    const int w = F.wave, lane = F.lane;
    const int b = cc >> 4, hh = (cc >> 2) & 3, qt = cc & 3;
    const h16* PAQ = (const h16*)(a->ws + WS_PAQ); h16* OB = (h16*)(a->ws + WS_PAQ) + C_Q; const float* ab = (const float*)(a->ws + WS_AB);
    const float* cwp = a->in[23];
    LAS unsigned char* lds = F.lds;
    const h16* QK = (const h16*)(a->ws + WS_A);
    const int qarr = w >> 2, qslot = ((w & 3) << 2) + (lane >> 4), qj = lane & 15;
    const int qkoff = qarr * 512 + hh * 128 + 8 * qj;
    const int tsl = lane >> 4, kq = lane & 15;
    const int sV = 2 * w + (lane >> 5), vloc = lane & 31, vcolp = C_GV + hh * 128 + 32 * qt + vloc, vch = vcolp - C_Q;
    float cwv[4];
#pragma unroll
    for (int i = 0; i < 4; ++i) cwv[i] = cwp[i * CONVCH + vch];
    const float negA = -fexp(a->in[24][hh]), dtb = a->in[25][hh];
    const int vi = 4 * w + tsl, vcol = 32 * qt + vi;
    const int sgrp = b;

#define GD_QK(Y_, v_) do { *(LAS u32x4*)((Y_) + qarr * 4096 + qslot * 256 + qj * 16) = (v_); } while (0)
#define GD_GB(Y_, ain_, bin_) do { if (w == 0 && lane < 16) { const float xx_ = (ain_) + dtb; const float sp_ = (xx_ > 20.f) ? xx_ : __logf(1.0f + fexp(xx_)); \
        const float eg_ = fexp(negA * sp_), me_ = eg_ - 1.0f, bt_ = fsigmoid(bin_); *(LAS u32x4*)((Y_) + 10240 + lane * 16) = (u32x4){__builtin_bit_cast(unsigned, bt_ * eg_), __builtin_bit_cast(unsigned, bt_), pkh(me_, me_), 0u}; } } while (0)
#define GD_PREFETCH(j) do { pre.qk = *(const u32x4*)(QK + (size_t)(b * SEQ + 16 * (j) + qslot) * D + qkoff); \
        const int rowv_ = b * SEQ + 16 * (j) + sV; \
        _Pragma("unroll") for (int i_ = 0; i_ < 4; ++i_) { int rr_ = rowv_ - 3 + i_; rr_ = rr_ < b * SEQ ? b * SEQ : rr_; pre.v[i_] = PAQ[(size_t)rr_ * PAQ_W + vcolp]; } \
        pre.vb = ab[(size_t)rowv_ * 8 + 4 + hh]; \
        if (w == 0 && lane < 16) { const int rg_ = b * SEQ + 16 * (j) + lane; pre.ain = ab[(size_t)rg_ * 8 + hh]; pre.bin = ab[(size_t)rg_ * 8 + 4 + hh]; } } while (0)

    {
        constexpr int KP = 272, VP = 80, TP = 68;
        constexpr int GC_KBE = 0, GC_QD = 16 * KP, GC_KD = 32 * KP, GC_QKM = 48 * KP, GC_VB = GC_QKM + 512, GC_EG = GC_VB + 32 * VP, GC_TF = GC_EG + 16, GC_SLOT = ((GC_TF + 16 * TP + 63) / 64) * 64;
        constexpr int RD = 6, TA0 = 2 * GC_SLOT, KQ0 = TA0 + 2048, AB0 = KQ0 + RD * 8192, VR0 = AB0 + RD * 1024, GC_END = VR0 + 8 * 1024;
        static_assert(GC_END <= RING_BYTES, "chunk LDS");
        const int n = lane & 15, q = lane >> 4;
        const int wu = __builtin_amdgcn_readfirstlane(w);
        const int only = (mode >= 11) ? mode - 11 : -1;
#define ROLE_ON(r_) (only < 0 || only == (r_))
#define GC_GATES(a_cur_, b_cur_) \
                const float xx = (a_cur_) + dtb; const float sp = (xx > 20.f) ? xx : __logf(1.0f + fexp(xx)); \
                const float bet = fsigmoid(b_cur_); float gc = negA * sp; \
                gc += dppf<0x111>(gc); gc += dppf<0x112>(gc); gc += dppf<0x114>(gc); gc += dppf<0x118>(gc); \
                const float egi = fexp(gc);
        const int rko = n * 256 + ((q & 1) << 3), rkx = (q >> 1) ^ n;
#define GC_RAWK(j, t_) (*(const LAS u32x2*)(lds + KQ0 + ((j) % RD) * 8192 + rko + (((2 * (t_)) ^ rkx) << 4)))
#define GC_RAWQ(j, t_) (*(const LAS u32x2*)(lds + KQ0 + ((j) % RD) * 8192 + 4096 + rko + (((2 * (t_)) ^ rkx) << 4)))
#define GC_LD_AB(j) do { const LAS unsigned char* abp_ = lds + AB0 + ((j) % RD) * 1024 + n * 32 + hh * 4; pa_in = *(const LAS float*)abp_; pb_in = *(const LAS float*)(abp_ + 16); } while (0)
        if (wu < 2) {
            f32x4 Sc[8];
#pragma unroll
            for (int t = 0; t < 8; ++t) Sc[t] = (f32x4){0.f, 0.f, 0.f, 0.f};
            WG_BAR();
            for (int it = -1; it <= NBLK_P; ++it) {
                if (it >= 1 && ROLE_ON(4)) {
                    const int jc = it - 1; const LAS unsigned char* L = lds + (jc & 1) * GC_SLOT;
                    f16x4 Sb[8];
#pragma unroll
                    for (int t = 0; t < 8; ++t) Sb[t] = cvt4(Sc[t]);
                    f32x4 X = *(const LAS f32x4*)(L + GC_VB + (16 * w + n) * VP + 16 * q);
                    f32x4 Oa = (f32x4){0.f, 0.f, 0.f, 0.f};
#pragma unroll
                    for (int t = 0; t < 8; ++t) {
                        X = MFMA16(*(const LAS f16x4*)(L + GC_KBE + n * KP + (16 * t + 4 * q) * 2), Sb[t], X);
                        Oa = MFMA16(*(const LAS f16x4*)(L + GC_QD + n * KP + (16 * t + 4 * q) * 2), Sb[t], Oa);
                    }
                    f32x4 VN = (f32x4){0.f, 0.f, 0.f, 0.f};
#pragma unroll
                    for (int s_ = 0; s_ < 4; ++s_) VN = __builtin_amdgcn_mfma_f32_16x16x4f32(*(const LAS float*)(L + GC_TF + n * TP + (4 * q + s_) * 4), X[s_], VN, 0, 0, 0);
                    const f16x4 VNb = cvt4(VN);
                    Oa = MFMA16(*(const LAS f16x4*)(L + GC_QKM + n * 32 + 8 * q), VNb, Oa);
                    const float eg15 = *(const LAS float*)(L + GC_EG);
                    const LAS unsigned char* kdp = L + GC_KD + (4 * q + (n >> 2)) * KP + (4 * (n & 3)) * 2;
#pragma unroll
                    for (int t = 0; t < 8; ++t) {
                        const f16x4 kdt = __builtin_bit_cast(f16x4, __builtin_amdgcn_ds_read_tr16_b64_v4i16((LAS v4i16_t*)(kdp + 32 * t)));
                        Sc[t] = MFMA16(kdt, VNb, Sc[t] * eg15);
                    }
                    if (do_write) {
#pragma unroll
                        for (int r = 0; r < 4; ++r) OB[(size_t)(b * SEQ + 16 * jc + 4 * q + r) * PAQ_W + 512 + hh * 128 + 32 * qt + 16 * w + n] = __builtin_bit_cast(h16, (_Float16)Oa[r]);
                    }
                }
                WG_BAR();
            }
            if (do_write) {
#pragma unroll
                for (int t = 0; t < 8; ++t)
#pragma unroll
                    for (int r = 0; r < 4; ++r) a->out[O_DELTA_P + ((size_t)(b * 4 + hh)) * 16384 + (size_t)(16 * t + 4 * q + r) * 128 + 32 * qt + 16 * w + n] = Sc[t][r];
            }
        } else if (wu < 4) {
            const int tp = wu - 2;
            LAS unsigned char* TA = lds + 2 * GC_SLOT + tp * 1024;
            float pa_in = 0.f, pb_in = 0.f;
            float tc[16];
#pragma unroll
            for (int r = 0; r < 16; ++r) tc[r] = 0.f;
            WG_BAR();
            for (int it = -1; it <= NBLK_P; ++it) {
                const int c1 = it + 1;
                if (!ROLE_ON(0)) {} else if ((c1 & 1) == tp && c1 < NBLK_P) {
                    GC_LD_AB(c1);
                    u32x2 kfr[8];
#pragma unroll
                    for (int t = 0; t < 8; ++t) kfr[t] = GC_RAWK(c1, t);
                    GC_GATES(pa_in, pb_in) (void)egi;
                    f32x4 kk = (f32x4){0.f, 0.f, 0.f, 0.f};
#pragma unroll
                    for (int t = 0; t < 8; ++t) kk = MFMA16(u2q(kfr[t]), u2q(kfr[t]), kk);
#pragma unroll
                    for (int r = 0; r < 4; ++r) { const int i = 4 * q + r; const float gci = __shfl(gc, i + (lane & 48)), bi = __shfl(bet, i + (lane & 48));
                        *(LAS float*)(TA + (i * 16 + n) * 4) = (i > n) ? bi * kk[r] * fexp(fminf(gci - gc, 0.f)) : 0.f; }
                    LDS_WAIT();
#pragma unroll
                    for (int r = 0; r < 8; ++r) {
                        float arow[8];
#pragma unroll
                        for (int m4 = 0; 4 * m4 < r; ++m4) { const f32x4 av = *(const LAS f32x4*)(TA + (r * 16 + 4 * m4) * 4); arow[4 * m4] = av.x; arow[4 * m4 + 1] = av.y; arow[4 * m4 + 2] = av.z; arow[4 * m4 + 3] = av.w; }
                        float a0 = (r == n) ? 1.0f : 0.0f, a1 = 0.f;
#pragma unroll
                        for (int m = 0; m + 1 < r; m += 2) { a0 -= arow[m] * tc[m]; a1 -= arow[m + 1] * tc[m + 1]; }
                        if (r & 1) a0 -= arow[r - 1] * tc[r - 1];
                        tc[r] = a0 + a1;
                    }
                } else if ((it & 1) == tp && it >= 0 && it < NBLK_P) {
                    LAS unsigned char* L = lds + (it & 1) * GC_SLOT;
#pragma unroll
                    for (int r = 8; r < 16; ++r) {
                        float arow[16];
#pragma unroll
                        for (int m4 = 0; 4 * m4 < r; ++m4) { const f32x4 av = *(const LAS f32x4*)(TA + (r * 16 + 4 * m4) * 4); arow[4 * m4] = av.x; arow[4 * m4 + 1] = av.y; arow[4 * m4 + 2] = av.z; arow[4 * m4 + 3] = av.w; }
                        float a0 = (r == n) ? 1.0f : 0.0f, a1 = 0.f;
#pragma unroll
                        for (int m = 0; m + 1 < r; m += 2) { a0 -= arow[m] * tc[m]; a1 -= arow[m + 1] * tc[m + 1]; }
                        if (r & 1) a0 -= arow[r - 1] * tc[r - 1];
                        tc[r] = a0 + a1;
                    }
                    if (q == 0) {
#pragma unroll
                        for (int r = 0; r < 16; ++r) *(LAS float*)(L + GC_TF + r * TP + n * 4) = tc[r];
                    }
                }
                WG_BAR();
            }
        } else if (wu == 4) {
            float pa_in = 0.f, pb_in = 0.f;
            WG_BAR();
            for (int it = -1; it <= NBLK_P; ++it) {
                if (it >= 0 && it < NBLK_P && ROLE_ON(1)) {
                    LAS unsigned char* L = lds + (it & 1) * GC_SLOT;
                    GC_LD_AB(it);
                    u32x2 kfr[8], qfr[8];
#pragma unroll
                    for (int t = 0; t < 8; ++t) { kfr[t] = GC_RAWK(it, t); qfr[t] = GC_RAWQ(it, t); }
                    GC_GATES(pa_in, pb_in)
                    const _Float16 s1 = (_Float16)(-bet * egi), s2 = (_Float16)egi, s3 = (_Float16)fexp(__shfl(gc, 15 + (lane & 48)) - gc);
#pragma unroll
                    for (int t = 0; t < 8; ++t) {
                        *(LAS f16x4*)(L + GC_KBE + n * KP + (16 * t + 4 * q) * 2) = u2q(kfr[t]) * s1;
                        *(LAS f16x4*)(L + GC_QD + n * KP + (16 * t + 4 * q) * 2) = u2q(qfr[t]) * s2;
                        *(LAS f16x4*)(L + GC_KD + n * KP + (16 * t + 4 * q) * 2) = u2q(kfr[t]) * s3;
                    }
                    if (lane == 15) *(LAS float*)(L + GC_EG) = egi;
                }
                WG_BAR();
            }
        } else if (wu < 7) {
            float pa_in = 0.f, pb_in = 0.f;
            const int cv_ = C_GV + hh * 128 + 32 * qt + 16 * (wu - 5) + 4 * q;
            f32x4 cw4[4];
#pragma unroll
            for (int i = 0; i < 4; ++i) cw4[i] = *(const f32x4*)(cwp + i * CONVCH + (cv_ - C_Q));
            unsigned go[4];
#pragma unroll
            for (int j = 0; j < 4; ++j) { const int tk = 4 * j + q; go[j] = (unsigned)((tk * D + (wu == 5 ? 512 : 0) + hh * 128 + 8 * (n ^ tk)) * 2); }
            const unsigned go4 = (wu == 5) ? (unsigned)(lane * 16) : (unsigned)((((lane >> 2) * PAQ_W) + C_GV + hh * 128 + 32 * qt + 8 * (lane & 3)) * 2);
            const unsigned char* g4 = (wu == 5) ? (const unsigned char*)(ab + (size_t)(b * SEQ) * 8) : (const unsigned char*)(PAQ + (size_t)(b * SEQ) * PAQ_W);
            const size_t g4s = (wu == 5) ? 16 * 8 * 4 : (size_t)16 * PAQ_W * 2;
            const unsigned char* gkq = (const unsigned char*)(QK + (size_t)(b * SEQ) * D);
#define GC_DMA(j) do { const unsigned char* gb_ = gkq + (size_t)(j) * (16 * D * 2); LAS unsigned char* ld_ = lds + KQ0 + ((j) % RD) * 8192 + (wu == 5 ? 0 : 4096); \
                _Pragma("unroll") for (int j_ = 0; j_ < 4; ++j_) __builtin_amdgcn_global_load_lds((const unsigned*)(gb_ + go[j_]), (LAS unsigned*)(ld_ + j_ * 1024), 16, 0, 0); \
                __builtin_amdgcn_global_load_lds((const unsigned*)(g4 + (size_t)(j) * g4s + go4), (LAS unsigned*)(lds + (wu == 5 ? AB0 + ((j) % RD) * 1024 : VR0 + ((j) & 7) * 1024)), 16, 0, 0); } while (0)
#pragma unroll
            for (int j = 0; j < RD - 2; ++j) GC_DMA(j);
            asm volatile("s_waitcnt vmcnt(0)" ::: "memory");
            WG_BAR();
            for (int it = -1; it <= NBLK_P; ++it) {
                if (it + RD - 1 < NBLK_P) GC_DMA(it + RD - 1);
                if (it >= 0 && it < NBLK_P && ROLE_ON(2)) {
                    LAS unsigned char* L = lds + (it & 1) * GC_SLOT;
                    GC_LD_AB(it);
                    const float bet = fsigmoid(pb_in);
                    const int tt = 16 * it + n;
                    f32x4 acc = (f32x4){0.f, 0.f, 0.f, 0.f};
#pragma unroll
                    for (int i = 0; i < 4; ++i) { const f32x4 x = unpk4(*(const LAS u32x2*)(lds + VR0 + ((tt - 3 + i) & 127) * 64 + (wu - 5) * 32 + q * 8)); if (tt - 3 + i >= 0) acc += x * cw4[i]; }
#pragma unroll
                    for (int e = 0; e < 4; ++e) *(LAS float*)(L + GC_VB + (16 * (wu - 5) + 4 * q + e) * VP + n * 4) = bet * fsilu(acc[e]);
                }
                if (it + RD - 1 < NBLK_P) asm volatile("s_waitcnt vmcnt(%0)" :: "n"(5 * (RD - 3)) : "memory"); else asm volatile("s_waitcnt vmcnt(0)" ::: "memory");
                WG_BAR();
            }
#undef GC_DMA
        } else {
            float pa_in = 0.f, pb_in = 0.f;
            WG_BAR();
            for (int it = -1; it <= NBLK_P; ++it) {
                if (it >= 0 && it < NBLK_P && ROLE_ON(3)) {
                    LAS unsigned char* L = lds + (it & 1) * GC_SLOT;
                    GC_LD_AB(it);
                    u32x2 kfr[8], qfr[8];
#pragma unroll
                    for (int t = 0; t < 8; ++t) { kfr[t] = GC_RAWK(it, t); qfr[t] = GC_RAWQ(it, t); }
                    GC_GATES(pa_in, pb_in) (void)egi; (void)bet;
                    f32x4 qk = (f32x4){0.f, 0.f, 0.f, 0.f};
#pragma unroll
                    for (int t = 0; t < 8; ++t) qk = MFMA16(u2q(qfr[t]), u2q(kfr[t]), qk);
#pragma unroll
                    for (int r = 0; r < 4; ++r) { const int i = 4 * q + r; const float gci = __shfl(gc, i + (lane & 48));
                        const float vq = (i >= n) ? qk[r] * fexp(fminf(gci - gc, 0.f)) : 0.f;
                        *(LAS h16*)(L + GC_QKM + i * 32 + n * 2) = __builtin_bit_cast(h16, (_Float16)vq); }
                }
                WG_BAR();
            }
        }
#undef GC_GATES
#undef GC_LD_AB
#undef GC_RAWK
#undef GC_RAWQ
        if (!do_write && mode != 16 && mode != 17) return;
    }
    static_assert(G_Y + 4 * GY_BYTES <= RING_BYTES, "sample LDS");
    float Sn[32];
#define GD_LDS_STATE(jb_) do { const int row0_ = blk_row0(NBLK_P + (jb_), b, sgrp); \
        const float* sp_ = a->in[4] + ((size_t)((row0_ - MP) >> 2) * 4 + hh) * 16384 + (size_t)(8 * kq) * 128 + vcol; \
        _Pragma("unroll") for (int q_ = 0; q_ < 4; ++q_) _Pragma("unroll") for (int i_ = 0; i_ < 8; ++i_) Sn[q_ * 8 + i_] = (mode == 17) ? 0.f : sp_[(size_t)q_ * 4 * 16384 + i_ * 128]; } while (0)
    GD_LDS_STATE(0);
#pragma unroll
    for (int jb = 0; jb < 4; ++jb) {
        LAS unsigned char* Y = lds + G_Y + jb * GY_BYTES;
        const int row0 = blk_row0(NBLK_P + jb, b, sgrp);
        { const u32x4 qv = *(const u32x4*)(QK + (size_t)(row0 + qslot) * D + qkoff); GD_QK(Y, qv); }
        { const int row = row0 + sV, t = sV & 3; float accv = 0.f;
#pragma unroll
          for (int i = 0; i < 4; ++i) { const int tt = t - 3 + i;
              const float xp = h2f(PAQ[(size_t)(row - 3 + i) * PAQ_W + vcolp]);
              const float xs = a->in[5][((size_t)((row - MP) >> 2) * 3 + (tt < 0 ? 3 + tt : 0)) * CONVCH + vch];
              accv += ((tt >= 0) ? xp : xs) * cwv[i]; }
          const float sv = fsilu(accv) * fsigmoid(ab[(size_t)row * 8 + 4 + hh]); *(LAS unsigned*)(Y + 8192 + sV * 128 + vloc * 4) = pkh(sv, sv); }
        { float ain = 0.f, bin = 0.f; if (w == 0 && lane < 16) { ain = ab[(size_t)(row0 + lane) * 8 + hh]; bin = ab[(size_t)(row0 + lane) * 8 + 4 + hh]; } GD_GB(Y, ain, bin); }
    }
    WG_BAR();
#pragma unroll
    for (int jb = 0; jb < 4; ++jb) {
        const int row0 = blk_row0(NBLK_P + jb, b, sgrp);
        const LAS unsigned char* Y = lds + G_Y + jb * GY_BYTES;
        const size_t sbase = ((size_t)((row0 - MP) >> 2) * 4 + hh) * 16384 + (size_t)(8 * kq) * 128 + vcol;
        h2 Sq[4][4];
#pragma unroll
        for (int q = 0; q < 4; ++q)
#pragma unroll
            for (int i = 0; i < 4; ++i) Sq[q][i] = (h2){(_Float16)Sn[q * 8 + 2 * i], (_Float16)Sn[q * 8 + 2 * i + 1]};
        if (jb + 1 < 4) GD_LDS_STATE(jb + 1);
        float osave = 0.f;
#pragma unroll
        for (int q = 0; q < 4; ++q) {
#pragma unroll
            for (int s = 4 * q; s < 4 * q + 4; ++s) { const GdnOps p = gdn_ld(Y, s, kq, vi); const float o = gdn_step(Sq[q], p); osave = (kq == s) ? o : osave; }
            float* so = a->out + O_DELTA_S + sbase + (size_t)q * 4 * 16384;
            if (do_write) {
#pragma unroll
            for (int i = 0; i < 4; ++i) { so[(2 * i) * 128] = (float)Sq[q][i].x; so[(2 * i + 1) * 128] = (float)Sq[q][i].y; } }
        }
        if (do_write || osave == 123.456f) OB[(size_t)(row0 + kq) * PAQ_W + 512 + hh * 128 + vcol] = __builtin_bit_cast(h16, (_Float16)osave);
    }
    WG_BAR();
#undef GD_LDS_STATE
#undef GD_QK
#undef GD_GB
#undef GD_PREFETCH
}

__device__ __forceinline__ void post_phase(KArgs a, Frame& F) {
    const h16* PAQ = (const h16*)(a->ws + WS_PAQ); const h16* Z = (const h16*)(a->ws + WS_Z); const h16* OI = (const h16*)(a->ws + WS_PAQ) + C_Q; h16* OB = (h16*)(a->ws + WS_A); const float* bon = (const float*)(a->ws + WS_BON);
    const float* mu = a->in[12];
    LAS unsigned char* lds = F.lds;
    const int lane = F.lane, w = F.wave, tsl = lane >> 4, n = lane & 15;
    const h16* g2t = (const h16*)(a->ws + WS_G2T);
    for (int blk = F.bx; blk < M / 16; blk += F.G) {
        const int row0 = blk * 16;
        {
            const int tok = F.tid >> 5, c4 = (F.tid & 31) * 4, row = row0 + tok;
            const bool smp = row >= MP; const int t = smp ? ((row - MP) & 3) : (row & (SEQ - 1));
            const f32x4 cg = unpk4(*(const u32x2*)(PAQ + (size_t)row * PAQ_W + C_GD + c4));
            f32x4 pg;
            if (t > 0) pg = unpk4(*(const u32x2*)(PAQ + (size_t)(row - 1) * PAQ_W + C_GD + c4));
            else if (smp) pg = *(const f32x4*)(a->in[3] + (size_t)((row - MP) >> 2) * APROJ + C_GD + c4);
            else pg = (f32x4){0.f, 0.f, 0.f, 0.f};
            const f32x4 m4 = *(const f32x4*)(mu + C_GD + c4);
            const f32x4 g = cg + (pg - cg) * m4;
            u32x2 o; o.x = pkh(fsigmoid(g.x), fsigmoid(g.y)); o.y = pkh(fsigmoid(g.z), fsigmoid(g.w));
            *(LAS u32x2*)(lds + tok * 256 + c4 * 2) = o;
        }
        __syncthreads();
        {
            f32x4 gacc[4];
#pragma unroll
            for (int nt = 0; nt < 4; ++nt) gacc[nt] = (f32x4){0.f, 0.f, 0.f, 0.f};
#pragma unroll
            for (int st = 0; st < 4; ++st) {
                const f16x8 av = *(const LAS f16x8*)(lds + n * 256 + tsl * 16 + st * 64);
#pragma unroll
                for (int nt = 0; nt < 4; ++nt) {
                    const f16x8 bv = *(const f16x8*)(g2t + (size_t)(w * 64 + nt * 16 + n) * 128 + 8 * tsl + 32 * st);
                    gacc[nt] = __builtin_amdgcn_mfma_f32_16x16x32_f16(av, bv, gacc[nt], 0, 0, 0);
                }
            }
#pragma unroll
            for (int i = 0; i < 4; ++i) {
                const int row = row0 + 4 * tsl + i;
                const bool smp = row >= MP; const int t = smp ? ((row - MP) & 3) : (row & (SEQ - 1));
                float o[4], sum = 0.f;
#pragma unroll
                for (int nt = 0; nt < 4; ++nt) { o[nt] = h2f(OI[(size_t)row * PAQ_W + w * 64 + nt * 16 + n]); sum += o[nt]; }
                const float mean = row_sum16(sum) * (1.0f / 64.0f);
                float var = 0.f;
#pragma unroll
                for (int nt = 0; nt < 4; ++nt) { o[nt] -= mean; var += o[nt] * o[nt]; }
                const float rstd = __builtin_amdgcn_rsqf(row_sum16(var) * (1.0f / 64.0f) + LNX_EPS);
                const f32x4 bp = *(const f32x4*)(bon + (size_t)row * 32 + w * 4);
                const float bonus = (bp.x + bp.y) + (bp.z + bp.w);
#pragma unroll
                for (int nt = 0; nt < 4; ++nt) {
                    const int col = w * 64 + nt * 16 + n;
                    const float cv = h2f(PAQ[(size_t)row * PAQ_W + C_V + col]); float pv;
                    if (t > 0) pv = h2f(PAQ[(size_t)(row - 1) * PAQ_W + C_V + col]); else if (smp) pv = a->in[3][(size_t)((row - MP) >> 2) * APROJ + C_V + col]; else pv = 0.f;
                    const float vl = cv + (pv - cv) * mu[C_V + col];
                    const float val = (o[nt] * rstd * a->in[21][col] + a->in[22][col] + bonus * vl) * gacc[nt][i];
                    o[nt] = val;
                }
                asm volatile("" ::: "memory");
#pragma unroll
                for (int nt = 0; nt < 4; ++nt) OB[(size_t)row * D + w * 64 + nt * 16 + n] = __builtin_bit_cast(h16, (_Float16)o[nt]);
            }
        }
#pragma unroll
        for (int i = 0; i < 2; ++i) {
            const int row = row0 + 2 * w + i, col = tsl * 128 + n * 8;
            const u32x4 ov = *(const u32x4*)(OI + (size_t)row * PAQ_W + 512 + col); const u32x4 zv = *(const u32x4*)(Z + (size_t)row * Z_W + col);
            const f32x4 o0 = unpk4((u32x2){ov.x, ov.y}), o1 = unpk4((u32x2){ov.z, ov.w}), z0 = unpk4((u32x2){zv.x, zv.y}), z1 = unpk4((u32x2){zv.z, zv.w});
            float ss = ((o0.x * o0.x + o0.y * o0.y) + (o0.z * o0.z + o0.w * o0.w)) + ((o1.x * o1.x + o1.y * o1.y) + (o1.z * o1.z + o1.w * o1.w));
            const float rstd = __builtin_amdgcn_rsqf(row_sum16(ss) * (1.0f / 128.0f) + RMS_EPS);
            const f32x4 n0 = *(const f32x4*)(a->in[26] + n * 8), n1 = *(const f32x4*)(a->in[26] + n * 8 + 4);
            f32x4 r0 = o0 * rstd * n0, r1 = o1 * rstd * n1;
            r0.x *= fsilu(z0.x); r0.y *= fsilu(z0.y); r0.z *= fsilu(z0.z); r0.w *= fsilu(z0.w);
            r1.x *= fsilu(z1.x); r1.y *= fsilu(z1.y); r1.z *= fsilu(z1.z); r1.w *= fsilu(z1.w);
            u32x4 wv; wv.x = pkh(r0.x, r0.y); wv.y = pkh(r0.z, r0.w); wv.z = pkh(r1.x, r1.y); wv.w = pkh(r1.z, r1.w);
            *(u32x4*)(OB + (size_t)row * D + 512 + col) = wv;
        }
        __syncthreads();
    }
}

__device__ __forceinline__ void final_norm(KArgs a, Frame& F) {
    pg8::RowScale rs{(const float*)(a->ws + WS_SSQ3), 16};
    const int gw = F.bx * NWAVES + F.wave, NGW = F.G * NWAVES;
    const f32x4* fw = (const f32x4*)a->in[34] + F.lane; f32x4 wv[4];
#pragma unroll
    for (int j = 0; j < 4; ++j) wv[j] = fw[64 * j];
    for (int m = gw; m < M; m += NGW) {
        f32x4* xr = (f32x4*)(a->out + (size_t)m * D) + F.lane; const u32x2* hr = (const u32x2*)((const h16*)(a->ws + WS_H3H) + (size_t)m * D) + F.lane; const float s = rs(m);
#pragma unroll
        for (int j = 0; j < 4; ++j) { const f32x4 v = unpk4(hr[64 * j]); xr[64 * j] = v * s * wv[j]; }
    }
}

__device__ __forceinline__ void late_convert(KArgs a, Frame& F, int part, int nparts) {
    unsigned char* ws = a->ws;
    LAS float* scr = (LAS float*)(F.lds + F.wave * 16384);
    const int gw = part * NWAVES + F.wave, NGW = nparts * NWAVES;
    constexpr int I_UP = 16 * 176, I_DN = 44 * 32, I_PJ = 8 * 32, I_WO = 16 * 32;
    constexpr int NITEMS = I_UP + I_DN + 2 * I_PJ + I_WO;
    for (int it = gw; it < NITEMS; it += NGW) {
        int r = it;
        if (r < I_UP) { tr_up_item(a->in[31], a->in[32], a->in[30], (h16*)(ws + WS_W2UP), r, scr, F.lane); continue; } r -= I_UP;
        if (r < I_DN) { const int kb = r / 32, nb = r % 32; tr_item(a->in[33], D, 64 * kb, 32 * nb, nullptr, (h16*)(ws + WS_W2DN), FF, 32 * nb, 64 * kb, scr, F.lane); continue; } r -= I_DN;
        if (r < I_PJ) { const int kb = r / 32, nb = r % 32; tr_item(a->in[27], D, 64 * kb, 32 * nb, nullptr, (h16*)(ws + WS_WPT), D, 32 * nb, 64 * kb, scr, F.lane); continue; } r -= I_PJ;
        if (r < I_PJ) { const int kb = r / 32, nb = r % 32; tr_item(a->in[28], D, 64 * kb, 32 * nb, nullptr, (h16*)(ws + WS_WPT), D, 32 * nb, 512 + 64 * kb, scr, F.lane); continue; } r -= I_PJ;
        { const int kb = r / 32, nb = r % 32; tr_item(a->in[29], D, 64 * kb, 32 * nb, nullptr, (h16*)(ws + WS_WOUTT), D, 32 * nb, 64 * kb, scr, F.lane); }
    }
}

constexpr int N_PHASES = 12;
__global__ void __launch_bounds__(NTHREADS, 2) mk_fwd(Args args) {
    extern __shared__ __attribute__((aligned(16))) unsigned char lds_raw[];
    Frame F;
    F.lds = (LAS unsigned char*)lds_raw;
    F.tid = threadIdx.x; F.lane = F.tid & 63; F.wave = __builtin_amdgcn_readfirstlane(F.tid >> 6);
    F.G = gridDim.x; F.bx = blockIdx.x;
    volatile LAS unsigned* MISC = (volatile LAS unsigned*)(F.lds + MISC_OFF);
    for (int u = F.tid; u < (LDS_BYTES - LDSCTL_OFF) / 4; u += NTHREADS) ((LAS unsigned*)(F.lds + LDSCTL_OFF))[u] = 0u;
    __syncthreads();
    KArgs ka0 = (KArgs)__builtin_amdgcn_kernarg_segment_ptr();
    unsigned char* ws = ka0->ws;
    XcdBarrier bar; bar.bar = (unsigned*)(ws + WS_CTL) + 1024; bar.x = 0; bar.st = nullptr;
    if (MK_N_LAUNCHES == 1) bar = xcd_barrier_post((unsigned*)(ws + WS_CTL) + 1024, MISC + 8);
    const int lo = ka0->ph_lo, hi = ka0->ph_hi;
#ifndef PH_MASK
#define PH_MASK 0xfff
#endif
#define IN(k) (((PH_MASK >> (k)) & 1) && lo <= (k) && (k) < hi)
#define SEAM(k) do { if (IN(k) && IN((k) + 1)) xcd_barrier(bar); } while (0)
    const int c = F.bx;

#define NREP(k) ((PROBE_REP == (k)) ? 2 : 1)
    if (IN(0)) for (int rep_ = 0; rep_ < NREP(0); ++rep_) { KArgs args = ka0; asm volatile("" : "+s"(args)); unsigned char* ws = args->ws; unsigned char* dob = (unsigned char*)args->out; (void)ws; (void)dob; p0_prologue(args, F); } SEAM(0);
    if (IN(1)) for (int rep_ = 0; rep_ < NREP(1); ++rep_) { KArgs args = ka0; asm volatile("" : "+s"(args)); unsigned char* ws = args->ws; unsigned char* dob = (unsigned char*)args->out; (void)ws; (void)dob;
        pg8::Gemm g{(const h16*)(ws + WS_A), (const h16*)(dob + DO_W1UP), D, D}; pg8::StaticOrder S; S.init(M, 5632, F.G, c);
        pg8::EpiSwiglu E{(h16*)(ws + WS_HID), pg8::RowScale{(const float*)(ws + WS_SSQ0), 1}};
        pg8::gemm_phase(F.lds, g, S, E);
    } SEAM(1);
    if (IN(2)) for (int rep_ = 0; rep_ < NREP(2); ++rep_) { KArgs args = ka0; asm volatile("" : "+s"(args)); unsigned char* ws = args->ws; unsigned char* dob = (unsigned char*)args->out; (void)ws; (void)dob;
        pg8::Gemm g{(const h16*)(ws + WS_HID), (const h16*)(dob + DO_W1DN), FF, FF}; pg8::StaticOrder S; S.init(MP, D, F.G, c);
        pg8::EpiResid<true, false, true> E{nullptr, nullptr, MP, (const h16*)(ws + WS_A), nullptr, (h16*)(dob + DO_H1H), (float*)(ws + WS_SSQ1), 0.5f};
        pg8::gemm_phase(F.lds, g, S, E);
        SResid SE{nullptr, (const h16*)(ws + WS_A), nullptr, (h16*)(dob + DO_H1H), (float*)(ws + WS_SSQ1), 0.5f};
        if (c < 256) sample_gemm(F.lds, g.A, FF, g.Bt, FF, SE, c, F.tid);
    } SEAM(2);
    if (IN(3)) for (int rep_ = 0; rep_ < NREP(3); ++rep_) { KArgs args = ka0; asm volatile("" : "+s"(args)); unsigned char* ws = args->ws; unsigned char* dob = (unsigned char*)args->out; (void)ws; (void)dob;
        pg8::Gemm g{(const h16*)(dob + DO_H1H), (const h16*)(dob + DO_WIN), D, D}; pg8::StaticOrder S; S.init(M, NIN, F.G, c);
        pg8::EpiP E{(h16*)(ws + WS_PAQ), (h16*)(ws + WS_Z), (h16*)(ws + WS_GT), pg8::RowScale{(const float*)(ws + WS_SSQ1), 16}};
        pg8::gemm_phase(F.lds, g, S, E);
        ab_gemv(args, F);
    } SEAM(3);
    if (IN(4)) for (int rep_ = 0; rep_ < NREP(4); ++rep_) { KArgs args = ka0; asm volatile("" : "+s"(args)); gdn_prep(args, F); } SEAM(4);
    if (IN(5)) for (int rep_ = 0; rep_ < NREP(5); ++rep_) { KArgs args = ka0; asm volatile("" : "+s"(args)); unsigned char* ws = args->ws; unsigned char* dob = (unsigned char*)args->out; (void)ws; (void)dob;
        const int mode = (MK_N_LAUNCHES == 1) ? 0 : args->pad;
        if (F.G == 256) { if (c < 128) { if (mode == 0 || mode == 1 || mode == 5 || mode == 6 || mode == 8 || mode == 9 || mode == 10) rwkv_role(args, F, c, mode); } else { if (mode == 0 || mode == 2 || mode == 3 || mode == 4 || mode >= 11) gdn_role(args, F, c - 128, mode); if (mode == 0) late_convert(args, F, c - 128, 128); } }
    } SEAM(5);
    if (IN(6)) for (int rep_ = 0; rep_ < NREP(6); ++rep_) { KArgs args = ka0; asm volatile("" : "+s"(args)); unsigned char* ws = args->ws; unsigned char* dob = (unsigned char*)args->out; (void)ws; (void)dob; post_phase(args, F); } SEAM(6);
    if (IN(7)) for (int rep_ = 0; rep_ < NREP(7); ++rep_) { KArgs args = ka0; asm volatile("" : "+s"(args)); unsigned char* ws = args->ws; unsigned char* dob = (unsigned char*)args->out; (void)ws; (void)dob;
        pg8::Gemm g{(const h16*)(ws + WS_A), (const h16*)(ws + WS_WPT), D, D}; pg8::StaticOrder S; S.init(MP, D, F.G, c);
        pg8::EpiMerge E{(const h16*)(ws + WS_GT), (h16*)(ws + WS_MRG), 8};
        pg8::gemm_phase(F.lds, g, S, E);
        SMerge SE{(const h16*)(ws + WS_GT), (h16*)(ws + WS_MRG)};
        if (c < 256) sample_gemm(F.lds, g.A, D, g.Bt, D, SE, c, F.tid);
    } SEAM(7);
    if (IN(8)) for (int rep_ = 0; rep_ < NREP(8); ++rep_) { KArgs args = ka0; asm volatile("" : "+s"(args)); unsigned char* ws = args->ws; unsigned char* dob = (unsigned char*)args->out; (void)ws; (void)dob;
        pg8::Gemm g{(const h16*)(ws + WS_MRG), (const h16*)(ws + WS_WOUTT), D, D}; pg8::StaticOrder S; S.init(MP, D, F.G, c);
        pg8::EpiResid<true, false, true> E{nullptr, nullptr, M, (const h16*)(dob + DO_H1H), nullptr, (h16*)(ws + WS_A), (float*)(ws + WS_SSQ2), 1.0f};
        pg8::gemm_phase(F.lds, g, S, E);
        SResid SE{nullptr, (const h16*)(dob + DO_H1H), nullptr, (h16*)(ws + WS_A), (float*)(ws + WS_SSQ2), 1.0f};
        if (c < 256) sample_gemm(F.lds, g.A, D, g.Bt, D, SE, c, F.tid);
    } SEAM(8);
    if (IN(9)) for (int rep_ = 0; rep_ < NREP(9); ++rep_) { KArgs args = ka0; asm volatile("" : "+s"(args)); unsigned char* ws = args->ws; unsigned char* dob = (unsigned char*)args->out; (void)ws; (void)dob;
        pg8::Gemm g{(const h16*)(ws + WS_A), (const h16*)(ws + WS_W2UP), D, D}; pg8::StaticOrder S; S.init(M, 5632, F.G, c);
        pg8::EpiSwiglu E{(h16*)(ws + WS_HID), pg8::RowScale{(const float*)(ws + WS_SSQ2), 16}};
        pg8::gemm_phase(F.lds, g, S, E);
    } SEAM(9);
    if (IN(10)) for (int rep_ = 0; rep_ < NREP(10); ++rep_) { KArgs args = ka0; asm volatile("" : "+s"(args)); unsigned char* ws = args->ws; unsigned char* dob = (unsigned char*)args->out; (void)ws; (void)dob;
        pg8::Gemm g{(const h16*)(ws + WS_HID), (const h16*)(ws + WS_W2DN), FF, FF}; pg8::StaticOrder S; S.init(MP, D, F.G, c);
        pg8::EpiResid<true, false, true> E{nullptr, nullptr, M, (const h16*)(ws + WS_A), nullptr, (h16*)(ws + WS_H3H), (float*)(ws + WS_SSQ3), 0.5f};
        pg8::gemm_phase(F.lds, g, S, E);
        SResid SE{nullptr, (const h16*)(ws + WS_A), nullptr, (h16*)(ws + WS_H3H), (float*)(ws + WS_SSQ3), 0.5f};
        if (c < 256) sample_gemm(F.lds, g.A, FF, g.Bt, FF, SE, c, F.tid);
    } SEAM(10);
    if (IN(11)) for (int rep_ = 0; rep_ < NREP(11); ++rep_) { KArgs args = ka0; asm volatile("" : "+s"(args)); unsigned char* ws = args->ws; unsigned char* dob = (unsigned char*)args->out; (void)ws; (void)dob; final_norm(args, F); }
#undef IN
#undef SEAM
}

extern "C" void kernel_launch(void* const* d_in, const int* in_sizes, int n_in, void* d_out, int out_size, void* d_ws, size_t ws_size, hipStream_t stream) {
    static int grid = 0;
    if (grid == 0) {
        if (n_in != 35 || in_sizes[0] != MP * D || in_sizes[1] != MS * D || (size_t)out_size != O_END || ws_size < WS_END) {
            fprintf(stderr, "kernel_launch: unexpected shapes: n_in %d in0 %d out %d ws %zu (need %zu)\n", n_in, n_in > 0 ? in_sizes[0] : -1, out_size, ws_size, (size_t)WS_END); grid = -1; return; }
        int dev = 0, cus = 0, per_cu = 0;
        if (hipGetDevice(&dev) != hipSuccess || hipDeviceGetAttribute(&cus, hipDeviceAttributeMultiprocessorCount, dev) != hipSuccess) { fprintf(stderr, "kernel_launch: device query failed\n"); grid = -1; return; }
        if (hipFuncSetAttribute((const void*)mk_fwd, hipFuncAttributeMaxDynamicSharedMemorySize, LDS_BYTES) != hipSuccess) { fprintf(stderr, "kernel_launch: hipFuncSetAttribute failed\n"); grid = -1; return; }
        if (hipOccupancyMaxActiveBlocksPerMultiprocessor(&per_cu, (const void*)mk_fwd, NTHREADS, LDS_BYTES) != hipSuccess || per_cu < 1) { fprintf(stderr, "kernel_launch: occupancy query says %d blocks per CU\n", per_cu); grid = -1; (void)hipGetLastError(); return; }
        (void)hipGetLastError();
        grid = cus;
        if (grid != 256) fprintf(stderr, "kernel_launch: %d CUs; the scan phase needs exactly 256 workgroups\n", grid);
    }
    if (grid < 0) return;
    (void)hipMemsetAsync((char*)d_ws + WS_CTL, 0, CTL_ZERO_BYTES, stream);
    Args a{};
    for (int i = 0; i < 35; ++i) a.in[i] = (const float*)d_in[i];
    a.out = (float*)d_out; a.ws = (unsigned char*)d_ws;
    if (MK_N_LAUNCHES == 1) {
        a.ph_lo = 0; a.ph_hi = N_PHASES; a.li = 0;
        hipLaunchKernelGGL(mk_fwd, dim3(grid), dim3(NTHREADS), LDS_BYTES, stream, a);
    } else {
        for (int li = 0; li < N_PHASES; ++li) { a.ph_lo = li; a.ph_hi = li + 1; a.li = li; hipLaunchKernelGGL(mk_fwd, dim3(grid), dim3(NTHREADS), LDS_BYTES, stream, a);
            if (li == PROBE_LREP) { a.pad = PROBE_MODE; for (int x_ = 0; x_ < PROBE_NX; ++x_) hipLaunchKernelGGL(mk_fwd, dim3(grid), dim3(NTHREADS), LDS_BYTES, stream, a); a.pad = 0; } }
    }
}
```

```cpp
#include <hip/hip_runtime.h>
#include <cstdio>
#include <cstdint>

#ifndef MK_N_LAUNCHES
#define MK_N_LAUNCHES 1
#endif

#ifndef PROBE_SCAN2
#define PROBE_SCAN2 0
#endif
#ifndef PROBE_MODE
#define PROBE_MODE 0
#endif
#ifndef PROBE_LREP
#define PROBE_LREP -1
#endif
#ifndef PROBE_NX
#define PROBE_NX 4
#endif
#ifndef PROBE_REP
#define PROBE_REP -1
#endif
#define LAS __attribute__((address_space(3)))
#define GAS __attribute__((address_space(1)))
typedef unsigned short h16;
typedef _Float16 f16x8 __attribute__((ext_vector_type(8)));
typedef _Float16 f16x4 __attribute__((ext_vector_type(4)));
typedef _Float16 f16x2 __attribute__((ext_vector_type(2)));
typedef _Float16 h2 __attribute__((ext_vector_type(2)));
typedef _Float16 f16x4 __attribute__((ext_vector_type(4)));
typedef float f32x4 __attribute__((ext_vector_type(4)));
typedef float f32x2 __attribute__((ext_vector_type(2)));
typedef unsigned u32x4 __attribute__((ext_vector_type(4)));
typedef unsigned u32x2 __attribute__((ext_vector_type(2)));
typedef short v4i16_t __attribute__((ext_vector_type(4)));
typedef GAS unsigned gu32;

constexpr int D = 1024, MP = 16384, MS = 512, M = MP + MS, SEQ = 2048, NB_P = 8, NB_S = 128, TS = 4;
constexpr int FF = 2816, APROJ = 1792, CONVCH = 1536;
constexpr int PAQ_W = 3328, Z_W = 512, GT_W = 2048, NIN = PAQ_W + Z_W + GT_W;
constexpr int GT_P = 2112;
constexpr float RMS_EPS = 1e-6f, LNX_EPS = 64e-5f;
constexpr int C_R = 0, C_WD = 512, C_K = 576, C_V = 1088, C_AD = 1600, C_GD = 1664, C_Q = 1792, C_GK = 2304, C_GV = 2816;
constexpr size_t O_Y = 0, O_RWKV_P = 17301504, O_SHIFT_P = 17563648, O_DELTA_P = 17577984, O_CONV_P = 18102272,
                 O_RWKV_S = 18139136, O_SHIFT_S = 22333440, O_DELTA_S = 22562816, O_CONV_S = 30951424, O_END = 31541248;

constexpr size_t MiB = 1u << 20;
constexpr size_t WS_CTL = 0, CTL_ZERO_BYTES = 64 * 1024;
constexpr size_t WS_SSQ0 = 1 * MiB, WS_SSQ1 = WS_SSQ0 + (size_t)M * 64, WS_SSQ2 = WS_SSQ1 + (size_t)M * 64, WS_SSQ3 = WS_SSQ2 + (size_t)M * 64;
constexpr size_t WS_AB = WS_SSQ3 + (size_t)M * 64;
constexpr size_t WS_BON = WS_AB + (size_t)M * 32;
constexpr size_t WS_WAB = WS_BON + (size_t)M * 128;
constexpr size_t WS_W2T = WS_WAB + 32768;
constexpr size_t WS_A2T = WS_W2T + 65536;
constexpr size_t WS_G2T = WS_A2T + 65536;
static_assert(WS_G2T + 131072 <= 8 * MiB, "small arrays");
constexpr size_t WS_A = 8 * MiB;
constexpr size_t WS_WPT = 41 * MiB, WS_WOUTT = 43 * MiB;
constexpr size_t WS_W2UP = 45 * MiB;
constexpr size_t WS_W2DN = 56 * MiB;
constexpr size_t WS_B = 62 * MiB;
constexpr size_t WS_HID = WS_B;
constexpr size_t WS_PAQ = WS_B;
constexpr size_t WS_Z = WS_PAQ + (size_t)M * PAQ_W * 2;
constexpr size_t WS_GT = WS_Z + (size_t)M * Z_W * 2;
constexpr size_t WS_MRG = WS_B;
constexpr size_t WS_H3H = 160 * MiB;
constexpr size_t WS_END = WS_GT + (size_t)M * GT_P * 2;
static_assert(WS_END <= 256 * MiB, "workspace map");
static_assert(WS_A + (size_t)M * D * 2 <= WS_WPT, "region A");
constexpr size_t DO_W1UP = O_DELTA_S * 4;
constexpr size_t DO_W1DN = DO_W1UP + (size_t)5632 * 1024 * 2;
constexpr size_t DO_H1H = (size_t)MP * D * 2;
constexpr size_t DO_WIN = O_RWKV_S * 4;
static_assert(DO_W1DN + (size_t)1024 * 2816 * 2 <= O_CONV_S * 4 && DO_WIN + (size_t)NIN * 1024 * 2 <= O_SHIFT_S * 4, "d_out scratch");

constexpr int NWAVES = 8, NTHREADS = 512;
constexpr int RING_BYTES = 131072, LDSCTL_OFF = RING_BYTES, MISC_OFF = LDSCTL_OFF + 320, LDS_BYTES = 147456;

__device__ __forceinline__ unsigned pkh(float lo, float hi) { f16x2 v; v.x = (_Float16)lo; v.y = (_Float16)hi; return __builtin_bit_cast(unsigned, v); }
__device__ __forceinline__ f32x2 unpk(unsigned u) { f16x2 v = __builtin_bit_cast(f16x2, u); f32x2 r; r.x = (float)v.x; r.y = (float)v.y; return r; }
__device__ __forceinline__ f32x4 unpk4(u32x2 u) { f32x2 a = unpk(u.x), b = unpk(u.y); return (f32x4){a.x, a.y, b.x, b.y}; }
__device__ __forceinline__ float h2f(h16 v) { return (float)__builtin_bit_cast(_Float16, v); }
__device__ __forceinline__ h2 bc2(float x) { const _Float16 h = (_Float16)x; return (h2){h, h}; }
__device__ __forceinline__ h2 u2h(unsigned u) { return __builtin_bit_cast(h2, u); }
__device__ __forceinline__ float fexp(float x) { return __builtin_amdgcn_exp2f(x * 1.44269504089f); }
__device__ __forceinline__ float frcp(float x) { return __builtin_amdgcn_rcpf(x); }
__device__ __forceinline__ float fsigmoid(float x) { return frcp(1.0f + fexp(-x)); }
__device__ __forceinline__ float fsilu(float x) { return x * frcp(1.0f + fexp(-x)); }
__device__ __forceinline__ float ftanh(float x) { return 1.0f - 2.0f * frcp(1.0f + fexp(2.0f * x)); }
template <int CTRL> __device__ __forceinline__ float dppf(float x) { return __builtin_bit_cast(float, __builtin_amdgcn_update_dpp(0, __builtin_bit_cast(int, x), CTRL, 0xF, 0xF, false)); }
__device__ __forceinline__ float row_sum16(float x) { x += dppf<0x128>(x); x += dppf<0x124>(x); x += dppf<0x122>(x); x += dppf<0x121>(x); return x; }
__device__ __forceinline__ float wave_sum(float v) {
#pragma unroll
    for (int o = 1; o < 64; o <<= 1) v += __shfl_xor(v, o);
    return v;
}
#define MFMA16(a_, b_, c_) __builtin_amdgcn_mfma_f32_16x16x16f16(a_, b_, c_, 0, 0, 0)
__device__ __forceinline__ f16x4 cvt4(f32x4 v) { return (f16x4){(_Float16)v.x, (_Float16)v.y, (_Float16)v.z, (_Float16)v.w}; }
__device__ __forceinline__ f16x4 u2q(u32x2 u) { return __builtin_bit_cast(f16x4, u); }
#define LDS_WAIT() asm volatile("s_waitcnt lgkmcnt(0)" ::: "memory")
#define VM_WAIT() asm volatile("s_waitcnt vmcnt(0)" ::: "memory")
#define RLX_AGENT __ATOMIC_RELAXED, __HIP_MEMORY_SCOPE_AGENT

namespace pg8 {
constexpr int BM = 256, BK = 64, HALF = 128, HTB = HALF * BK * 2, STAGE_BYTES = 8 * HTB, NXCD = 8, WGM = 8;
__host__ __device__ __forceinline__ int lds_byte(int r, int c) { const int st = (r >> 4) * 2 + (c >> 5), rr = r & 15, cc = c & 31, ob = rr * 64 + cc * 2; return st * 1024 + (ob ^ (((ob >> 9) & 1) << 5)); }
__host__ __device__ __forceinline__ void stage_rc(int b, int& R, int& C) { const int st = b / 1024, sb = b % 1024, swz = sb ^ (((sb >> 9) & 1) << 5); R = (st >> 1) * 16 + swz / 64; C = (st & 1) * 32 + (swz % 64) / 2; }
__host__ __device__ __forceinline__ int perm32(int rho) { const int n = rho >> 4, i = rho & 15; return 8 * (i >> 2) + 4 * n + (i & 3); }

struct Unit { int pm, pn; };
struct Gemm { const h16* A; const h16* Bt; int lda, K; };

struct StaticOrder {
    int nM, nN, nwg, G, c;
    __device__ void init(int Mr, int N, int G_, int c_) { nM = Mr / BM; nN = N / BM; nwg = nM * nN; G = G_; c = c_; }
    __device__ bool next(int i, Unit& u) const {
        const long L = (long)i * G + c; if (L >= nwg) return false;
        int wgid = (int)L; { const int q = nwg / NXCD, r = nwg % NXCD, xcd = wgid % NXCD, off = wgid / NXCD; wgid = (xcd < r ? xcd * (q + 1) : r * (q + 1) + (xcd - r) * q) + off; }
        const int nig = WGM * nN, gid = wgid / nig, fm = gid * WGM, gsz = (nM - fm) < WGM ? (nM - fm) : WGM;
        u.pm = fm + ((wgid % nig) % gsz); u.pn = (wgid % nig) / gsz; return true;
    }
};

struct RowScale {
    const float* ssq; int np;
    __device__ __forceinline__ float operator()(int row) const {
        const f32x4* p = (const f32x4*)(ssq + (size_t)row * 16); float s;
        if (np == 1) s = ssq[(size_t)row * 16];
        else { f32x4 a = p[0], b = p[1], c = p[2], d = p[3]; s = ((a.x + a.y) + (a.z + a.w)) + ((b.x + b.y) + (b.z + b.w)) + ((c.x + c.y) + (c.z + c.w)) + ((d.x + d.y) + (d.z + d.w)); }
        return __builtin_amdgcn_rsqf(s * (1.0f / 1024.0f) + RMS_EPS);
    }
};

struct EpiSwiglu {
    static constexpr bool PERM = true, MID = false;
    h16* O; RowScale rs;
    __device__ __forceinline__ void operator()(const f32x4 (&acc)[2][2][4][2], const Unit& u, int wr, int wc, int fr, int fq) const {
        const int row0 = u.pm * BM + wr * 64 + fr, col0 = u.pn * 128 + wc * 32 + 8 * fq;
#pragma unroll
        for (int ai = 0; ai < 2; ++ai)
#pragma unroll
            for (int m = 0; m < 4; ++m) {
                const int row = row0 + ai * HALF + m * 16; const float s = rs(row);
                float o[8];
#pragma unroll
                for (int n = 0; n < 2; ++n)
#pragma unroll
                    for (int i = 0; i < 4; ++i) { const float g = acc[ai][0][m][n][i] * s, v = acc[ai][1][m][n][i] * s; o[4 * n + i] = fsilu(g) * v; }
                u32x4 w; w.x = pkh(o[0], o[1]); w.y = pkh(o[2], o[3]); w.z = pkh(o[4], o[5]); w.w = pkh(o[6], o[7]);
                *(u32x4*)(O + (size_t)row * FF + col0) = w;
            }
    }
};
struct EpiP {
    static constexpr bool PERM = true, MID = false;
    h16 *paq, *z, *gt; RowScale rs;
    __device__ __forceinline__ void operator()(const f32x4 (&acc)[2][2][4][2], const Unit& u, int wr, int wc, int fr, int fq) const {
        h16* base; int ld, colt;
        if (u.pn < 13) { base = paq; ld = PAQ_W; colt = u.pn * BM; } else if (u.pn < 15) { base = z; ld = Z_W; colt = (u.pn - 13) * BM; } else { base = gt; ld = GT_P; colt = (u.pn - 15) * BM; }
        const int row0 = u.pm * BM + wr * 64 + fr, col0 = colt + wc * 32 + 8 * fq;
#pragma unroll
        for (int ai = 0; ai < 2; ++ai)
#pragma unroll
            for (int m = 0; m < 4; ++m) {
                const int row = row0 + ai * HALF + m * 16; const float s = rs(row);
#pragma unroll
                for (int bj = 0; bj < 2; ++bj) {
                    f32x4 a = acc[ai][bj][m][0] * s, b = acc[ai][bj][m][1] * s;
                    if (u.pn >= 15) {
#pragma unroll
                        for (int i = 0; i < 4; ++i) { a[i] = fmaxf(fsigmoid(a[i]), 1e-7f); b[i] = fmaxf(fsigmoid(b[i]), 1e-7f); }
                    }
                    u32x4 w; w.x = pkh(a.x, a.y); w.y = pkh(a.z, a.w); w.z = pkh(b.x, b.y); w.w = pkh(b.z, b.w);
                    *(u32x4*)(base + (size_t)row * ld + col0 + bj * HALF) = w;
                }
            }
    }
};
template <bool RH, bool WF, bool WH>
struct EpiResid {
    static constexpr bool PERM = false, MID = false;
    const float* base0; const float* base1; int split_row;
    const h16* resh; float* out; h16* outh; float* ssq; float alpha;
    __device__ __forceinline__ void operator()(const f32x4 (&acc)[2][2][4][2], const Unit& u, int wr, int wc, int fr, int fq) const {
        const int row0 = u.pm * BM + wr * 64 + fr, col0 = u.pn * BM + wc * 32 + 4 * fq;
#pragma unroll
        for (int ai = 0; ai < 2; ++ai)
#pragma unroll
            for (int m = 0; m < 4; ++m) {
                const int row = row0 + ai * HALF + m * 16;
                const float* bp = (row < split_row) ? base0 + (size_t)row * D : base1 + (size_t)(row - split_row) * D;
                float s = 0.f;
#pragma unroll
                for (int bj = 0; bj < 2; ++bj)
#pragma unroll
                    for (int n = 0; n < 2; ++n) {
                        const int col = col0 + bj * HALF + n * 16;
                        const f32x4 bv = RH ? unpk4(*(const u32x2*)(resh + (size_t)row * D + col)) : *(const f32x4*)(bp + col); const f32x4 o = bv + acc[ai][bj][m][n] * alpha;
                        if (WF) *(f32x4*)(out + (size_t)row * D + col) = o;
                        if (WH) { u32x2 w; w.x = pkh(o.x, o.y); w.y = pkh(o.z, o.w); *(u32x2*)(outh + (size_t)row * D + col) = w; }
                        s += (o.x * o.x + o.y * o.y) + (o.z * o.z + o.w * o.w);
                    }
                s += __shfl_xor(s, 16); s += __shfl_xor(s, 32);
                if (fq == 0) ssq[(size_t)row * 16 + u.pn * 4 + wc] = s;
            }
    }
};
struct EpiMerge {
    static constexpr bool PERM = true, MID = true;
    const h16* gt; h16* O; int mid_t;
    __device__ __forceinline__ void mid(f32x4 (&acc)[2][2][4][2], const Unit& u, int wr, int wc, int fr, int fq) const {
        asm volatile("" : "+v"(fr), "+v"(fq));
        const int row0 = u.pm * BM + wr * 64 + fr, col0 = u.pn * BM + wc * 32 + 8 * fq;
#pragma unroll
        for (int ai = 0; ai < 2; ++ai)
#pragma unroll
            for (int m = 0; m < 4; ++m) {
                const h16* gp = gt + (size_t)(row0 + ai * HALF + m * 16) * GT_P + col0;
#pragma unroll
                for (int bj = 0; bj < 2; ++bj) {
                    const u32x4 ga = *(const u32x4*)(gp + bj * HALF), gb = *(const u32x4*)(gp + 1024 + bj * HALF);
                    const f32x4 a0 = unpk4((u32x2){ga.x, ga.y}), a1 = unpk4((u32x2){ga.z, ga.w}), b0 = unpk4((u32x2){gb.x, gb.y}), b1 = unpk4((u32x2){gb.z, gb.w});
                    f32x4 r0, r1;
#pragma unroll
                    for (int i = 0; i < 4; ++i) { r0[i] = a0[i] * frcp(b0[i]); r1[i] = a1[i] * frcp(b1[i]); }
                    acc[ai][bj][m][0] *= r0; acc[ai][bj][m][1] *= r1;
                    asm volatile("" ::: "memory");
                }
            }
    }
    __device__ __forceinline__ void operator()(const f32x4 (&acc)[2][2][4][2], const Unit& u, int wr, int wc, int fr, int fq) const {
        const int row0 = u.pm * BM + wr * 64 + fr, col0 = u.pn * BM + wc * 32 + 8 * fq;
#pragma unroll
        for (int ai = 0; ai < 2; ++ai)
#pragma unroll
            for (int m = 0; m < 4; ++m) {
                const int row = row0 + ai * HALF + m * 16;
                const h16* gp = gt + (size_t)row * GT_P + 1024 + col0;
#pragma unroll
                for (int bj = 0; bj < 2; ++bj) {
                    const u32x4 gb = *(const u32x4*)(gp + bj * HALF);
                    const f32x4 b0 = unpk4((u32x2){gb.x, gb.y}), b1 = unpk4((u32x2){gb.z, gb.w});
                    f32x4 a = acc[ai][bj][m][0], b = acc[ai][bj][m][1];
#pragma unroll
                    for (int i = 0; i < 4; ++i) { a[i] *= b0[i]; b[i] *= b1[i]; }
                    u32x4 w; w.x = pkh(a.x, a.y); w.y = pkh(a.z, a.w); w.z = pkh(b.x, b.y); w.w = pkh(b.z, b.w);
                    *(u32x4*)(O + (size_t)row * D + col0 + bj * HALF) = w;
                }
            }
    }
};

template <class Epi, class Sched>
__device__ __forceinline__ void gemm_phase(LAS unsigned char* lds, const Gemm g, const Sched& S, const Epi& E) {
    const int tid = threadIdx.x, wid = __builtin_amdgcn_readfirstlane(tid >> 6), lane = tid & 63, wr = wid >> 2, wc = wid & 3, fr = lane & 15, fq = lane >> 4;
    const int K = g.K, nt = K / BK, lda = g.lda;
    unsigned voffA[2], voffB[2];
#pragma unroll
    for (int i = 0; i < 2; ++i) { int R, C; stage_rc(tid * 16 + i * 8192, R, C); const int Rb = Epi::PERM ? ((R & ~31) + perm32(R & 31)) : R;
        voffA[i] = (unsigned)(R * lda + C) * 2u; voffB[i] = (unsigned)(Rb * K + C) * 2u; }
    const size_t kstep = (size_t)(BK * 2);
    const size_t hstepA = (size_t)HALF * lda * 2, hstepB = (size_t)HALF * K * 2;
    const size_t tstepA = 2 * hstepA, tstepB = 2 * hstepB;
    const unsigned ldsw = (unsigned)wid * 1024u;
    const int aoff = lds_byte(wr * 64 + fr, fq * 8), boff = lds_byte(wc * 32 + fr, fq * 8);
#define PG8_SA(b, h) (((b) * 2 + (h)) * HTB)
#define PG8_SB(b, h) ((4 + (b) * 2 + (h)) * HTB)
#define PG8_STAGE(bufoff, gbase, voff) do { _Pragma("unroll") for (int _i = 0; _i < 2; ++_i) \
        __builtin_amdgcn_global_load_lds((const unsigned*)((const char*)(gbase) + (voff)[_i]), (LAS unsigned*)(lds + (bufoff) + ldsw + _i * 8192), 16, 0, 0); } while (0)
#define PG8_LDA(dst, b, h) do { _Pragma("unroll") for (int m = 0; m < 4; ++m) _Pragma("unroll") for (int k = 0; k < 2; ++k) dst[m][k] = *(const LAS f16x8*)(lds + PG8_SA(b, h) + aoff + m * 2048 + k * 1024); } while (0)
#define PG8_LDB(dst, b, h) do { _Pragma("unroll") for (int n = 0; n < 2; ++n) _Pragma("unroll") for (int k = 0; k < 2; ++k) dst[n][k] = *(const LAS f16x8*)(lds + PG8_SB(b, h) + boff + n * 2048 + k * 1024); } while (0)
#define PG8_MMA(ai, bj, At, Bt) do { __builtin_amdgcn_s_setprio(1); _Pragma("unroll") for (int m = 0; m < 4; ++m) _Pragma("unroll") for (int n = 0; n < 2; ++n) _Pragma("unroll") for (int k = 0; k < 2; ++k) \
        acc[ai][bj][m][n] = __builtin_amdgcn_mfma_f32_16x16x32_f16(Bt[n][k], At[m][k], acc[ai][bj][m][n], 0, 0, 0); __builtin_amdgcn_s_setprio(0); } while (0)
#define PG8_WAIT_V(n) asm volatile("s_waitcnt vmcnt(" #n ")" ::: "memory")
#define PG8_WAIT_L(n) asm volatile("s_waitcnt lgkmcnt(" #n ")" ::: "memory")
#define PG8_BAR __builtin_amdgcn_s_barrier()
#define PG8_SCHED __builtin_amdgcn_sched_barrier(0)
#define PG8_KBODY \
            const bool last = (t == nt - 2); \
            const char* a1 = cA + (size_t)(t + 1) * kstep; \
            const char* a2 = last ? nA : cA + (size_t)(t + 2) * kstep; const char* b2 = last ? nB : cB + (size_t)(t + 2) * kstep; \
            const char* a3 = a2 + kstep; const char* b3 = b2 + kstep; \
            PG8_LDB(B0, 0, 0); PG8_LDB(B1, 0, 1); PG8_SCHED; PG8_LDA(At, 0, 0); PG8_STAGE(PG8_SA(1, 1), a1 + hstepA, voffA); \
            PG8_WAIT_V(8); PG8_WAIT_L(0); PG8_BAR; PG8_MMA(0, 0, At, B0); PG8_MMA(0, 1, At, B1); PG8_BAR; PG8_SCHED; \
            PG8_LDA(At, 0, 1); PG8_STAGE(PG8_SB(0, 0), b2, voffB); PG8_STAGE(PG8_SB(0, 1), b2 + hstepB, voffB); PG8_STAGE(PG8_SA(0, 0), a2, voffA); \
            PG8_WAIT_V(8); PG8_WAIT_L(0); PG8_BAR; PG8_MMA(1, 0, At, B0); PG8_MMA(1, 1, At, B1); PG8_BAR; PG8_SCHED; \
            PG8_LDB(B0, 1, 0); PG8_LDB(B1, 1, 1); PG8_SCHED; PG8_LDA(At, 1, 0); PG8_STAGE(PG8_SA(0, 1), a2 + hstepA, voffA); \
            PG8_WAIT_V(8); PG8_WAIT_L(0); PG8_BAR; PG8_MMA(0, 0, At, B0); PG8_MMA(0, 1, At, B1); PG8_BAR; PG8_SCHED; \
            PG8_LDA(At, 1, 1); PG8_STAGE(PG8_SB(1, 0), b3, voffB); PG8_STAGE(PG8_SB(1, 1), b3 + hstepB, voffB); PG8_STAGE(PG8_SA(1, 0), a3, voffA); \
            PG8_WAIT_V(8); PG8_WAIT_L(0); PG8_BAR; PG8_MMA(1, 0, At, B0); PG8_MMA(1, 1, At, B1); PG8_BAR; PG8_SCHED;
    Unit cur, nxt; int ui = 0;
    if (!S.next(0, cur)) return;
    f32x4 acc[2][2][4][2];
#pragma unroll
    for (int a = 0; a < 2; ++a)
#pragma unroll
        for (int b = 0; b < 2; ++b)
#pragma unroll
            for (int m = 0; m < 4; ++m)
#pragma unroll
                for (int n = 0; n < 2; ++n) acc[a][b][m][n] = (f32x4){0.f, 0.f, 0.f, 0.f};
    f16x8 At[4][2], B0[2][2], B1[2][2];
    const char* cA = (const char*)g.A + (size_t)cur.pm * tstepA; const char* cB = (const char*)g.Bt + (size_t)cur.pn * tstepB;
    PG8_STAGE(PG8_SB(0, 0), cB, voffB); PG8_STAGE(PG8_SB(0, 1), cB + hstepB, voffB); PG8_STAGE(PG8_SA(0, 0), cA, voffA); PG8_STAGE(PG8_SA(0, 1), cA + hstepA, voffA);
    if (wr == 1) PG8_BAR;
    PG8_WAIT_V(2); PG8_BAR;
    PG8_STAGE(PG8_SB(1, 0), cB + kstep, voffB); PG8_STAGE(PG8_SA(1, 0), cA + kstep, voffA); PG8_STAGE(PG8_SB(1, 1), cB + hstepB + kstep, voffB);
    PG8_WAIT_V(6); PG8_BAR;
    for (;;) {
        const bool has_next = S.next(ui + 1, nxt);
        const char* nA = has_next ? (const char*)g.A + (size_t)nxt.pm * tstepA : cA; const char* nB = has_next ? (const char*)g.Bt + (size_t)nxt.pn * tstepB : cB;
        if constexpr (Epi::MID) {
            for (int t = 0; t < E.mid_t; t += 2) { PG8_KBODY }
            E.mid(acc, cur, wr, wc, fr, fq); PG8_SCHED;
            for (int t = E.mid_t; t < nt; t += 2) { PG8_KBODY }
        } else {
            for (int t = 0; t < nt; t += 2) { PG8_KBODY }
        }
        if (wr == 0) PG8_BAR;
        E(acc, cur, wr, wc, fr, fq);
        if (!has_next) break;
#pragma unroll
        for (int a = 0; a < 2; ++a)
#pragma unroll
            for (int b = 0; b < 2; ++b)
#pragma unroll
                for (int m = 0; m < 4; ++m)
#pragma unroll
                    for (int n = 0; n < 2; ++n) acc[a][b][m][n] = (f32x4){0.f, 0.f, 0.f, 0.f};
        cur = nxt; cA = nA; cB = nB; ++ui;
        if (wr == 1) PG8_BAR;
    }
    PG8_WAIT_V(0);
    PG8_BAR;
#undef PG8_KBODY
#undef PG8_SA
#undef PG8_SB
#undef PG8_STAGE
#undef PG8_LDA
#undef PG8_LDB
#undef PG8_MMA
#undef PG8_WAIT_V
#undef PG8_WAIT_L
#undef PG8_BAR
#undef PG8_SCHED
}
}

struct SResid {
    const float* base; const h16* resh; float* out; h16* outh; float* ssq; float alpha;
    __device__ __forceinline__ void operator()(f32x4 sa, f32x4 sb, int row, int col, int pc, int t) const {
        const f32x4 bv = resh ? unpk4(*(const u32x2*)(resh + (size_t)row * D + col)) : *(const f32x4*)(base + (size_t)row * D + col); const f32x4 o = bv + (sa + sb) * alpha;
        if (out) *(f32x4*)(out + (size_t)row * D + col) = o;
        if (outh) { u32x2 w; w.x = pkh(o.x, o.y); w.y = pkh(o.z, o.w); *(u32x2*)(outh + (size_t)row * D + col) = w; }
        float s = (o.x * o.x + o.y * o.y) + (o.z * o.z + o.w * o.w);
        s = row_sum16(s);
        if ((t & 15) == 0) ssq[(size_t)row * 16 + pc] = s;
    }
};
struct SMerge {
    const h16* gt; h16* O;
    __device__ __forceinline__ void operator()(f32x4 sa, f32x4 sb, int row, int col, int pc, int t) const {
        const f32x4 ga = unpk4(*(const u32x2*)(gt + (size_t)row * GT_P + col)), gb = unpk4(*(const u32x2*)(gt + (size_t)row * GT_P + 1024 + col));
        const f32x4 o = ga * sa + gb * sb;
        u32x2 w; w.x = pkh(o.x, o.y); w.y = pkh(o.z, o.w); *(u32x2*)(O + (size_t)row * D + col) = w;
    }
};
template <class SE>
__device__ __forceinline__ void sample_gemm(LAS unsigned char* lds, const h16* A, int lda, const h16* Bt, int K, const SE& E, int piece, int tid) {
    const int w = __builtin_amdgcn_readfirstlane(tid >> 6), lane = tid & 63, n = lane & 15, q = lane >> 4;
    const int pr = piece >> 4, pc = piece & 15, kw = K >> 3, kbeg = w * kw;
    f32x4 acc[2][4];
#pragma unroll
    for (int m = 0; m < 2; ++m)
#pragma unroll
        for (int nn = 0; nn < 4; ++nn) acc[m][nn] = (f32x4){0.f, 0.f, 0.f, 0.f};
    const h16* ap = A + (size_t)(MP + 32 * pr + n) * lda + kbeg + 8 * q;
    const h16* bp = Bt + (size_t)(64 * pc + n) * K + kbeg + 8 * q;
#pragma unroll 4
    for (int k0 = 0; k0 < kw; k0 += 32) {
        f16x8 av[2], bv[4];
#pragma unroll
        for (int m = 0; m < 2; ++m) av[m] = *(const f16x8*)(ap + (size_t)(16 * m) * lda + k0);
#pragma unroll
        for (int nn = 0; nn < 4; ++nn) bv[nn] = *(const f16x8*)(bp + (size_t)(16 * nn) * K + k0);
#pragma unroll
        for (int m = 0; m < 2; ++m)
#pragma unroll
            for (int nn = 0; nn < 4; ++nn) acc[m][nn] = __builtin_amdgcn_mfma_f32_16x16x32_f16(av[m], bv[nn], acc[m][nn], 0, 0, 0);
    }
    LAS float* P = (LAS float*)lds + w * 2048;
#pragma unroll
    for (int m = 0; m < 2; ++m)
#pragma unroll
        for (int nn = 0; nn < 4; ++nn)
#pragma unroll
            for (int i = 0; i < 4; ++i) P[(16 * m + 4 * q + i) * 64 + 16 * nn + n] = acc[m][nn][i];
    LDS_WAIT(); __builtin_amdgcn_s_barrier(); asm volatile("" ::: "memory");
    const int r = tid >> 4, c4 = (tid & 15) * 4;
    const LAS float* Q = (const LAS float*)lds + r * 64 + c4;
    f32x4 sa = *(const LAS f32x4*)(Q), sb = *(const LAS f32x4*)(Q + 4 * 2048);
#pragma unroll
    for (int ww = 1; ww < 4; ++ww) { sa += *(const LAS f32x4*)(Q + ww * 2048); sb += *(const LAS f32x4*)(Q + (4 + ww) * 2048); }
    E(sa, sb, MP + 32 * pr + r, 64 * pc + c4, pc, tid);
    LDS_WAIT(); __builtin_amdgcn_s_barrier(); asm volatile("" ::: "memory");
}

#define XB_TMO      128
#define XB_XCNT(j)  (256  + 64 * (j))
#define XB_XSUB(j)  (1280 + 64 * (j))
#define XB_XGEN(j)  (2304 + 64 * (j))
#define XB_TOP      3328
#define XB_TOPGEN   3392
#define XCD_BAR_WORDS 3456
#define XB_SPIN_CAP (1u << 18)
__device__ __forceinline__ unsigned xb_ld(unsigned* p)              { return __hip_atomic_load(p, __ATOMIC_RELAXED, __HIP_MEMORY_SCOPE_AGENT); }
__device__ __forceinline__ unsigned xb_add(unsigned* p, unsigned v) { return __hip_atomic_fetch_add(p, v, __ATOMIC_RELAXED, __HIP_MEMORY_SCOPE_AGENT); }
__device__ __forceinline__ unsigned xb_xcc_id() { return (unsigned)__builtin_amdgcn_s_getreg((3 << 11) | 20) & 0xFu; }
#define XB_SPIN(cond, bar) do { unsigned _sp = 0; while (cond) { __builtin_amdgcn_s_sleep(1); \
    if ((++_sp & 255u) == 0u) { if (xb_ld(&(bar)[XB_TMO])) break; if (_sp > XB_SPIN_CAP) { atomicAdd(&(bar)[XB_TMO], 1u); break; } } } } while (0)
struct XcdBarrier { unsigned* bar; unsigned x; volatile LAS unsigned* st; };
__device__ __forceinline__ XcdBarrier xcd_barrier_post(unsigned* bar, volatile LAS unsigned* st) {
    XcdBarrier b; b.bar = bar; b.x = xb_xcc_id(); b.st = st;
    if (threadIdx.x == 0) (void)xb_add(&bar[XB_XCNT(b.x)], 1u);
    return b;
}
__device__ __forceinline__ void xcd_barrier_complete(unsigned* bar, unsigned x, unsigned& nloc, unsigned& nx) {
    const unsigned G = gridDim.x * gridDim.y * gridDim.z;
    unsigned sum, cnt, mine, sp = 0u;
    for (;;) {
        sum = 0u; cnt = 0u; mine = 0u;
#pragma unroll
        for (unsigned j = 0; j < 16; ++j) { const unsigned c = xb_ld(&bar[XB_XCNT(j)]); sum += c; cnt += (c > 0u) ? 1u : 0u; mine = (j == x) ? c : mine; }
        if (sum == G) break;
        __builtin_amdgcn_s_sleep(1);
        if ((++sp & 255u) == 0u) { if (xb_ld(&bar[XB_TMO])) break; if (sp > XB_SPIN_CAP) { atomicAdd(&bar[XB_TMO], 1u); break; } }
    }
    nloc = mine > 0u ? mine : 1u; nx = cnt > 0u ? cnt : 1u;
}
__device__ __forceinline__ void xcd_barrier(const XcdBarrier& b) {
    asm volatile("s_waitcnt vmcnt(0)" ::: "memory");
    __syncthreads();
    if (threadIdx.x == 0) {
        unsigned* bar = b.bar;
        __builtin_amdgcn_s_waitcnt(0);
        unsigned nloc = b.st[0], nx = b.st[1];
        if (nloc == 0u) { xcd_barrier_complete(bar, b.x, nloc, nx); b.st[0] = nloc; b.st[1] = nx; }
        const unsigned old = xb_add(&bar[XB_XSUB(b.x)], 1u);
        const unsigned gen = old / nloc;
        if (old + 1u == (gen + 1u) * nloc) {
            __builtin_amdgcn_fence(__ATOMIC_RELEASE, "agent");
            asm volatile("s_waitcnt vmcnt(0)" ::: "memory");
            const unsigned og = xb_add(&bar[XB_TOP], 1u);
            const unsigned tg = og / nx;
            if (og + 1u == (tg + 1u) * nx) xb_add(&bar[XB_TOPGEN], 1u);
            else XB_SPIN(xb_ld(&bar[XB_TOPGEN]) == tg, bar);
            __builtin_amdgcn_fence(__ATOMIC_ACQUIRE, "agent");
            xb_add(&bar[XB_XGEN(b.x)], 1u);
            asm volatile("s_waitcnt vmcnt(0)" ::: "memory");
        } else {
            XB_SPIN(xb_ld(&bar[XB_XGEN(b.x)]) == gen, bar);
            __builtin_amdgcn_fence(__ATOMIC_ACQUIRE, "agent");
            asm volatile("s_waitcnt vmcnt(0)" ::: "memory");
        }
    }
    __syncthreads();
}

struct Args { const float* in[35]; float* out; unsigned char* ws; int ph_lo, ph_hi, li, pad; };
typedef const Args __attribute__((address_space(4)))* KArgs;

struct Frame {
    LAS unsigned char* lds; int tid, lane, wave, G, bx;
};

__device__ __forceinline__ void tr_item(const float* W, int ldw, int k0, int src_col0, const float* kscale, h16* WT, int ldwt, int dst_row0, int dst_k0, LAS float* scr, int lane) {
    float vv[32];
#pragma unroll
    for (int i = 0; i < 32; ++i) { const int kk = 2 * i + (lane >> 5); vv[i] = W[(size_t)(k0 + kk) * ldw + src_col0 + (lane & 31)]; }
    if (kscale) {
#pragma unroll
        for (int i = 0; i < 32; ++i) vv[i] *= kscale[k0 + 2 * i + (lane >> 5)];
    }
#pragma unroll
    for (int i = 0; i < 32; ++i) { const int kk = 2 * i + (lane >> 5); scr[kk * 33 + (lane & 31)] = vv[i]; }
    LDS_WAIT(); asm volatile("" ::: "memory");
    const int c = lane & 7;
#pragma unroll
    for (int j = 0; j < 4; ++j) { const int n = (lane >> 3) + 8 * j; const LAS float* s = scr + (8 * c) * 33 + n;
        u32x4 o; o.x = pkh(s[0 * 33], s[1 * 33]); o.y = pkh(s[2 * 33], s[3 * 33]); o.z = pkh(s[4 * 33], s[5 * 33]); o.w = pkh(s[6 * 33], s[7 * 33]);
        *(u32x4*)(WT + (size_t)(dst_row0 + n) * ldwt + dst_k0 + 8 * c) = o; }
    LDS_WAIT(); asm volatile("" ::: "memory");
}
__device__ __forceinline__ void tr_up_item(const float* Wg, const float* Wu, const float* nrm, h16* WT, int item, LAS float* scr, int lane) {
    const int nblk = 5632 / 32, kb = item / nblk, nb = item % nblk, d0 = nb * 32, pn = d0 >> 8, j0 = d0 & 255;
    const float* src = (j0 < 128) ? Wg : Wu; const int col = 128 * pn + (j0 & 127);
    tr_item(src, FF, 64 * kb, col, nrm, WT, D, d0, 64 * kb, scr, lane);
}
__device__ __forceinline__ void p0_prologue(KArgs a, Frame& F) {
    unsigned char* ws = a->ws; unsigned char* dob = (unsigned char*)a->out;
    LAS float* scr = (LAS float*)(F.lds + F.wave * 16384);
    const int gw = F.bx * NWAVES + F.wave, NGW = F.G * NWAVES;
    constexpr int I_UP = 16 * 176, I_DN = 44 * 32, I_IN = 16 * 184;
    constexpr int NITEMS = I_UP + I_DN + I_IN;
    for (int it = gw; it < NITEMS; it += NGW) {
        int r = it;
        if (r < I_UP) { tr_up_item(a->in[7], a->in[8], a->in[6], (h16*)(dob + DO_W1UP), r, scr, F.lane); continue; } r -= I_UP;
        if (r < I_DN) { const int kb = r / 32, nb = r % 32; tr_item(a->in[9], D, 64 * kb, 32 * nb, nullptr, (h16*)(dob + DO_W1DN), FF, 32 * nb, 64 * kb, scr, F.lane); continue; } r -= I_DN;
        { const int kb = r / 184, nb = r % 184, d0 = 32 * nb; tr_item(a->in[11], 5896, 64 * kb, d0 + (d0 >= PAQ_W ? 8 : 0), a->in[10], (h16*)(dob + DO_WIN), D, d0, 64 * kb, scr, F.lane); }
    }
    {
        const int gt = F.bx * NTHREADS + F.tid, NGT = F.G * NTHREADS;
        h16* wab = (h16*)(ws + WS_WAB); h16* w2t = (h16*)(ws + WS_W2T); h16* a2t = (h16*)(ws + WS_A2T); h16* g2t = (h16*)(ws + WS_G2T);
        for (int i = gt; i < 16 * 1024; i += NGT) { const int j = i >> 10, k = i & 1023; const float v = (j < 8) ? a->in[11][(size_t)k * 5896 + PAQ_W + j] * a->in[10][k] : 0.f; wab[i] = __builtin_bit_cast(h16, (_Float16)v); }
        for (int i = gt; i < 512 * 64; i += NGT) { const int n = i >> 6, k = i & 63; w2t[i] = __builtin_bit_cast(h16, (_Float16)a->in[14][k * 512 + n]); a2t[i] = __builtin_bit_cast(h16, (_Float16)a->in[16][k * 512 + n]); }
        for (int i = gt; i < 512 * 128; i += NGT) { const int n = i >> 7, k = i & 127; g2t[i] = __builtin_bit_cast(h16, (_Float16)a->in[17][k * 512 + n]); }
    }
    h16* xh = (h16*)(ws + WS_A); float* ssq0 = (float*)(ws + WS_SSQ0);
    for (int m0 = gw; m0 < M; m0 += 4 * NGW) {
        f32x4 v[4][4];
#pragma unroll
        for (int r = 0; r < 4; ++r) { const int m = m0 + r * NGW; if (m < M) { const float* xrow = (m < MP) ? a->in[0] + (size_t)m * D : a->in[1] + (size_t)(m - MP) * D; const f32x4* xr = (const f32x4*)xrow + F.lane;
#pragma unroll
            for (int j = 0; j < 4; ++j) v[r][j] = xr[64 * j]; } }
#pragma unroll
        for (int r = 0; r < 4; ++r) { const int m = m0 + r * NGW; if (m < M) { u32x2* o8 = (u32x2*)(xh + (size_t)m * D) + F.lane; float s = 0.f;
#pragma unroll
            for (int j = 0; j < 4; ++j) { const f32x4 t = v[r][j]; s += (t.x * t.x + t.y * t.y) + (t.z * t.z + t.w * t.w); u32x2 w; w.x = pkh(t.x, t.y); w.y = pkh(t.z, t.w); o8[64 * j] = w; }
            s = wave_sum(s);
            if (F.lane == 0) ssq0[(size_t)m * 16] = s; } }
    }
}

__device__ __forceinline__ void ab_gemv(KArgs a, Frame& F) {
    const h16* hh = (const h16*)((const unsigned char*)a->out + DO_H1H); const h16* wab = (const h16*)(a->ws + WS_WAB); float* ab = (float*)(a->ws + WS_AB);
    pg8::RowScale rs{(const float*)(a->ws + WS_SSQ1), 16};
    const int gw = F.bx * NWAVES + F.wave, NGW = F.G * NWAVES, n = F.lane & 15, q = F.lane >> 4;
    for (int tile = gw; tile < M / 16; tile += NGW) {
        const h16* ap = hh + (size_t)(tile * 16 + n) * D + 8 * q; const h16* bp = wab + (size_t)n * D + 8 * q;
        f32x4 acc0 = (f32x4){0.f, 0.f, 0.f, 0.f}, acc1 = acc0;
#pragma unroll 8
        for (int st = 0; st < 32; st += 2) {
            const f16x8 a0 = *(const f16x8*)(ap + 32 * st), b0 = *(const f16x8*)(bp + 32 * st), a1 = *(const f16x8*)(ap + 32 * st + 32), b1 = *(const f16x8*)(bp + 32 * st + 32);
            acc0 = __builtin_amdgcn_mfma_f32_16x16x32_f16(a0, b0, acc0, 0, 0, 0); acc1 = __builtin_amdgcn_mfma_f32_16x16x32_f16(a1, b1, acc1, 0, 0, 0);
        }
        if (n < 8) {
#pragma unroll
            for (int i = 0; i < 4; ++i) { const int row = tile * 16 + 4 * q + i; ab[(size_t)row * 8 + n] = (acc0[i] + acc1[i]) * rs(row); }
        }
    }
}

__device__ __forceinline__ void gdn_prep(KArgs a, Frame& F) {
    const h16* PAQ = (const h16*)(a->ws + WS_PAQ); h16* QK = (h16*)(a->ws + WS_A);
    const float* cwp = a->in[23];
    const int lane = F.lane, arr = lane >> 5, c4 = (lane & 31) * 4;
    const int gw = F.bx * NWAVES + F.wave, NGW = F.G * NWAVES;
    for (int item = gw; item < (M / 4) * 4; item += NGW) {
        const int hh = item & 3, run = item >> 2, row0 = 4 * run;
        const int qcol = (arr ? C_GK : C_Q) + hh * 128 + c4, qch = qcol - C_Q;
        f32x4 cwq[4];
#pragma unroll
        for (int i = 0; i < 4; ++i) cwq[i] = *(const f32x4*)(cwp + i * CONVCH + qch);
        const float qscale = arr ? 1.0f : 0.08838834764831845f;
        const h16* pq = PAQ + (size_t)row0 * PAQ_W + qcol;
        f32x4 w0, w1, w2;
        if (row0 >= MP) { const float* sc = a->in[5] + (size_t)((row0 - MP) >> 2) * 3 * CONVCH + qch; w0 = *(const f32x4*)sc; w1 = *(const f32x4*)(sc + CONVCH); w2 = *(const f32x4*)(sc + 2 * CONVCH); }
        else if ((row0 & (SEQ - 1)) == 0) { w0 = w1 = w2 = (f32x4){0.f, 0.f, 0.f, 0.f}; }
        else { w0 = unpk4(*(const u32x2*)(pq - 3 * PAQ_W)); w1 = unpk4(*(const u32x2*)(pq - 2 * PAQ_W)); w2 = unpk4(*(const u32x2*)(pq - PAQ_W)); }
        f32x4 xs[4];
#pragma unroll
        for (int i = 0; i < 4; ++i) xs[i] = unpk4(*(const u32x2*)(pq + (size_t)i * PAQ_W));
#pragma unroll
        for (int i = 0; i < 4; ++i) {
            f32x4 cv = w0 * cwq[0] + w1 * cwq[1] + w2 * cwq[2] + xs[i] * cwq[3];
            cv.x = fsilu(cv.x); cv.y = fsilu(cv.y); cv.z = fsilu(cv.z); cv.w = fsilu(cv.w);
            float ss = (cv.x * cv.x + cv.y * cv.y) + (cv.z * cv.z + cv.w * cv.w);
            ss = row_sum16(ss); ss += __shfl_xor(ss, 16);
            const float sc = __builtin_amdgcn_rsqf(ss + 1e-6f) * qscale;
            cv = cv * sc;
            u32x2 o; o.x = pkh(cv.x, cv.y); o.y = pkh(cv.z, cv.w);
            *(u32x2*)(QK + (size_t)(row0 + i) * D + arr * 512 + hh * 128 + c4) = o;
            w0 = w1; w1 = w2; w2 = xs[i];
        }
    }
    const int gt = F.bx * NTHREADS + F.tid, NGT = F.G * NTHREADS;
    for (int i = gt; i < NB_P * APROJ; i += NGT) { const int bb = i / APROJ, cc = i % APROJ; a->out[O_SHIFT_P + i] = h2f(PAQ[(size_t)(bb * SEQ + SEQ - 1) * PAQ_W + cc]); }
    for (int i = gt; i < NB_S * APROJ; i += NGT) { const int bb = i / APROJ, cc = i % APROJ; a->out[O_SHIFT_S + i] = h2f(PAQ[(size_t)(MP + bb * TS + TS - 1) * PAQ_W + cc]); }
    for (int i = gt; i < NB_P * 3 * CONVCH; i += NGT) { const int bb = i / (3 * CONVCH), r = (i / CONVCH) % 3, cc = i % CONVCH; a->out[O_CONV_P + i] = h2f(PAQ[(size_t)(bb * SEQ + SEQ - 3 + r) * PAQ_W + C_Q + cc]); }
    for (int i = gt; i < NB_S * 3 * CONVCH; i += NGT) { const int bb = i / (3 * CONVCH), r = (i / CONVCH) % 3, cc = i % CONVCH; a->out[O_CONV_S + i] = h2f(PAQ[(size_t)(MP + bb * TS + 1 + r) * PAQ_W + C_Q + cc]); }
}

constexpr int NBLK_P = SEQ / 16, NBLK = NBLK_P + 4;
constexpr int RX_BYTES = 8192, RY_BYTES = 17408, GY_BYTES = 10752;
constexpr int ROPS_BYTES = 17664, RG_BYTES = 3584;
constexpr int R_X = 0, R_Y = R_X + 2 * RX_BYTES, R_OPS = R_Y + 3 * RY_BYTES, R_G = R_OPS + 3 * ROPS_BYTES, G_Y = 0;
static_assert(R_G + 2 * RG_BYTES <= RING_BYTES && G_Y + 2 * GY_BYTES <= RING_BYTES, "scan LDS");

__device__ __forceinline__ int blk_row0(int j, int b, int sgrp) { return (j < NBLK_P) ? b * SEQ + 16 * j : MP + 16 * (4 * sgrp + (j - NBLK_P)); }
#define WG_BAR() do { asm volatile("s_waitcnt lgkmcnt(0)" ::: "memory"); __builtin_amdgcn_s_barrier(); asm volatile("" ::: "memory"); } while (0)

struct RwkvPre { u32x2 cr, cw, ck, ca, pr, pw, pk, pa; };
struct RwkvOps { u32x2 r, d, k, q, b; unsigned v; };
__device__ __forceinline__ RwkvOps rwkv_ld(const LAS unsigned char* Y, int s, int kq, int vi) {
    RwkvOps o; const LAS unsigned char* p = Y + s * 128 + kq * 8;
    o.r = *(const LAS u32x2*)(p); o.d = *(const LAS u32x2*)(p + 2048); o.k = *(const LAS u32x2*)(p + 4096); o.q = *(const LAS u32x2*)(p + 6144); o.b = *(const LAS u32x2*)(p + 8192);
    o.v = *(const LAS unsigned*)(Y + 10240 + s * 128 + vi * 4);
    return o;
}
__device__ __forceinline__ float rwkv_step(h2& S0, h2& S1, const RwkvOps& p) {
    float sa = __builtin_amdgcn_fdot2(S0, u2h(p.q.x), 0.f, false); sa = __builtin_amdgcn_fdot2(S1, u2h(p.q.y), sa, false);
    sa = -row_sum16(sa);
    const h2 sah = bc2(sa), vv = u2h(p.v);
    S0 = __builtin_elementwise_fma(S0, u2h(p.d.x), __builtin_elementwise_fma(vv, u2h(p.k.x), sah * u2h(p.b.x)));
    S1 = __builtin_elementwise_fma(S1, u2h(p.d.y), __builtin_elementwise_fma(vv, u2h(p.k.y), sah * u2h(p.b.y)));
    float o = __builtin_amdgcn_fdot2(S0, u2h(p.r.x), 0.f, false); o = __builtin_amdgcn_fdot2(S1, u2h(p.r.y), o, false);
    return row_sum16(o);
}

__device__ __forceinline__ void rwkv_role(KArgs a, Frame& F, int c, int mode, int part) {
    const bool do_stage = (mode != 6), do_scan = (mode != 5), do_write = (mode < 3);
    const bool do_c1 = (mode != 8), do_c2 = (mode != 8 && mode != 9), do_cons = (mode != 8 && mode != 9 && mode != 10);
    const int w = F.wave, lane = F.lane;
    const int b = c >> 4, h = (c >> 1) & 7, half = c & 1;
    const h16* PAQ = (const h16*)(a->ws + WS_PAQ); h16* OB = (h16*)(a->ws + WS_PAQ) + C_Q; float* bon = (float*)(a->ws + WS_BON);
    const float* mu = a->in[12];
    LAS unsigned char* lds = F.lds;
    const int tsl = lane >> 4, kq = lane & 15;
    const int rwA = w & 3;
    const f32x4 mu_r = *(const f32x4*)(mu + C_R + h * 64 + 4 * kq), mu_w = *(const f32x4*)(mu + C_WD + 4 * kq), mu_k = *(const f32x4*)(mu + C_K + h * 64 + 4 * kq), mu_a = *(const f32x4*)(mu + C_AD + 4 * kq);
    const f32x4 kkw = *(const f32x4*)(a->in[18] + h * 64 + 4 * kq);
    const int o_r = C_R + h * 64 + 4 * kq, o_w = C_WD + 4 * kq, o_k = C_K + h * 64 + 4 * kq, o_a = C_AD + 4 * kq;
    const int sA = 4 * rwA + tsl;
    const int sVv = 2 * w + (lane >> 5), vloc = lane & 31, vcolp = C_V + h * 64 + 32 * half + vloc; const float mu_v = mu[vcolp];
    const int kb = 16 * rwA + kq;
    const float w0b = a->in[13][h * 64 + kb], a0b = a->in[15][h * 64 + kb], kab = a->in[19][h * 64 + kb], rkb = a->in[20][h * 64 + kb];
    f16x8 w2f[2], a2f[2];
    { const h16* w2t = (const h16*)(a->ws + WS_W2T) + (size_t)(h * 64 + kb) * 64 + 8 * tsl; const h16* a2t = (const h16*)(a->ws + WS_A2T) + (size_t)(h * 64 + kb) * 64 + 8 * tsl;
      w2f[0] = *(const f16x8*)w2t; w2f[1] = *(const f16x8*)(w2t + 32); a2f[0] = *(const f16x8*)a2t; a2f[1] = *(const f16x8*)(a2t + 32); }
    const int vi = 4 * w + tsl, vrow = 32 * half + vi;
    h2 S0 = (h2){0, 0}, S1 = (h2){0, 0};
    const int sgrp = b;

#define RW_PREFETCH(j) do { const int row_ = b * SEQ + 16 * (j) + sA; const h16* pc_ = PAQ + (size_t)row_ * PAQ_W; const h16* pp_ = pc_ - (((j) == 0 && sA == 0) ? 0 : PAQ_W); \
        pre.cr = *(const u32x2*)(pc_ + o_r); pre.cw = *(const u32x2*)(pc_ + o_w); pre.ck = *(const u32x2*)(pc_ + o_k); pre.ca = *(const u32x2*)(pc_ + o_a); \
        pre.pr = *(const u32x2*)(pp_ + o_r); pre.pw = *(const u32x2*)(pp_ + o_w); pre.pk = *(const u32x2*)(pp_ + o_k); pre.pa = *(const u32x2*)(pp_ + o_a); } while (0)
#define RW_STAGE_A(j, cr, cw, ck, ca, pr, pw, pk, pa) do { \
        LAS unsigned char* X_ = lds + R_X + ((j) & 1) * RX_BYTES; LAS unsigned char* Y_ = lds + R_Y + ((j) % 3) * RY_BYTES; \
        const f32x4 r_ = cr + (pr - cr) * mu_r, w_ = cw + (pw - cw) * mu_w, k_ = ck + (pk - ck) * mu_k, a_ = ca + (pa - ca) * mu_a; \
        { u32x2 t_; t_.x = pkh(r_.x, r_.y); t_.y = pkh(r_.z, r_.w); *(LAS u32x2*)(Y_ + 0 + sA * 128 + kq * 8) = t_; } \
        { u32x2 t_; t_.x = pkh(ftanh(w_.x), ftanh(w_.y)); t_.y = pkh(ftanh(w_.z), ftanh(w_.w)); *(LAS u32x2*)(X_ + 0 + sA * 128 + kq * 8) = t_; } \
        { u32x2 t_; t_.x = pkh(a_.x, a_.y); t_.y = pkh(a_.z, a_.w); *(LAS u32x2*)(X_ + 2048 + sA * 128 + kq * 8) = t_; } \
        *(LAS f32x4*)(X_ + 4096 + sA * 256 + kq * 16) = k_; \
        const f32x4 kkr_ = k_ * kkw; \
        float ss_ = (kkr_.x * kkr_.x + kkr_.y * kkr_.y) + (kkr_.z * kkr_.z + kkr_.w * kkr_.w); \
        ss_ = row_sum16(ss_); \
        const float inv_ = frcp(fmaxf(__builtin_amdgcn_sqrtf(ss_), 1e-12f)); \
        { const f32x4 kn_ = kkr_ * inv_; u32x2 t_; t_.x = pkh(kn_.x, kn_.y); t_.y = pkh(kn_.z, kn_.w); *(LAS u32x2*)(Y_ + 6144 + sA * 128 + kq * 8) = t_; } } while (0)
#define RW_STAGE_V(j, cv, pv) do { LAS unsigned char* Y_ = lds + R_Y + ((j) % 3) * RY_BYTES; \
        const float vl_ = (cv) + ((pv) - (cv)) * mu_v; *(LAS unsigned*)(Y_ + 10240 + sVv * 128 + vloc * 4) = pkh(vl_, vl_); \
        *(LAS h16*)(Y_ + 16384 + vloc * 32 + sVv * 2) = __builtin_bit_cast(h16, (_Float16)vl_); } while (0)
#define RW_STAGE_B(j) do { \
        LAS unsigned char* X_ = lds + R_X + ((j) & 1) * RX_BYTES; LAS unsigned char* Y_ = lds + R_Y + ((j) % 3) * RY_BYTES; \
        f32x4 wacc_ = (f32x4){0.f, 0.f, 0.f, 0.f}, aacc_ = (f32x4){0.f, 0.f, 0.f, 0.f}; \
        _Pragma("unroll") for (int st_ = 0; st_ < 2; ++st_) { \
            const f16x8 ta_ = *(const LAS f16x8*)(X_ + 0 + kq * 128 + tsl * 16 + st_ * 64); \
            const f16x8 aa_ = *(const LAS f16x8*)(X_ + 2048 + kq * 128 + tsl * 16 + st_ * 64); \
            wacc_ = __builtin_amdgcn_mfma_f32_16x16x32_f16(ta_, w2f[st_], wacc_, 0, 0, 0); \
            aacc_ = __builtin_amdgcn_mfma_f32_16x16x32_f16(aa_, a2f[st_], aacc_, 0, 0, 0); } \
        const int row0_ = blk_row0((j), b, sgrp); \
        _Pragma("unroll") for (int i_ = 0; i_ < 4; ++i_) { \
            const int s_ = 4 * tsl + i_; \
            const float ld_ = -0.60653065971f * fsigmoid(w0b + wacc_[i_]); const float dd_ = fexp(ld_); \
            *(LAS float*)(Y_ + 12288 + s_ * 256 + kb * 4) = ld_; \
            const float av_ = fsigmoid(a0b + aacc_[i_]); \
            const float kr_ = *(const LAS float*)(X_ + 4096 + s_ * 256 + kb * 4); \
            const float kkv_ = h2f(*(const LAS h16*)(Y_ + 6144 + s_ * 128 + kb * 2)); \
            const float rv_ = h2f(*(const LAS h16*)(Y_ + 0 + s_ * 128 + kb * 2)); \
            const float kp_ = kr_ * (1.0f + (av_ - 1.0f) * kab); \
            *(LAS h16*)(Y_ + 2048 + s_ * 128 + kb * 2) = __builtin_bit_cast(h16, (_Float16)dd_); \
            *(LAS h16*)(Y_ + 4096 + s_ * 128 + kb * 2) = __builtin_bit_cast(h16, (_Float16)kp_); \
            *(LAS h16*)(Y_ + 8192 + s_ * 128 + kb * 2) = __builtin_bit_cast(h16, (_Float16)(kkv_ * av_)); \
            const float bp_ = row_sum16(rv_ * kp_ * rkb); \
            if (do_write && half == 0 && kq == 0) bon[(size_t)(row0_ + s_) * 32 + h * 4 + rwA] = bp_; } } while (0)

    if (part == 0)
    {
        constexpr int RAWR = 0, RAWW = 8192, RAWK = 16384, RAWA = 24576, RAWV = 32768, RAW_END = 36864;
        constexpr int TWP = 144, CP = 136;
        constexpr int AO0 = RAW_END, AO_TW = 0, AO_AD = 16 * TWP, AO_R = 32 * TWP, AO_KK = AO_R + 16 * CP, AO_KR = AO_KK + 16 * CP, AO_SLOT = ((AO_KR + 16 * CP + 63) / 64) * 64;
        constexpr int VR0 = AO0 + 2 * AO_SLOT;
        constexpr int TLP = 40;
        constexpr int TL0 = VR0 + 4096, T_AR = 0, T_RR = 64 * TLP, T_BR = 2 * 64 * TLP, T_KR = 3 * 64 * TLP, T_BH = 4 * 64 * TLP, T_KH = 5 * 64 * TLP, T_PM = 6 * 64 * TLP, T_PC = T_PM + 256, TL_SLOT = T_PC + 256;
        constexpr int TFP = 68;
        constexpr int GG0 = TL0 + 3 * TL_SLOT, GG_TF = 0, GG_NK = 16 * TFP, GG_MB = GG_NK + 512, GG_MK = GG_MB + 512, GG_SLOT = ((GG_MK + 512 + 63) / 64) * 64, AM0 = GG0 + 2 * GG_SLOT, RC_END = AM0 + 1024;
        static_assert(RC_END <= RING_BYTES, "rwkv chunk LDS");
        const int n = kq, q = tsl;
        const int wu = __builtin_amdgcn_readfirstlane(w);
        const int bcg = (wu == 6) ? 3 : wu;
        constexpr int NIT = NBLK_P + 3;
        if (wu < 3 || wu == 6) {
            float tri[4], mid[4];
#pragma unroll
            for (int s_ = 0; s_ < 4; ++s_) { tri[s_] = (4 * q + s_ <= n) ? 1.0f : 0.0f; mid[s_] = (4 * q + s_ <= 7) ? 1.0f : 0.0f; }
            const int trp = (4 * q + (n >> 2)) * CP + (16 * bcg + 4 * (n & 3)) * 2;
            const int kb = 16 * bcg + n;
            const float w0b = a->in[13][h * 64 + kb], a0b = a->in[15][h * 64 + kb], kab = a->in[19][h * 64 + kb], rkb = a->in[20][h * 64 + kb];
            f16x8 w2f[2], a2f[2];
            { const h16* w2t = (const h16*)(a->ws + WS_W2T) + (size_t)(h * 64 + kb) * 64 + 8 * q; const h16* a2t = (const h16*)(a->ws + WS_A2T) + (size_t)(h * 64 + kb) * 64 + 8 * q;
              w2f[0] = *(const f16x8*)w2t; w2f[1] = *(const f16x8*)(w2t + 32); a2f[0] = *(const f16x8*)a2t; a2f[1] = *(const f16x8*)(a2t + 32); }
            WG_BAR();
            for (int it = 0; it < NIT; ++it) {
                if (it >= 1 && it - 1 < NBLK_P) {
                    const int jc = it - 1; const LAS unsigned char* AO = lds + AO0 + (jc & 1) * AO_SLOT; LAS unsigned char* P = lds + TL0 + (jc % 3) * TL_SLOT;
                    f32x4 wacc = (f32x4){0.f, 0.f, 0.f, 0.f}, aacc = wacc;
#pragma unroll
                    for (int st = 0; st < 2; ++st) {
                        const f16x8 ta = *(const LAS f16x8*)(AO + AO_TW + n * TWP + q * 16 + st * 64);
                        const f16x8 aa = *(const LAS f16x8*)(AO + AO_AD + n * TWP + q * 16 + st * 64);
                        wacc = __builtin_amdgcn_mfma_f32_16x16x32_f16(ta, w2f[st], wacc, 0, 0, 0);
                        aacc = __builtin_amdgcn_mfma_f32_16x16x32_f16(aa, a2f[st], aacc, 0, 0, 0);
                    }
                    const f32x4 rv = unpk4(__builtin_bit_cast(u32x2, __builtin_amdgcn_ds_read_tr16_b64_v4i16((LAS v4i16_t*)(AO + AO_R + trp))));
                    const f32x4 kkv = unpk4(__builtin_bit_cast(u32x2, __builtin_amdgcn_ds_read_tr16_b64_v4i16((LAS v4i16_t*)(AO + AO_KK + trp))));
                    const f32x4 krv = unpk4(__builtin_bit_cast(u32x2, __builtin_amdgcn_ds_read_tr16_b64_v4i16((LAS v4i16_t*)(AO + AO_KR + trp))));
                    f32x4 ld, av;
#pragma unroll
                    for (int e = 0; e < 4; ++e) { ld[e] = -0.60653065971f * fsigmoid(w0b + wacc[e]); av[e] = fsigmoid(a0b + aacc[e]); }
                    f32x4 L = (f32x4){0.f, 0.f, 0.f, 0.f}, Lm = L, Lf = L;
#pragma unroll
                    for (int s_ = 0; s_ < 4; ++s_) {
                        L = __builtin_amdgcn_mfma_f32_16x16x4f32(tri[s_], ld[s_], L, 0, 0, 0);
                        Lm = __builtin_amdgcn_mfma_f32_16x16x4f32(mid[s_], ld[s_], Lm, 0, 0, 0);
                        Lf = __builtin_amdgcn_mfma_f32_16x16x4f32(1.0f, ld[s_], Lf, 0, 0, 0);
                    }
                    const float lmid = Lm[0], PM = fexp(lmid), c15 = fexp(Lf[0] - lmid);
                    f32x4 E, Em1, Ei;
#pragma unroll
                    for (int e = 0; e < 4; ++e) { E[e] = fexp(L[e] - lmid); Em1[e] = fexp(L[e] - ld[e] - lmid); Ei[e] = frcp(E[e]); }
                    const f32x4 E15 = Ei * c15;
                    const f32x4 kpv = krv * (1.0f + (av - 1.0f) * kab), kav = kkv * av;
                    LAS unsigned char* tw = P + kb * TLP + q * 8;
                    *(LAS f16x4*)(tw + T_AR) = cvt4(-kkv * Em1); *(LAS f16x4*)(tw + T_RR) = cvt4(rv * E);
                    *(LAS f16x4*)(tw + T_BR) = cvt4(kav * Ei); *(LAS f16x4*)(tw + T_KR) = cvt4(kpv * Ei);
                    *(LAS f16x4*)(tw + T_BH) = cvt4(kav * E15); *(LAS f16x4*)(tw + T_KH) = cvt4(kpv * E15);
                    if (q == 0) { *(LAS float*)(P + T_PM + kb * 4) = PM; *(LAS float*)(P + T_PC + kb * 4) = PM * c15; }
                    const int row0 = b * SEQ + 16 * jc;
#pragma unroll
                    for (int e = 0; e < 4; ++e) { const float bp = row_sum16(rv[e] * kpv[e] * rkb);
                        if (do_write && half == 0 && n == 0) bon[(size_t)(row0 + 4 * q + e) * 32 + h * 4 + bcg] = bp; }
                }
                WG_BAR();
            }
        } else if (wu == 4 || wu == 5) {
            const int wa = wu - 4;
            const h16* gbase = PAQ + (size_t)(b * SEQ) * PAQ_W;
            const unsigned gt0 = (unsigned)(((lane >> 3) * PAQ_W + (wa == 0 ? C_R + h * 64 : C_K + h * 64) + 8 * (lane & 7)) * 2);
            const unsigned gt1 = (unsigned)(((lane >> 3) * PAQ_W + (wa == 0 ? C_WD : C_AD) + 8 * (lane & 7)) * 2);
            const unsigned gtv = (unsigned)(((lane >> 2) * PAQ_W + C_V + h * 64 + 32 * half + 8 * (lane & 3)) * 2);
            const int d0 = (wa == 0) ? RAWR : RAWK, d1 = (wa == 0) ? RAWW : RAWA;
#define RC_DMA(j) do { const unsigned char* gb_ = (const unsigned char*)(gbase + (size_t)(16 * (j)) * PAQ_W); const int ro_ = ((16 * (j)) & 63) * 128; \
                __builtin_amdgcn_global_load_lds((const unsigned*)(gb_ + gt0), (LAS unsigned*)(lds + d0 + ro_), 16, 0, 0); \
                __builtin_amdgcn_global_load_lds((const unsigned*)(gb_ + gt0 + 8 * PAQ_W * 2), (LAS unsigned*)(lds + d0 + ro_ + 1024), 16, 0, 0); \
                __builtin_amdgcn_global_load_lds((const unsigned*)(gb_ + gt1), (LAS unsigned*)(lds + d1 + ro_), 16, 0, 0); \
                __builtin_amdgcn_global_load_lds((const unsigned*)(gb_ + gt1 + 8 * PAQ_W * 2), (LAS unsigned*)(lds + d1 + ro_ + 1024), 16, 0, 0); \
                __builtin_amdgcn_global_load_lds((const unsigned*)(gb_ + gtv), (LAS unsigned*)(lds + RAWV + (ro_ >> 1)), 16, 0, 0); } while (0)
            RC_DMA(0); RC_DMA(1);
            asm volatile("s_waitcnt vmcnt(0)" ::: "memory");
            const float mu_v0 = mu[C_V + h * 64 + 32 * half + 2 * kq], mu_v1 = mu[C_V + h * 64 + 32 * half + 2 * kq + 1];
            WG_BAR();
            for (int it = 0; it < NIT; ++it) {
                if (it + 2 < NBLK_P) RC_DMA(it + 2);
                if (it < NBLK_P) {
                    LAS unsigned char* AO = lds + AO0 + (it & 1) * AO_SLOT;
#pragma unroll
                    for (int p = 0; p < 2; ++p) {
                        const int i = 8 * wa + 4 * p + tsl, rowc = (16 * it + i) & 63, rowp = (rowc - 1) & 63;
                        const f32x4 cr = unpk4(*(const LAS u32x2*)(lds + RAWR + rowc * 128 + kq * 8)), cw_ = unpk4(*(const LAS u32x2*)(lds + RAWW + rowc * 128 + kq * 8)),
                                    ck = unpk4(*(const LAS u32x2*)(lds + RAWK + rowc * 128 + kq * 8)), ca = unpk4(*(const LAS u32x2*)(lds + RAWA + rowc * 128 + kq * 8));
                        f32x4 pr = unpk4(*(const LAS u32x2*)(lds + RAWR + rowp * 128 + kq * 8)), pw = unpk4(*(const LAS u32x2*)(lds + RAWW + rowp * 128 + kq * 8)),
                              pk = unpk4(*(const LAS u32x2*)(lds + RAWK + rowp * 128 + kq * 8)), pa = unpk4(*(const LAS u32x2*)(lds + RAWA + rowp * 128 + kq * 8));
                        const unsigned cvu = *(const LAS unsigned*)(lds + RAWV + rowc * 64 + kq * 4); unsigned pvu = *(const LAS unsigned*)(lds + RAWV + rowp * 64 + kq * 4);
                        if (it == 0 && i == 0) { pr = pw = pk = pa = (f32x4){0.f, 0.f, 0.f, 0.f}; pvu = 0u; }
                        const f32x4 r_ = cr + (pr - cr) * mu_r, w_ = cw_ + (pw - cw_) * mu_w, k_ = ck + (pk - ck) * mu_k, a_ = ca + (pa - ca) * mu_a;
                        { u32x2 t_; t_.x = pkh(r_.x, r_.y); t_.y = pkh(r_.z, r_.w); *(LAS u32x2*)(AO + AO_R + i * CP + kq * 8) = t_; }
                        { u32x2 t_; t_.x = pkh(ftanh(w_.x), ftanh(w_.y)); t_.y = pkh(ftanh(w_.z), ftanh(w_.w)); *(LAS u32x2*)(AO + AO_TW + i * TWP + kq * 8) = t_; }
                        { u32x2 t_; t_.x = pkh(a_.x, a_.y); t_.y = pkh(a_.z, a_.w); *(LAS u32x2*)(AO + AO_AD + i * TWP + kq * 8) = t_; }
                        { u32x2 t_; t_.x = pkh(k_.x, k_.y); t_.y = pkh(k_.z, k_.w); *(LAS u32x2*)(AO + AO_KR + i * CP + kq * 8) = t_; }
                        const f32x4 kkr = k_ * kkw;
                        float ss = (kkr.x * kkr.x + kkr.y * kkr.y) + (kkr.z * kkr.z + kkr.w * kkr.w);
                        ss = row_sum16(ss);
                        const float inv = frcp(fmaxf(__builtin_amdgcn_sqrtf(ss), 1e-12f));
                        { const f32x4 kn = kkr * inv; u32x2 t_; t_.x = pkh(kn.x, kn.y); t_.y = pkh(kn.z, kn.w); *(LAS u32x2*)(AO + AO_KK + i * CP + kq * 8) = t_; }
                        { const h2 cv2 = u2h(cvu), pv2 = u2h(pvu); const float c0 = (float)cv2.x, c1 = (float)cv2.y;
                          *(LAS unsigned*)(lds + VR0 + (it & 3) * 1024 + i * 64 + kq * 4) = pkh(c0 + ((float)pv2.x - c0) * mu_v0, c1 + ((float)pv2.y - c1) * mu_v1); }
                    }
                }
                if (it + 2 < NBLK_P) asm volatile("s_waitcnt vmcnt(5)" ::: "memory"); else asm volatile("s_waitcnt vmcnt(0)" ::: "memory");
                WG_BAR();
            }
#undef RC_DMA
        } else if (wu == 3) {
            const int tra = (4 * q + (n >> 2)) * TLP + (n & 3) * 8;
            WG_BAR();
            for (int it = 0; it < NIT; ++it) {
                if (it >= 2 && it - 2 < NBLK_P) {
                    const int jc = it - 2; const LAS unsigned char* P = lds + TL0 + (jc % 3) * TL_SLOT; LAS unsigned char* Gs = lds + GG0 + (jc & 1) * GG_SLOT; LAS unsigned char* AM = lds + AM0;
                    f32x4 nb = (f32x4){0.f, 0.f, 0.f, 0.f}, nk = nb, mb = nb, mk = nb;
#pragma unroll
                    for (int s_ = 0; s_ < 4; ++s_) {
                        const f16x4 ar = __builtin_bit_cast(f16x4, __builtin_amdgcn_ds_read_tr16_b64_v4i16((LAS v4i16_t*)(P + T_AR + 16 * s_ * TLP + tra)));
                        const f16x4 rr = __builtin_bit_cast(f16x4, __builtin_amdgcn_ds_read_tr16_b64_v4i16((LAS v4i16_t*)(P + T_RR + 16 * s_ * TLP + tra)));
                        const f16x4 br = __builtin_bit_cast(f16x4, __builtin_amdgcn_ds_read_tr16_b64_v4i16((LAS v4i16_t*)(P + T_BR + 16 * s_ * TLP + tra)));
                        const f16x4 kr = __builtin_bit_cast(f16x4, __builtin_amdgcn_ds_read_tr16_b64_v4i16((LAS v4i16_t*)(P + T_KR + 16 * s_ * TLP + tra)));
                        nb = MFMA16(ar, br, nb); nk = MFMA16(ar, kr, nk); mb = MFMA16(rr, br, mb); mk = MFMA16(rr, kr, mk);
                    }
#pragma unroll
                    for (int r = 0; r < 4; ++r) { const int i = 4 * q + r;
                        *(LAS float*)(AM + (i * 16 + n) * 4) = (i > n) ? nb[r] : 0.f;
                        *(LAS h16*)(Gs + GG_NK + i * 32 + n * 2) = __builtin_bit_cast(h16, (_Float16)((i > n) ? nk[r] : 0.f));
                        *(LAS h16*)(Gs + GG_MB + i * 32 + n * 2) = __builtin_bit_cast(h16, (_Float16)((i >= n) ? mb[r] : 0.f));
                        *(LAS h16*)(Gs + GG_MK + i * 32 + n * 2) = __builtin_bit_cast(h16, (_Float16)((i >= n) ? mk[r] : 0.f)); }
                    LDS_WAIT();
                    float tc[16];
#pragma unroll
                    for (int r = 0; r < 16; ++r) {
                        float arow[16];
#pragma unroll
                        for (int m4 = 0; 4 * m4 < r; ++m4) { const f32x4 av = *(const LAS f32x4*)(AM + (r * 16 + 4 * m4) * 4); arow[4 * m4] = av.x; arow[4 * m4 + 1] = av.y; arow[4 * m4 + 2] = av.z; arow[4 * m4 + 3] = av.w; }
                        float a0 = (r == n) ? 1.0f : 0.0f, a1 = 0.f;
#pragma unroll
                        for (int m = 0; m + 1 < r; m += 2) { a0 += arow[m] * tc[m]; a1 += arow[m + 1] * tc[m + 1]; }
                        if (r & 1) a0 += arow[r - 1] * tc[r - 1];
                        tc[r] = a0 + a1;
                    }
                    if (q == 0) {
#pragma unroll
                        for (int r = 0; r < 16; ++r) *(LAS float*)(Gs + GG_TF + r * TFP + n * 4) = tc[r];
                    }
                }
                WG_BAR();
            }
        } else {
            f32x4 Xs[2][4];
#pragma unroll
            for (int cw = 0; cw < 2; ++cw)
#pragma unroll
                for (int t = 0; t < 4; ++t) Xs[cw][t] = (f32x4){0.f, 0.f, 0.f, 0.f};
            const int tra = (4 * q + (n >> 2)) * TLP + (n & 3) * 8;
            WG_BAR();
            for (int it = 0; it < NIT; ++it) {
                if (it >= 3) {
                    const int jc = it - 3; const LAS unsigned char* P = lds + TL0 + (jc % 3) * TL_SLOT; const LAS unsigned char* Gs = lds + GG0 + (jc & 1) * GG_SLOT;
                    const LAS unsigned char* VR = lds + VR0 + (jc & 3) * 1024;
                    f16x4 art[4], rrt[4], bht[4], kht[4]; f32x4 pm4[4], pc4[4];
#pragma unroll
                    for (int t = 0; t < 4; ++t) {
                        art[t] = __builtin_bit_cast(f16x4, __builtin_amdgcn_ds_read_tr16_b64_v4i16((LAS v4i16_t*)(P + T_AR + 16 * t * TLP + tra)));
                        rrt[t] = __builtin_bit_cast(f16x4, __builtin_amdgcn_ds_read_tr16_b64_v4i16((LAS v4i16_t*)(P + T_RR + 16 * t * TLP + tra)));
                        bht[t] = *(const LAS f16x4*)(P + T_BH + (16 * t + n) * TLP + q * 8); kht[t] = *(const LAS f16x4*)(P + T_KH + (16 * t + n) * TLP + q * 8);
                        pm4[t] = *(const LAS f32x4*)(P + T_PM + (16 * t + 4 * q) * 4); pc4[t] = *(const LAS f32x4*)(P + T_PC + (16 * t + 4 * q) * 4);
                    }
                    const f16x4 nkf = *(const LAS f16x4*)(Gs + GG_NK + n * 32 + 8 * q), mbf = *(const LAS f16x4*)(Gs + GG_MB + n * 32 + 8 * q), mkf = *(const LAS f16x4*)(Gs + GG_MK + n * 32 + 8 * q);
                    float tf[4];
#pragma unroll
                    for (int s_ = 0; s_ < 4; ++s_) tf[s_] = *(const LAS float*)(Gs + GG_TF + n * TFP + (4 * q + s_) * 4);
#pragma unroll
                    for (int cw = 0; cw < 2; ++cw) {
                        const f16x4 Vf = __builtin_bit_cast(f16x4, __builtin_amdgcn_ds_read_tr16_b64_v4i16((LAS v4i16_t*)(VR + (4 * q + (n >> 2)) * 64 + (16 * cw + 4 * (n & 3)) * 2)));
                        f16x4 Xp[4];
#pragma unroll
                        for (int t = 0; t < 4; ++t) Xp[t] = cvt4(Xs[cw][t] * pm4[t]);
                        f32x4 Wa = (f32x4){0.f, 0.f, 0.f, 0.f}, Oa = Wa;
#pragma unroll
                        for (int t = 0; t < 4; ++t) { Wa = MFMA16(art[t], Xp[t], Wa); Oa = MFMA16(rrt[t], Xp[t], Oa); }
                        Wa = MFMA16(nkf, Vf, Wa);
                        f32x4 U = (f32x4){0.f, 0.f, 0.f, 0.f};
#pragma unroll
                        for (int s_ = 0; s_ < 4; ++s_) U = __builtin_amdgcn_mfma_f32_16x16x4f32(tf[s_], Wa[s_], U, 0, 0, 0);
                        const f16x4 Ub = cvt4(U);
                        Oa = MFMA16(mbf, Ub, Oa);
                        Oa = MFMA16(mkf, Vf, Oa);
#pragma unroll
                        for (int t = 0; t < 4; ++t) Xs[cw][t] = MFMA16(bht[t], Ub, MFMA16(kht[t], Vf, Xs[cw][t] * pc4[t]));
                        if (do_write) {
#pragma unroll
                            for (int r = 0; r < 4; ++r) OB[(size_t)(b * SEQ + 16 * jc + 4 * q + r) * PAQ_W + h * 64 + 32 * half + 16 * cw + n] = __builtin_bit_cast(h16, (_Float16)Oa[r]);
                        }
                    }
                }
                WG_BAR();
            }
            if (do_write) {
#pragma unroll
                for (int cw = 0; cw < 2; ++cw)
#pragma unroll
                    for (int t = 0; t < 4; ++t) *(f32x4*)(a->out + O_RWKV_P + ((size_t)(b * 8 + h)) * 4096 + (size_t)(32 * half + 16 * cw + n) * 64 + 16 * t + 4 * q) = Xs[cw][t];
            }
        }
    }
    if (!do_write || part == 0) return;
    for (int it = 0; it < 6; ++it) {
        if (it < 4) {
            const int j = NBLK_P + it, row0 = blk_row0(j, b, sgrp);
            if (w < 4) {
                const int row = row0 + sA; const h16* pc = PAQ + (size_t)row * PAQ_W;
                const f32x4 cr = unpk4(*(const u32x2*)(pc + o_r)), cw = unpk4(*(const u32x2*)(pc + o_w)), ck = unpk4(*(const u32x2*)(pc + o_k)), ca = unpk4(*(const u32x2*)(pc + o_a));
                f32x4 pr, pw, pk, pa;
                if ((sA & 3) == 0) {
                    const float* sp = a->in[3] + (size_t)((row - MP) >> 2) * APROJ;
                    pr = *(const f32x4*)(sp + o_r); pw = *(const f32x4*)(sp + o_w); pk = *(const f32x4*)(sp + o_k); pa = *(const f32x4*)(sp + o_a);
                } else {
                    const h16* pp = pc - PAQ_W;
                    pr = unpk4(*(const u32x2*)(pp + o_r)); pw = unpk4(*(const u32x2*)(pp + o_w)); pk = unpk4(*(const u32x2*)(pp + o_k)); pa = unpk4(*(const u32x2*)(pp + o_a));
                }
                RW_STAGE_A(j, cr, cw, ck, ca, pr, pw, pk, pa);
            }
            { const int row = row0 + sVv; const float cv = h2f(PAQ[(size_t)row * PAQ_W + vcolp]);
              const float pv = ((sVv & 3) == 0) ? a->in[3][(size_t)((row - MP) >> 2) * APROJ + vcolp] : h2f(PAQ[(size_t)(row - 1) * PAQ_W + vcolp]);
              RW_STAGE_V(j, cv, pv); }
        }
        if (w >= 4 && it >= 1 && it - 1 < 4) RW_STAGE_B(NBLK_P + it - 1);
        if (it >= 2) {
            const int j = NBLK_P + it - 2; const int row0 = blk_row0(j, b, sgrp);
            const LAS unsigned char* Y = lds + R_Y + (j % 3) * RY_BYTES;
            const size_t sbase = ((size_t)((row0 - MP) >> 2) * 8 + h) * 4096 + vrow * 64 + 4 * kq;
            f32x4 st[4];
#pragma unroll
            for (int q = 0; q < 4; ++q) st[q] = *(const f32x4*)(a->in[2] + sbase + (size_t)q * 8 * 4096);
            float osave = 0.f;
#pragma unroll
            for (int q = 0; q < 4; ++q) {
                S0 = (h2){(_Float16)st[q].x, (_Float16)st[q].y}; S1 = (h2){(_Float16)st[q].z, (_Float16)st[q].w};
#pragma unroll
                for (int s = 4 * q; s < 4 * q + 4; ++s) { const RwkvOps p = rwkv_ld(Y, s, kq, vi); const float o = rwkv_step(S0, S1, p); osave = (kq == s) ? o : osave; }
                *(f32x4*)(a->out + O_RWKV_S + sbase + (size_t)q * 8 * 4096) = (f32x4){(float)S0.x, (float)S0.y, (float)S1.x, (float)S1.y};
            }
            OB[(size_t)(row0 + kq) * PAQ_W + h * 64 + vrow] = __builtin_bit_cast(h16, (_Float16)osave);
        }
        WG_BAR();
    }
#undef RW_PREFETCH
#undef RW_PREFETCH_V
#undef RW_STAGE_A
#undef RW_STAGE_V
#undef RW_STAGE_B
}

struct GdnPre { u32x4 qk; h16 v[4]; float ain, bin, vb; };
struct GdnOps { u32x4 q, k; unsigned v; float eg, beta; unsigned meh; };
__device__ __forceinline__ GdnOps gdn_ld(const LAS unsigned char* Y, int s, int kq, int vi) {
    GdnOps o;
    o.q = *(const LAS u32x4*)(Y + 0 + s * 256 + kq * 16); o.k = *(const LAS u32x4*)(Y + 4096 + s * 256 + kq * 16);
    o.v = *(const LAS unsigned*)(Y + 8192 + s * 128 + vi * 4); o.eg = *(const LAS float*)(Y + 10240 + s * 16); o.beta = *(const LAS float*)(Y + 10240 + s * 16 + 4); o.meh = *(const LAS unsigned*)(Y + 10240 + s * 16 + 8);
    return o;
}
__device__ __forceinline__ float gdn_step(h2 (&S)[4], const GdnOps& p) {
    float ks = __builtin_amdgcn_fdot2(S[1], u2h(p.k.y), __builtin_amdgcn_fdot2(S[0], u2h(p.k.x), 0.f, false), false) + __builtin_amdgcn_fdot2(S[3], u2h(p.k.w), __builtin_amdgcn_fdot2(S[2], u2h(p.k.z), 0.f, false), false);
    ks = row_sum16(ks);
    const float vv = (float)u2h(p.v).x;
    const float dl = vv - p.eg * ks;
    const h2 dlh = bc2(dl), meh = u2h(p.meh);
    S[0] = __builtin_elementwise_fma(u2h(p.k.x), dlh, __builtin_elementwise_fma(S[0], meh, S[0])); S[1] = __builtin_elementwise_fma(u2h(p.k.y), dlh, __builtin_elementwise_fma(S[1], meh, S[1]));
    S[2] = __builtin_elementwise_fma(u2h(p.k.z), dlh, __builtin_elementwise_fma(S[2], meh, S[2])); S[3] = __builtin_elementwise_fma(u2h(p.k.w), dlh, __builtin_elementwise_fma(S[3], meh, S[3]));
    float o = __builtin_amdgcn_fdot2(S[0], u2h(p.q.x), 0.f, false); o = __builtin_amdgcn_fdot2(S[1], u2h(p.q.y), o, false);
    o = __builtin_amdgcn_fdot2(S[2], u2h(p.q.z), o, false); o = __builtin_amdgcn_fdot2(S[3], u2h(p.q.w), o, false);
    return row_sum16(o);
}

__device__ __forceinline__ void gdn_role(KArgs a, Frame& F, int cc, int mode) {
    const bool do_stage = (mode != 4), do_scan = (mode != 3), do_write = (mode < 3);
    const int w = F.wave, lane = F.lane;
    const int b = cc >> 4, hh = (cc >> 2) & 3, qt = cc & 3;
    const h16* PAQ = (const h16*)(a->ws + WS_PAQ); h16* OB = (h16*)(a->ws + WS_PAQ) + C_Q; const float* ab = (const float*)(a->ws + WS_AB);
    const float* cwp = a->in[23];
    LAS unsigned char* lds = F.lds;
    const h16* QK = (const h16*)(a->ws + WS_A);
    const int qarr = w >> 2, qslot = ((w & 3) << 2) + (lane >> 4), qj = lane & 15;
    const int qkoff = qarr * 512 + hh * 128 + 8 * qj;
    const int tsl = lane >> 4, kq = lane & 15;
    const int sV = 2 * w + (lane >> 5), vloc = lane & 31, vcolp = C_GV + hh * 128 + 32 * qt + vloc, vch = vcolp - C_Q;
    float cwv[4];
#pragma unroll
    for (int i = 0; i < 4; ++i) cwv[i] = cwp[i * CONVCH + vch];
    const float negA = -fexp(a->in[24][hh]), dtb = a->in[25][hh];
    const int vi = 4 * w + tsl, vcol = 32 * qt + vi;
    const int sgrp = b;

#define GD_QK(Y_, v_) do { *(LAS u32x4*)((Y_) + qarr * 4096 + qslot * 256 + qj * 16) = (v_); } while (0)
#define GD_GB(Y_, ain_, bin_) do { if (w == 0 && lane < 16) { const float xx_ = (ain_) + dtb; const float sp_ = (xx_ > 20.f) ? xx_ : __logf(1.0f + fexp(xx_)); \
        const float eg_ = fexp(negA * sp_), me_ = eg_ - 1.0f, bt_ = fsigmoid(bin_); *(LAS u32x4*)((Y_) + 10240 + lane * 16) = (u32x4){__builtin_bit_cast(unsigned, bt_ * eg_), __builtin_bit_cast(unsigned, bt_), pkh(me_, me_), 0u}; } } while (0)
#define GD_PREFETCH(j) do { pre.qk = *(const u32x4*)(QK + (size_t)(b * SEQ + 16 * (j) + qslot) * D + qkoff); \
        const int rowv_ = b * SEQ + 16 * (j) + sV; \
        _Pragma("unroll") for (int i_ = 0; i_ < 4; ++i_) { int rr_ = rowv_ - 3 + i_; rr_ = rr_ < b * SEQ ? b * SEQ : rr_; pre.v[i_] = PAQ[(size_t)rr_ * PAQ_W + vcolp]; } \
        pre.vb = ab[(size_t)rowv_ * 8 + 4 + hh]; \
        if (w == 0 && lane < 16) { const int rg_ = b * SEQ + 16 * (j) + lane; pre.ain = ab[(size_t)rg_ * 8 + hh]; pre.bin = ab[(size_t)rg_ * 8 + 4 + hh]; } } while (0)

    {
        constexpr int KP = 272, VP = 80, TP = 68;
        constexpr int GC_KBE = 0, GC_QD = 16 * KP, GC_KD = 32 * KP, GC_QKM = 48 * KP, GC_VB = GC_QKM + 512, GC_EG = GC_VB + 32 * VP, GC_TF = GC_EG + 16, GC_SLOT = ((GC_TF + 16 * TP + 63) / 64) * 64;
        constexpr int RD = 6, TA0 = 2 * GC_SLOT, KQ0 = TA0 + 2048, AB0 = KQ0 + RD * 8192, VR0 = AB0 + RD * 1024, GC_END = VR0 + 8 * 1024;
        static_assert(GC_END <= RING_BYTES, "chunk LDS");
        const int n = lane & 15, q = lane >> 4;
        const int wu = __builtin_amdgcn_readfirstlane(w);
        const int only = (mode >= 11) ? mode - 11 : -1;
#define ROLE_ON(r_) (only < 0 || only == (r_))
#define GC_GATES(a_cur_, b_cur_) \
                const float xx = (a_cur_) + dtb; const float sp = (xx > 20.f) ? xx : __logf(1.0f + fexp(xx)); \
                const float bet = fsigmoid(b_cur_); float gc = negA * sp; \
                gc += dppf<0x111>(gc); gc += dppf<0x112>(gc); gc += dppf<0x114>(gc); gc += dppf<0x118>(gc); \
                const float egi = fexp(gc);
        const int rko = n * 256 + ((q & 1) << 3), rkx = (q >> 1) ^ n;
#define GC_RAWK(j, t_) (*(const LAS u32x2*)(lds + KQ0 + ((j) % RD) * 8192 + rko + (((2 * (t_)) ^ rkx) << 4)))
#define GC_RAWQ(j, t_) (*(const LAS u32x2*)(lds + KQ0 + ((j) % RD) * 8192 + 4096 + rko + (((2 * (t_)) ^ rkx) << 4)))
#define GC_LD_AB(j) do { const LAS unsigned char* abp_ = lds + AB0 + ((j) % RD) * 1024 + n * 32 + hh * 4; pa_in = *(const LAS float*)abp_; pb_in = *(const LAS float*)(abp_ + 16); } while (0)
        if (wu < 2) {
            f32x4 Sc[8];
#pragma unroll
            for (int t = 0; t < 8; ++t) Sc[t] = (f32x4){0.f, 0.f, 0.f, 0.f};
            WG_BAR();
            for (int it = -1; it <= NBLK_P; ++it) {
                if (it >= 1 && ROLE_ON(4)) {
                    const int jc = it - 1; const LAS unsigned char* L = lds + (jc & 1) * GC_SLOT;
                    f16x4 Sb[8];
#pragma unroll
                    for (int t = 0; t < 8; ++t) Sb[t] = cvt4(Sc[t]);
                    f32x4 X = *(const LAS f32x4*)(L + GC_VB + (16 * w + n) * VP + 16 * q);
                    f32x4 Oa = (f32x4){0.f, 0.f, 0.f, 0.f};
#pragma unroll
                    for (int t = 0; t < 8; ++t) {
                        X = MFMA16(*(const LAS f16x4*)(L + GC_KBE + n * KP + (16 * t + 4 * q) * 2), Sb[t], X);
                        Oa = MFMA16(*(const LAS f16x4*)(L + GC_QD + n * KP + (16 * t + 4 * q) * 2), Sb[t], Oa);
                    }
                    f32x4 VN = (f32x4){0.f, 0.f, 0.f, 0.f};
#pragma unroll
                    for (int s_ = 0; s_ < 4; ++s_) VN = __builtin_amdgcn_mfma_f32_16x16x4f32(*(const LAS float*)(L + GC_TF + n * TP + (4 * q + s_) * 4), X[s_], VN, 0, 0, 0);
                    const f16x4 VNb = cvt4(VN);
                    Oa = MFMA16(*(const LAS f16x4*)(L + GC_QKM + n * 32 + 8 * q), VNb, Oa);
                    const float eg15 = *(const LAS float*)(L + GC_EG);
                    const LAS unsigned char* kdp = L + GC_KD + (4 * q + (n >> 2)) * KP + (4 * (n & 3)) * 2;
#pragma unroll
                    for (int t = 0; t < 8; ++t) {
                        const f16x4 kdt = __builtin_bit_cast(f16x4, __builtin_amdgcn_ds_read_tr16_b64_v4i16((LAS v4i16_t*)(kdp + 32 * t)));
                        Sc[t] = MFMA16(kdt, VNb, Sc[t] * eg15);
                    }
                    if (do_write) {
#pragma unroll
                        for (int r = 0; r < 4; ++r) OB[(size_t)(b * SEQ + 16 * jc + 4 * q + r) * PAQ_W + 512 + hh * 128 + 32 * qt + 16 * w + n] = __builtin_bit_cast(h16, (_Float16)Oa[r]);
                    }
                }
                WG_BAR();
            }
            if (do_write) {
#pragma unroll
                for (int t = 0; t < 8; ++t)
#pragma unroll
                    for (int r = 0; r < 4; ++r) a->out[O_DELTA_P + ((size_t)(b * 4 + hh)) * 16384 + (size_t)(16 * t + 4 * q + r) * 128 + 32 * qt + 16 * w + n] = Sc[t][r];
            }
        } else if (wu < 4) {
            const int tp = wu - 2;
            LAS unsigned char* TA = lds + 2 * GC_SLOT + tp * 1024;
            float pa_in = 0.f, pb_in = 0.f;
            float tc[16];
#pragma unroll
            for (int r = 0; r < 16; ++r) tc[r] = 0.f;
            WG_BAR();
            for (int it = -1; it <= NBLK_P; ++it) {
                const int c1 = it + 1;
                if (!ROLE_ON(0)) {} else if ((c1 & 1) == tp && c1 < NBLK_P) {
                    GC_LD_AB(c1);
                    u32x2 kfr[8];
#pragma unroll
                    for (int t = 0; t < 8; ++t) kfr[t] = GC_RAWK(c1, t);
                    GC_GATES(pa_in, pb_in) (void)egi;
                    f32x4 kk = (f32x4){0.f, 0.f, 0.f, 0.f};
#pragma unroll
                    for (int t = 0; t < 8; ++t) kk = MFMA16(u2q(kfr[t]), u2q(kfr[t]), kk);
#pragma unroll
                    for (int r = 0; r < 4; ++r) { const int i = 4 * q + r; const float gci = __shfl(gc, i + (lane & 48)), bi = __shfl(bet, i + (lane & 48));
                        *(LAS float*)(TA + (i * 16 + n) * 4) = (i > n) ? bi * kk[r] * fexp(fminf(gci - gc, 0.f)) : 0.f; }
                    LDS_WAIT();
#pragma unroll
                    for (int r = 0; r < 8; ++r) {
                        float arow[8];
#pragma unroll
                        for (int m4 = 0; 4 * m4 < r; ++m4) { const f32x4 av = *(const LAS f32x4*)(TA + (r * 16 + 4 * m4) * 4); arow[4 * m4] = av.x; arow[4 * m4 + 1] = av.y; arow[4 * m4 + 2] = av.z; arow[4 * m4 + 3] = av.w; }
                        float a0 = (r == n) ? 1.0f : 0.0f, a1 = 0.f;
#pragma unroll
                        for (int m = 0; m + 1 < r; m += 2) { a0 -= arow[m] * tc[m]; a1 -= arow[m + 1] * tc[m + 1]; }
                        if (r & 1) a0 -= arow[r - 1] * tc[r - 1];
                        tc[r] = a0 + a1;
                    }
                } else if ((it & 1) == tp && it >= 0 && it < NBLK_P) {
                    LAS unsigned char* L = lds + (it & 1) * GC_SLOT;
#pragma unroll
                    for (int r = 8; r < 16; ++r) {
                        float arow[16];
#pragma unroll
                        for (int m4 = 0; 4 * m4 < r; ++m4) { const f32x4 av = *(const LAS f32x4*)(TA + (r * 16 + 4 * m4) * 4); arow[4 * m4] = av.x; arow[4 * m4 + 1] = av.y; arow[4 * m4 + 2] = av.z; arow[4 * m4 + 3] = av.w; }
                        float a0 = (r == n) ? 1.0f : 0.0f, a1 = 0.f;
#pragma unroll
                        for (int m = 0; m + 1 < r; m += 2) { a0 -= arow[m] * tc[m]; a1 -= arow[m + 1] * tc[m + 1]; }
                        if (r & 1) a0 -= arow[r - 1] * tc[r - 1];
                        tc[r] = a0 + a1;
                    }
                    if (q == 0) {
#pragma unroll
                        for (int r = 0; r < 16; ++r) *(LAS float*)(L + GC_TF + r * TP + n * 4) = tc[r];
                    }
                }
                WG_BAR();
            }
        } else if (wu == 4) {
            float pa_in = 0.f, pb_in = 0.f;
            WG_BAR();
            for (int it = -1; it <= NBLK_P; ++it) {
                if (it >= 0 && it < NBLK_P && ROLE_ON(1)) {
                    LAS unsigned char* L = lds + (it & 1) * GC_SLOT;
                    GC_LD_AB(it);
                    u32x2 kfr[8], qfr[8];
#pragma unroll
                    for (int t = 0; t < 8; ++t) { kfr[t] = GC_RAWK(it, t); qfr[t] = GC_RAWQ(it, t); }
                    GC_GATES(pa_in, pb_in)
                    const _Float16 s1 = (_Float16)(-bet * egi), s2 = (_Float16)egi, s3 = (_Float16)fexp(__shfl(gc, 15 + (lane & 48)) - gc);
#pragma unroll
                    for (int t = 0; t < 8; ++t) {
                        *(LAS f16x4*)(L + GC_KBE + n * KP + (16 * t + 4 * q) * 2) = u2q(kfr[t]) * s1;
                        *(LAS f16x4*)(L + GC_QD + n * KP + (16 * t + 4 * q) * 2) = u2q(qfr[t]) * s2;
                        *(LAS f16x4*)(L + GC_KD + n * KP + (16 * t + 4 * q) * 2) = u2q(kfr[t]) * s3;
                    }
                    if (lane == 15) *(LAS float*)(L + GC_EG) = egi;
                }
                WG_BAR();
            }
        } else if (wu < 7) {
            float pa_in = 0.f, pb_in = 0.f;
            const int cv_ = C_GV + hh * 128 + 32 * qt + 16 * (wu - 5) + 4 * q;
            f32x4 cw4[4];
#pragma unroll
            for (int i = 0; i < 4; ++i) cw4[i] = *(const f32x4*)(cwp + i * CONVCH + (cv_ - C_Q));
            unsigned go[4];
#pragma unroll
            for (int j = 0; j < 4; ++j) { const int tk = 4 * j + q; go[j] = (unsigned)((tk * D + (wu == 5 ? 512 : 0) + hh * 128 + 8 * (n ^ tk)) * 2); }
            const unsigned go4 = (wu == 5) ? (unsigned)(lane * 16) : (unsigned)((((lane >> 2) * PAQ_W) + C_GV + hh * 128 + 32 * qt + 8 * (lane & 3)) * 2);
            const unsigned char* g4 = (wu == 5) ? (const unsigned char*)(ab + (size_t)(b * SEQ) * 8) : (const unsigned char*)(PAQ + (size_t)(b * SEQ) * PAQ_W);
            const size_t g4s = (wu == 5) ? 16 * 8 * 4 : (size_t)16 * PAQ_W * 2;
            const unsigned char* gkq = (const unsigned char*)(QK + (size_t)(b * SEQ) * D);
#define GC_DMA(j) do { const unsigned char* gb_ = gkq + (size_t)(j) * (16 * D * 2); LAS unsigned char* ld_ = lds + KQ0 + ((j) % RD) * 8192 + (wu == 5 ? 0 : 4096); \
                _Pragma("unroll") for (int j_ = 0; j_ < 4; ++j_) __builtin_amdgcn_global_load_lds((const unsigned*)(gb_ + go[j_]), (LAS unsigned*)(ld_ + j_ * 1024), 16, 0, 0); \
                __builtin_amdgcn_global_load_lds((const unsigned*)(g4 + (size_t)(j) * g4s + go4), (LAS unsigned*)(lds + (wu == 5 ? AB0 + ((j) % RD) * 1024 : VR0 + ((j) & 7) * 1024)), 16, 0, 0); } while (0)
#pragma unroll
            for (int j = 0; j < RD - 2; ++j) GC_DMA(j);
            asm volatile("s_waitcnt vmcnt(0)" ::: "memory");
            WG_BAR();
            for (int it = -1; it <= NBLK_P; ++it) {
                if (it + RD - 1 < NBLK_P) GC_DMA(it + RD - 1);
                if (it >= 0 && it < NBLK_P && ROLE_ON(2)) {
                    LAS unsigned char* L = lds + (it & 1) * GC_SLOT;
                    GC_LD_AB(it);
                    const float bet = fsigmoid(pb_in);
                    const int tt = 16 * it + n;
                    f32x4 acc = (f32x4){0.f, 0.f, 0.f, 0.f};
#pragma unroll
                    for (int i = 0; i < 4; ++i) { const f32x4 x = unpk4(*(const LAS u32x2*)(lds + VR0 + ((tt - 3 + i) & 127) * 64 + (wu - 5) * 32 + q * 8)); if (tt - 3 + i >= 0) acc += x * cw4[i]; }
#pragma unroll
                    for (int e = 0; e < 4; ++e) *(LAS float*)(L + GC_VB + (16 * (wu - 5) + 4 * q + e) * VP + n * 4) = bet * fsilu(acc[e]);
                }
                if (it + RD - 1 < NBLK_P) asm volatile("s_waitcnt vmcnt(%0)" :: "n"(5 * (RD - 3)) : "memory"); else asm volatile("s_waitcnt vmcnt(0)" ::: "memory");
                WG_BAR();
            }
#undef GC_DMA
        } else {
            float pa_in = 0.f, pb_in = 0.f;
            WG_BAR();
            for (int it = -1; it <= NBLK_P; ++it) {
                if (it >= 0 && it < NBLK_P && ROLE_ON(3)) {
                    LAS unsigned char* L = lds + (it & 1) * GC_SLOT;
                    GC_LD_AB(it);
                    u32x2 kfr[8], qfr[8];
#pragma unroll
                    for (int t = 0; t < 8; ++t) { kfr[t] = GC_RAWK(it, t); qfr[t] = GC_RAWQ(it, t); }
                    GC_GATES(pa_in, pb_in) (void)egi; (void)bet;
                    f32x4 qk = (f32x4){0.f, 0.f, 0.f, 0.f};
#pragma unroll
                    for (int t = 0; t < 8; ++t) qk = MFMA16(u2q(qfr[t]), u2q(kfr[t]), qk);
#pragma unroll
                    for (int r = 0; r < 4; ++r) { const int i = 4 * q + r; const float gci = __shfl(gc, i + (lane & 48));
                        const float vq = (i >= n) ? qk[r] * fexp(fminf(gci - gc, 0.f)) : 0.f;
                        *(LAS h16*)(L + GC_QKM + i * 32 + n * 2) = __builtin_bit_cast(h16, (_Float16)vq); }
                }
                WG_BAR();
            }
        }
#undef GC_GATES
#undef GC_LD_AB
#undef GC_RAWK
#undef GC_RAWQ
        if (!do_write && mode != 16 && mode != 17) return;
    }
    static_assert(G_Y + 4 * GY_BYTES <= RING_BYTES, "sample LDS");
    constexpr int IMG0 = G_Y + 4 * GY_BYTES, IMGP = 272, IMG_SEQ = 32 * IMGP;
    static_assert(IMG0 + 4 * IMG_SEQ <= RING_BYTES, "sample state image");
    f32x4 Sn[8];
    const int ldk = F.tid >> 3, ldc = (F.tid & 7) * 4;
#define GD_LDS_STATE(jb_) do { const int seq0_ = (blk_row0(NBLK_P + (jb_), b, sgrp) - MP) >> 2; \
        _Pragma("unroll") for (int p_ = 0; p_ < 8; ++p_) Sn[p_] = *(const f32x4*)(a->in[4] + ((size_t)(seq0_ + (p_ >> 1)) * 4 + hh) * 16384 + (size_t)(64 * (p_ & 1) + ldk) * 128 + 32 * qt + ldc); } while (0)
    GD_LDS_STATE(0);
#pragma unroll
    for (int jb = 0; jb < 4; ++jb) {
        LAS unsigned char* Y = lds + G_Y + jb * GY_BYTES;
        const int row0 = blk_row0(NBLK_P + jb, b, sgrp);
        { const u32x4 qv = *(const u32x4*)(QK + (size_t)(row0 + qslot) * D + qkoff); GD_QK(Y, qv); }
        { const int row = row0 + sV, t = sV & 3; float accv = 0.f;
#pragma unroll
          for (int i = 0; i < 4; ++i) { const int tt = t - 3 + i;
              const float xp = h2f(PAQ[(size_t)(row - 3 + i) * PAQ_W + vcolp]);
              const float xs = a->in[5][((size_t)((row - MP) >> 2) * 3 + (tt < 0 ? 3 + tt : 0)) * CONVCH + vch];
              accv += ((tt >= 0) ? xp : xs) * cwv[i]; }
          const float sv = fsilu(accv) * fsigmoid(ab[(size_t)row * 8 + 4 + hh]); *(LAS unsigned*)(Y + 8192 + sV * 128 + vloc * 4) = pkh(sv, sv); }
        { float ain = 0.f, bin = 0.f; if (w == 0 && lane < 16) { ain = ab[(size_t)(row0 + lane) * 8 + hh]; bin = ab[(size_t)(row0 + lane) * 8 + 4 + hh]; } GD_GB(Y, ain, bin); }
    }
    WG_BAR();
#pragma unroll
    for (int jb = 0; jb < 4; ++jb) {
        const int row0 = blk_row0(NBLK_P + jb, b, sgrp);
        const LAS unsigned char* Y = lds + G_Y + jb * GY_BYTES;
        const int seq0 = (row0 - MP) >> 2;
#pragma unroll
        for (int p = 0; p < 8; ++p)
#pragma unroll
            for (int e = 0; e < 4; ++e) *(LAS h16*)(lds + IMG0 + (p >> 1) * IMG_SEQ + (ldc + e) * IMGP + (64 * (p & 1) + ldk) * 2) = __builtin_bit_cast(h16, (_Float16)Sn[p][e]);
        WG_BAR();
        h2 Sq[4][4];
#pragma unroll
        for (int q = 0; q < 4; ++q) { const u32x4 v = *(const LAS u32x4*)(lds + IMG0 + q * IMG_SEQ + vi * IMGP + kq * 16); Sq[q][0] = u2h(v.x); Sq[q][1] = u2h(v.y); Sq[q][2] = u2h(v.z); Sq[q][3] = u2h(v.w); }
        if (jb + 1 < 4) GD_LDS_STATE(jb + 1);
        float osave = 0.f;
#pragma unroll
        for (int q = 0; q < 4; ++q) {
#pragma unroll
            for (int s = 4 * q; s < 4 * q + 4; ++s) { const GdnOps p = gdn_ld(Y, s, kq, vi); const float o = gdn_step(Sq[q], p); osave = (kq == s) ? o : osave; }
            *(LAS u32x4*)(lds + IMG0 + q * IMG_SEQ + vi * IMGP + kq * 16) = (u32x4){__builtin_bit_cast(unsigned, Sq[q][0]), __builtin_bit_cast(unsigned, Sq[q][1]), __builtin_bit_cast(unsigned, Sq[q][2]), __builtin_bit_cast(unsigned, Sq[q][3])};
        }
        if (do_write) OB[(size_t)(row0 + kq) * PAQ_W + 512 + hh * 128 + vcol] = __builtin_bit_cast(h16, (_Float16)osave);
        WG_BAR();
        if (do_write) {
#pragma unroll
            for (int p = 0; p < 8; ++p) { f32x4 o;
#pragma unroll
                for (int e = 0; e < 4; ++e) o[e] = h2f(*(const LAS h16*)(lds + IMG0 + (p >> 1) * IMG_SEQ + (ldc + e) * IMGP + (64 * (p & 1) + ldk) * 2));
                *(f32x4*)(a->out + O_DELTA_S + ((size_t)(seq0 + (p >> 1)) * 4 + hh) * 16384 + (size_t)(64 * (p & 1) + ldk) * 128 + 32 * qt + ldc) = o; }
        }
        WG_BAR();
    }
    WG_BAR();
#undef GD_LDS_STATE
#undef GD_QK
#undef GD_GB
#undef GD_PREFETCH
}

__device__ __forceinline__ void post_phase(KArgs a, Frame& F) {
    const h16* PAQ = (const h16*)(a->ws + WS_PAQ); const h16* Z = (const h16*)(a->ws + WS_Z); const h16* OI = (const h16*)(a->ws + WS_PAQ) + C_Q; h16* OB = (h16*)(a->ws + WS_A); const float* bon = (const float*)(a->ws + WS_BON);
    const float* mu = a->in[12];
    LAS unsigned char* lds = F.lds;
    const int lane = F.lane, w = F.wave, tsl = lane >> 4, n = lane & 15;
    const h16* g2t = (const h16*)(a->ws + WS_G2T);
    for (int blk = F.bx; blk < M / 16; blk += F.G) {
        const int row0 = blk * 16;
        {
            const int tok = F.tid >> 5, c4 = (F.tid & 31) * 4, row = row0 + tok;
            const bool smp = row >= MP; const int t = smp ? ((row - MP) & 3) : (row & (SEQ - 1));
            const f32x4 cg = unpk4(*(const u32x2*)(PAQ + (size_t)row * PAQ_W + C_GD + c4));
            f32x4 pg;
            if (t > 0) pg = unpk4(*(const u32x2*)(PAQ + (size_t)(row - 1) * PAQ_W + C_GD + c4));
            else if (smp) pg = *(const f32x4*)(a->in[3] + (size_t)((row - MP) >> 2) * APROJ + C_GD + c4);
            else pg = (f32x4){0.f, 0.f, 0.f, 0.f};
            const f32x4 m4 = *(const f32x4*)(mu + C_GD + c4);
            const f32x4 g = cg + (pg - cg) * m4;
            u32x2 o; o.x = pkh(fsigmoid(g.x), fsigmoid(g.y)); o.y = pkh(fsigmoid(g.z), fsigmoid(g.w));
            *(LAS u32x2*)(lds + tok * 256 + c4 * 2) = o;
        }
        __syncthreads();
        {
            f32x4 gacc[4];
#pragma unroll
            for (int nt = 0; nt < 4; ++nt) gacc[nt] = (f32x4){0.f, 0.f, 0.f, 0.f};
#pragma unroll
            for (int st = 0; st < 4; ++st) {
                const f16x8 av = *(const LAS f16x8*)(lds + n * 256 + tsl * 16 + st * 64);
#pragma unroll
                for (int nt = 0; nt < 4; ++nt) {
                    const f16x8 bv = *(const f16x8*)(g2t + (size_t)(w * 64 + nt * 16 + n) * 128 + 8 * tsl + 32 * st);
                    gacc[nt] = __builtin_amdgcn_mfma_f32_16x16x32_f16(av, bv, gacc[nt], 0, 0, 0);
                }
            }
#pragma unroll
            for (int i = 0; i < 4; ++i) {
                const int row = row0 + 4 * tsl + i;
                const bool smp = row >= MP; const int t = smp ? ((row - MP) & 3) : (row & (SEQ - 1));
                float o[4], sum = 0.f;
#pragma unroll
                for (int nt = 0; nt < 4; ++nt) { o[nt] = h2f(OI[(size_t)row * PAQ_W + w * 64 + nt * 16 + n]); sum += o[nt]; }
                const float mean = row_sum16(sum) * (1.0f / 64.0f);
                float var = 0.f;
#pragma unroll
                for (int nt = 0; nt < 4; ++nt) { o[nt] -= mean; var += o[nt] * o[nt]; }
                const float rstd = __builtin_amdgcn_rsqf(row_sum16(var) * (1.0f / 64.0f) + LNX_EPS);
                const f32x4 bp = *(const f32x4*)(bon + (size_t)row * 32 + w * 4);
                const float bonus = (bp.x + bp.y) + (bp.z + bp.w);
#pragma unroll
                for (int nt = 0; nt < 4; ++nt) {
                    const int col = w * 64 + nt * 16 + n;
                    const float cv = h2f(PAQ[(size_t)row * PAQ_W + C_V + col]); float pv;
                    if (t > 0) pv = h2f(PAQ[(size_t)(row - 1) * PAQ_W + C_V + col]); else if (smp) pv = a->in[3][(size_t)((row - MP) >> 2) * APROJ + C_V + col]; else pv = 0.f;
                    const float vl = cv + (pv - cv) * mu[C_V + col];
                    const float val = (o[nt] * rstd * a->in[21][col] + a->in[22][col] + bonus * vl) * gacc[nt][i];
                    o[nt] = val;
                }
                asm volatile("" ::: "memory");
#pragma unroll
                for (int nt = 0; nt < 4; ++nt) OB[(size_t)row * D + w * 64 + nt * 16 + n] = __builtin_bit_cast(h16, (_Float16)o[nt]);
            }
        }
#pragma unroll
        for (int i = 0; i < 2; ++i) {
            const int row = row0 + 2 * w + i, col = tsl * 128 + n * 8;
            const u32x4 ov = *(const u32x4*)(OI + (size_t)row * PAQ_W + 512 + col); const u32x4 zv = *(const u32x4*)(Z + (size_t)row * Z_W + col);
            const f32x4 o0 = unpk4((u32x2){ov.x, ov.y}), o1 = unpk4((u32x2){ov.z, ov.w}), z0 = unpk4((u32x2){zv.x, zv.y}), z1 = unpk4((u32x2){zv.z, zv.w});
            float ss = ((o0.x * o0.x + o0.y * o0.y) + (o0.z * o0.z + o0.w * o0.w)) + ((o1.x * o1.x + o1.y * o1.y) + (o1.z * o1.z + o1.w * o1.w));
            const float rstd = __builtin_amdgcn_rsqf(row_sum16(ss) * (1.0f / 128.0f) + RMS_EPS);
            const f32x4 n0 = *(const f32x4*)(a->in[26] + n * 8), n1 = *(const f32x4*)(a->in[26] + n * 8 + 4);
            f32x4 r0 = o0 * rstd * n0, r1 = o1 * rstd * n1;
            r0.x *= fsilu(z0.x); r0.y *= fsilu(z0.y); r0.z *= fsilu(z0.z); r0.w *= fsilu(z0.w);
            r1.x *= fsilu(z1.x); r1.y *= fsilu(z1.y); r1.z *= fsilu(z1.z); r1.w *= fsilu(z1.w);
            u32x4 wv; wv.x = pkh(r0.x, r0.y); wv.y = pkh(r0.z, r0.w); wv.z = pkh(r1.x, r1.y); wv.w = pkh(r1.z, r1.w);
            *(u32x4*)(OB + (size_t)row * D + 512 + col) = wv;
        }
        __syncthreads();
    }
}

__device__ __forceinline__ void final_norm(KArgs a, Frame& F) {
    pg8::RowScale rs{(const float*)(a->ws + WS_SSQ3), 16};
    const int gw = F.bx * NWAVES + F.wave, NGW = F.G * NWAVES;
    const f32x4* fw = (const f32x4*)a->in[34] + F.lane; f32x4 wv[4];
#pragma unroll
    for (int j = 0; j < 4; ++j) wv[j] = fw[64 * j];
    for (int m = gw; m < M; m += NGW) {
        f32x4* xr = (f32x4*)(a->out + (size_t)m * D) + F.lane; const u32x2* hr = (const u32x2*)((const h16*)(a->ws + WS_H3H) + (size_t)m * D) + F.lane; const float s = rs(m);
#pragma unroll
        for (int j = 0; j < 4; ++j) { const f32x4 v = unpk4(hr[64 * j]); xr[64 * j] = v * s * wv[j]; }
    }
}

__device__ __forceinline__ void late_convert(KArgs a, Frame& F, int part, int nparts) {
    unsigned char* ws = a->ws;
    LAS float* scr = (LAS float*)(F.lds + F.wave * 16384);
    const int gw = part * NWAVES + F.wave, NGW = nparts * NWAVES;
    constexpr int I_UP = 16 * 176, I_DN = 44 * 32, I_PJ = 8 * 32, I_WO = 16 * 32;
    constexpr int NITEMS = I_UP + I_DN + 2 * I_PJ + I_WO;
    for (int it = gw; it < NITEMS; it += NGW) {
        int r = it;
        if (r < I_UP) { tr_up_item(a->in[31], a->in[32], a->in[30], (h16*)(ws + WS_W2UP), r, scr, F.lane); continue; } r -= I_UP;
        if (r < I_DN) { const int kb = r / 32, nb = r % 32; tr_item(a->in[33], D, 64 * kb, 32 * nb, nullptr, (h16*)(ws + WS_W2DN), FF, 32 * nb, 64 * kb, scr, F.lane); continue; } r -= I_DN;
        if (r < I_PJ) { const int kb = r / 32, nb = r % 32; tr_item(a->in[27], D, 64 * kb, 32 * nb, nullptr, (h16*)(ws + WS_WPT), D, 32 * nb, 64 * kb, scr, F.lane); continue; } r -= I_PJ;
        if (r < I_PJ) { const int kb = r / 32, nb = r % 32; tr_item(a->in[28], D, 64 * kb, 32 * nb, nullptr, (h16*)(ws + WS_WPT), D, 32 * nb, 512 + 64 * kb, scr, F.lane); continue; } r -= I_PJ;
        { const int kb = r / 32, nb = r % 32; tr_item(a->in[29], D, 64 * kb, 32 * nb, nullptr, (h16*)(ws + WS_WOUTT), D, 32 * nb, 64 * kb, scr, F.lane); }
    }
}

constexpr int N_PHASES = 12;
__global__ void __launch_bounds__(NTHREADS, 2) mk_fwd(Args args) {
    extern __shared__ __attribute__((aligned(16))) unsigned char lds_raw[];
    Frame F;
    F.lds = (LAS unsigned char*)lds_raw;
    F.tid = threadIdx.x; F.lane = F.tid & 63; F.wave = __builtin_amdgcn_readfirstlane(F.tid >> 6);
    F.G = gridDim.x; F.bx = blockIdx.x;
    volatile LAS unsigned* MISC = (volatile LAS unsigned*)(F.lds + MISC_OFF);
    for (int u = F.tid; u < (LDS_BYTES - LDSCTL_OFF) / 4; u += NTHREADS) ((LAS unsigned*)(F.lds + LDSCTL_OFF))[u] = 0u;
    __syncthreads();
    KArgs ka0 = (KArgs)__builtin_amdgcn_kernarg_segment_ptr();
    unsigned char* ws = ka0->ws;
    XcdBarrier bar; bar.bar = (unsigned*)(ws + WS_CTL) + 1024; bar.x = 0; bar.st = nullptr;
    if (MK_N_LAUNCHES == 1) bar = xcd_barrier_post((unsigned*)(ws + WS_CTL) + 1024, MISC + 8);
    const int lo = ka0->ph_lo, hi = ka0->ph_hi;
#ifndef PH_MASK
#define PH_MASK 0xfff
#endif
#define IN(k) (((PH_MASK >> (k)) & 1) && lo <= (k) && (k) < hi)
#define SEAM(k) do { if (IN(k) && IN((k) + 1)) xcd_barrier(bar); } while (0)
    const int c = F.bx;

#define NREP(k) ((PROBE_REP == (k)) ? 2 : 1)
    if (IN(0)) for (int rep_ = 0; rep_ < NREP(0); ++rep_) { KArgs args = ka0; asm volatile("" : "+s"(args)); unsigned char* ws = args->ws; unsigned char* dob = (unsigned char*)args->out; (void)ws; (void)dob; p0_prologue(args, F); } SEAM(0);
    if (IN(1)) for (int rep_ = 0; rep_ < NREP(1); ++rep_) { KArgs args = ka0; asm volatile("" : "+s"(args)); unsigned char* ws = args->ws; unsigned char* dob = (unsigned char*)args->out; (void)ws; (void)dob;
        pg8::Gemm g{(const h16*)(ws + WS_A), (const h16*)(dob + DO_W1UP), D, D}; pg8::StaticOrder S; S.init(M, 5632, F.G, c);
        pg8::EpiSwiglu E{(h16*)(ws + WS_HID), pg8::RowScale{(const float*)(ws + WS_SSQ0), 1}};
        pg8::gemm_phase(F.lds, g, S, E);
    } SEAM(1);
    if (IN(2)) for (int rep_ = 0; rep_ < NREP(2); ++rep_) { KArgs args = ka0; asm volatile("" : "+s"(args)); unsigned char* ws = args->ws; unsigned char* dob = (unsigned char*)args->out; (void)ws; (void)dob;
        pg8::Gemm g{(const h16*)(ws + WS_HID), (const h16*)(dob + DO_W1DN), FF, FF}; pg8::StaticOrder S; S.init(MP, D, F.G, c);
        pg8::EpiResid<true, false, true> E{nullptr, nullptr, MP, (const h16*)(ws + WS_A), nullptr, (h16*)(dob + DO_H1H), (float*)(ws + WS_SSQ1), 0.5f};
        pg8::gemm_phase(F.lds, g, S, E);
        SResid SE{nullptr, (const h16*)(ws + WS_A), nullptr, (h16*)(dob + DO_H1H), (float*)(ws + WS_SSQ1), 0.5f};
        if (c < 256) sample_gemm(F.lds, g.A, FF, g.Bt, FF, SE, c, F.tid);
    } SEAM(2);
    if (IN(3)) for (int rep_ = 0; rep_ < NREP(3); ++rep_) { KArgs args = ka0; asm volatile("" : "+s"(args)); unsigned char* ws = args->ws; unsigned char* dob = (unsigned char*)args->out; (void)ws; (void)dob;
        pg8::Gemm g{(const h16*)(dob + DO_H1H), (const h16*)(dob + DO_WIN), D, D}; pg8::StaticOrder S; S.init(M, NIN, F.G, c);
        pg8::EpiP E{(h16*)(ws + WS_PAQ), (h16*)(ws + WS_Z), (h16*)(ws + WS_GT), pg8::RowScale{(const float*)(ws + WS_SSQ1), 16}};
        pg8::gemm_phase(F.lds, g, S, E);
        ab_gemv(args, F);
    } SEAM(3);
    if (IN(4)) for (int rep_ = 0; rep_ < NREP(4); ++rep_) { KArgs args = ka0; asm volatile("" : "+s"(args)); gdn_prep(args, F); } SEAM(4);
    if (IN(5)) for (int rep_ = 0; rep_ < NREP(5); ++rep_) { KArgs args = ka0; asm volatile("" : "+s"(args)); unsigned char* ws = args->ws; unsigned char* dob = (unsigned char*)args->out; (void)ws; (void)dob;
        const int mode = (MK_N_LAUNCHES == 1) ? 0 : args->pad;
        if (F.G == 256) { if (c < 128) { if (mode == 0 || mode == 1 || mode == 5 || mode == 6 || mode == 8 || mode == 9 || mode == 10) rwkv_role(args, F, c, mode, 0); } else { if (mode == 0 || mode == 2 || mode == 3 || mode == 4 || mode >= 11) gdn_role(args, F, c - 128, mode); if (mode == 0) { rwkv_role(args, F, c - 128, 0, 1); late_convert(args, F, c - 128, 128); } } }
    } SEAM(5);
    if (IN(6)) for (int rep_ = 0; rep_ < NREP(6); ++rep_) { KArgs args = ka0; asm volatile("" : "+s"(args)); unsigned char* ws = args->ws; unsigned char* dob = (unsigned char*)args->out; (void)ws; (void)dob; post_phase(args, F); } SEAM(6);
    if (IN(7)) for (int rep_ = 0; rep_ < NREP(7); ++rep_) { KArgs args = ka0; asm volatile("" : "+s"(args)); unsigned char* ws = args->ws; unsigned char* dob = (unsigned char*)args->out; (void)ws; (void)dob;
        pg8::Gemm g{(const h16*)(ws + WS_A), (const h16*)(ws + WS_WPT), D, D}; pg8::StaticOrder S; S.init(MP, D, F.G, c);
        pg8::EpiMerge E{(const h16*)(ws + WS_GT), (h16*)(ws + WS_MRG), 8};
        pg8::gemm_phase(F.lds, g, S, E);
        SMerge SE{(const h16*)(ws + WS_GT), (h16*)(ws + WS_MRG)};
        if (c < 256) sample_gemm(F.lds, g.A, D, g.Bt, D, SE, c, F.tid);
    } SEAM(7);
    if (IN(8)) for (int rep_ = 0; rep_ < NREP(8); ++rep_) { KArgs args = ka0; asm volatile("" : "+s"(args)); unsigned char* ws = args->ws; unsigned char* dob = (unsigned char*)args->out; (void)ws; (void)dob;
        pg8::Gemm g{(const h16*)(ws + WS_MRG), (const h16*)(ws + WS_WOUTT), D, D}; pg8::StaticOrder S; S.init(MP, D, F.G, c);
        pg8::EpiResid<true, false, true> E{nullptr, nullptr, M, (const h16*)(dob + DO_H1H), nullptr, (h16*)(ws + WS_A), (float*)(ws + WS_SSQ2), 1.0f};
        pg8::gemm_phase(F.lds, g, S, E);
        SResid SE{nullptr, (const h16*)(dob + DO_H1H), nullptr, (h16*)(ws + WS_A), (float*)(ws + WS_SSQ2), 1.0f};
        if (c < 256) sample_gemm(F.lds, g.A, D, g.Bt, D, SE, c, F.tid);
    } SEAM(8);
    if (IN(9)) for (int rep_ = 0; rep_ < NREP(9); ++rep_) { KArgs args = ka0; asm volatile("" : "+s"(args)); unsigned char* ws = args->ws; unsigned char* dob = (unsigned char*)args->out; (void)ws; (void)dob;
        pg8::Gemm g{(const h16*)(ws + WS_A), (const h16*)(ws + WS_W2UP), D, D}; pg8::StaticOrder S; S.init(M, 5632, F.G, c);
        pg8::EpiSwiglu E{(h16*)(ws + WS_HID), pg8::RowScale{(const float*)(ws + WS_SSQ2), 16}};
        pg8::gemm_phase(F.lds, g, S, E);
    } SEAM(9);
    if (IN(10)) for (int rep_ = 0; rep_ < NREP(10); ++rep_) { KArgs args = ka0; asm volatile("" : "+s"(args)); unsigned char* ws = args->ws; unsigned char* dob = (unsigned char*)args->out; (void)ws; (void)dob;
        pg8::Gemm g{(const h16*)(ws + WS_HID), (const h16*)(ws + WS_W2DN), FF, FF}; pg8::StaticOrder S; S.init(MP, D, F.G, c);
        pg8::EpiResid<true, false, true> E{nullptr, nullptr, M, (const h16*)(ws + WS_A), nullptr, (h16*)(ws + WS_H3H), (float*)(ws + WS_SSQ3), 0.5f};
        pg8::gemm_phase(F.lds, g, S, E);
        SResid SE{nullptr, (const h16*)(ws + WS_A), nullptr, (h16*)(ws + WS_H3H), (float*)(ws + WS_SSQ3), 0.5f};
        if (c < 256) sample_gemm(F.lds, g.A, FF, g.Bt, FF, SE, c, F.tid);
    } SEAM(10);
    if (IN(11)) for (int rep_ = 0; rep_ < NREP(11); ++rep_) { KArgs args = ka0; asm volatile("" : "+s"(args)); unsigned char* ws = args->ws; unsigned char* dob = (unsigned char*)args->out; (void)ws; (void)dob; final_norm(args, F); }
#undef IN
#undef SEAM
}

extern "C" void kernel_launch(void* const* d_in, const int* in_sizes, int n_in, void* d_out, int out_size, void* d_ws, size_t ws_size, hipStream_t stream) {
    static int grid = 0;
    if (grid == 0) {
        if (n_in != 35 || in_sizes[0] != MP * D || in_sizes[1] != MS * D || (size_t)out_size != O_END || ws_size < WS_END) {
            fprintf(stderr, "kernel_launch: unexpected shapes: n_in %d in0 %d out %d ws %zu (need %zu)\n", n_in, n_in > 0 ? in_sizes[0] : -1, out_size, ws_size, (size_t)WS_END); grid = -1; return; }
        int dev = 0, cus = 0, per_cu = 0;
        if (hipGetDevice(&dev) != hipSuccess || hipDeviceGetAttribute(&cus, hipDeviceAttributeMultiprocessorCount, dev) != hipSuccess) { fprintf(stderr, "kernel_launch: device query failed\n"); grid = -1; return; }
        if (hipFuncSetAttribute((const void*)mk_fwd, hipFuncAttributeMaxDynamicSharedMemorySize, LDS_BYTES) != hipSuccess) { fprintf(stderr, "kernel_launch: hipFuncSetAttribute failed\n"); grid = -1; return; }
        if (hipOccupancyMaxActiveBlocksPerMultiprocessor(&per_cu, (const void*)mk_fwd, NTHREADS, LDS_BYTES) != hipSuccess || per_cu < 1) { fprintf(stderr, "kernel_launch: occupancy query says %d blocks per CU\n", per_cu); grid = -1; (void)hipGetLastError(); return; }
        (void)hipGetLastError();
        grid = cus;
        if (grid != 256) fprintf(stderr, "kernel_launch: %d CUs; the scan phase needs exactly 256 workgroups\n", grid);
    }
    if (grid < 0) return;
    (void)hipMemsetAsync((char*)d_ws + WS_CTL, 0, CTL_ZERO_BYTES, stream);
    Args a{};
    for (int i = 0; i < 35; ++i) a.in[i] = (const float*)d_in[i];
    a.out = (float*)d_out; a.ws = (unsigned char*)d_ws;
    if (MK_N_LAUNCHES == 1) {
        a.ph_lo = 0; a.ph_hi = N_PHASES; a.li = 0;
        hipLaunchKernelGGL(mk_fwd, dim3(grid), dim3(NTHREADS), LDS_BYTES, stream, a);
    } else {
        for (int li = 0; li < N_PHASES; ++li) { a.ph_lo = li; a.ph_hi = li + 1; a.li = li; hipLaunchKernelGGL(mk_fwd, dim3(grid), dim3(NTHREADS), LDS_BYTES, stream, a);
            if (li == PROBE_LREP) { a.pad = PROBE_MODE; for (int x_ = 0; x_ < PROBE_NX; ++x_) hipLaunchKernelGGL(mk_fwd, dim3(grid), dim3(NTHREADS), LDS_BYTES, stream, a); a.pad = 0; } }
    }
}
```
